# Optimizing an MI355X kernel written in HIP

```python
import jax, jax.numpy as jnp
from jax import lax
import numpy as np

D_MODEL = 1024
BATCH = 4
SEQ = 8192
DEPTH = 2

CHUNK = 64
D_MIX = D_MODEL
D_A = D_MIX // 2
D_B = D_MIX - D_A
A_HEADS = 4
A_HEAD_DIM = D_A // A_HEADS
SGU_BLOCK = 128
B_HEADS = 4
B_V_DIM = D_B // B_HEADS
B_QK_DIM = B_V_DIM // 2
D_QK = B_HEADS * B_QK_DIM
QK_CONV = 4
D_FF = 2816
FFN_CONV = 3
LN_EPS = 1e-5
DEEPNORM_ALPHA = (2 * DEPTH) ** 0.25
DEEPNORM_BETA = (8 * DEPTH) ** -0.25
D_IN = 2 * D_A + 2 * D_QK + 2 * D_B + 2 * B_HEADS
SPLITS = [D_A, 2 * D_A, 2 * D_A + 2 * D_QK, 2 * D_A + 2 * D_QK + D_B,
          2 * D_A + 2 * D_QK + 2 * D_B, 2 * D_A + 2 * D_QK + 2 * D_B + B_HEADS]

kernel_name = 'hybrid_sgu_mlstm_deepnorm_encoder'


def layer_norm(x, g, b=None):
    xf = x.astype(jnp.float32)
    mu = xf.mean(-1, keepdims=True)
    var = jnp.square(xf - mu).mean(-1, keepdims=True)
    y = (xf - mu) * lax.rsqrt(var + LN_EPS) * g.astype(jnp.float32)
    if b is not None:
        y = y + b.astype(jnp.float32)
    return y.astype(x.dtype)


def causal_dwconv(x, w, b):
    width = w.shape[0]
    s_len = x.shape[1]
    xp = jnp.pad(x, ((0, 0), (width - 1, 0), (0, 0)))
    y = b
    for j in range(width):
        y = y + xp[:, j:j + s_len] * w[j]
    return y


def spatial_gating(u, v, w_s, b_s, ln_g, ln_b):
    bsz, s_len = u.shape[:2]
    nb = s_len // SGU_BLOCK
    v = layer_norm(v, ln_g, ln_b)
    chunk_id = jnp.arange(SGU_BLOCK) // CHUNK
    mask = chunk_id[:, None] >= chunk_id[None, :]
    w = jnp.where(mask, w_s, jnp.zeros_like(w_s))
    vb = v.reshape(bsz, nb, SGU_BLOCK, A_HEADS, A_HEAD_DIM)
    s = jnp.einsum('hij,bnjhc->bnihc', w, vb) + b_s.T[None, None, :, :, None]
    return u * s.reshape(bsz, s_len, A_HEADS, A_HEAD_DIM)


def mlstm_chunkwise(q, k, v, i_pre, log_f):
    bsz, nh, s_len, dk = q.shape
    dv = v.shape[-1]
    nc = s_len // CHUNK
    f32 = jnp.float32
    q = q.astype(f32).reshape(bsz, nh, nc, CHUNK, dk)
    k = (k.astype(f32) * dk ** -0.5).reshape(bsz, nh, nc, CHUNK, dk)
    v = v.astype(f32).reshape(bsz, nh, nc, CHUNK, dv)
    ig = i_pre.astype(f32).reshape(bsz, nh, nc, CHUNK)
    lf = log_f.astype(f32).reshape(bsz, nh, nc, CHUNK)
    b = jnp.cumsum(lf, axis=-1)
    b_end = b[..., -1]
    g = b_end[..., None] - b + ig

    def step(carry, xs):
        c, n, m = carry
        a, g_c, k_c, v_c = xs
        m_new = jnp.maximum(a + m, g_c.max(-1))
        decay = jnp.exp(a + m - m_new)
        kw = k_c * jnp.exp(g_c - m_new[..., None])[..., None]
        c_new = decay[..., None, None] * c + jnp.einsum('bhlk,bhlv->bhkv', kw, v_c)
        n_new = decay[..., None] * n + kw.sum(-2)
        return (c_new, n_new, m_new), (c, n, m)

    init = (jnp.zeros((bsz, nh, dk, dv), f32), jnp.zeros((bsz, nh, dk), f32), jnp.zeros((bsz, nh), f32))
    xs = (jnp.moveaxis(b_end, 2, 0), jnp.moveaxis(g, 2, 0), jnp.moveaxis(k, 2, 0), jnp.moveaxis(v, 2, 0))
    _, (c_prev, n_prev, m_prev) = lax.scan(step, init, xs)
    c_prev = jnp.moveaxis(c_prev, 0, 2)
    n_prev = jnp.moveaxis(n_prev, 0, 2)
    m_prev = jnp.moveaxis(m_prev, 0, 2)

    causal = jnp.tril(jnp.ones((CHUNK, CHUNK), dtype=bool))
    log_d = jnp.where(causal, b[..., :, None] - b[..., None, :] + ig[..., None, :], -jnp.inf)
    log_inter = b + m_prev[..., None]
    m = jnp.maximum(log_d.max(-1), log_inter)
    w_intra = jnp.exp(log_d - m[..., None])
    w_inter = jnp.exp(log_inter - m)
    scores = jnp.einsum('bhntk,bhnsk->bhnts', q, k) * w_intra
    num = (jnp.einsum('bhnts,bhnsv->bhntv', scores, v)
           + w_inter[..., None] * jnp.einsum('bhntk,bhnkv->bhntv', q, c_prev))
    den = scores.sum(-1) + w_inter * jnp.einsum('bhntk,bhnk->bhnt', q, n_prev)
    h = num / jnp.maximum(jnp.abs(den), jnp.exp(-m))[..., None]
    return h.reshape(bsz, nh, s_len, dv)


def hybrid_mixer(x, w_in, b_igate, b_fgate, qk_conv_w, qk_conv_b, sgu_w, sgu_b, sgu_ln_g, sgu_ln_b,
                 mh_norm_g, w_out):
    bsz, s_len, _ = x.shape
    z = x @ w_in
    a_u, a_v, qk, b_v, b_o, g_i, g_f = jnp.split(z, SPLITS, axis=-1)
    a_u = jax.nn.gelu(a_u, approximate=False).reshape(bsz, s_len, A_HEADS, A_HEAD_DIM)
    a_v = jax.nn.gelu(a_v, approximate=False).reshape(bsz, s_len, A_HEADS, A_HEAD_DIM)
    y_a = spatial_gating(a_u, a_v, sgu_w, sgu_b, sgu_ln_g, sgu_ln_b).reshape(bsz, s_len, D_A)
    qk = jax.nn.silu(causal_dwconv(qk, qk_conv_w, qk_conv_b))
    q, k = jnp.split(qk, 2, axis=-1)
    q = q.reshape(bsz, s_len, B_HEADS, B_QK_DIM).transpose(0, 2, 1, 3)
    k = k.reshape(bsz, s_len, B_HEADS, B_QK_DIM).transpose(0, 2, 1, 3)
    v = b_v.reshape(bsz, s_len, B_HEADS, B_V_DIM).transpose(0, 2, 1, 3)
    i_pre = (g_i + b_igate).transpose(0, 2, 1)
    log_f = jax.nn.log_sigmoid((g_f + b_fgate).astype(jnp.float32)).transpose(0, 2, 1)
    h = mlstm_chunkwise(q, k, v, i_pre, log_f).transpose(0, 2, 1, 3)
    h = layer_norm(h, mh_norm_g).astype(x.dtype)
    o = jax.nn.sigmoid(b_o).reshape(bsz, s_len, B_HEADS, B_V_DIM)
    y_b = (o * h).reshape(bsz, s_len, D_B)
    return jnp.concatenate([y_a, y_b], axis=-1) @ w_out


def conv_glu_ffn(x, w_up, conv_w, conv_b, w_down):
    gate, up = jnp.split(x @ w_up, 2, axis=-1)
    gate = jax.nn.gelu(causal_dwconv(gate, conv_w, conv_b), approximate=False)
    return (gate * up) @ w_down


def setup_inputs(seed: int = 0) -> dict:
    key = jax.random.key(seed)
    ks = jax.random.split(key, 20)

    def nrm(k, shape, scale):
        return jax.random.normal(k, shape, jnp.float32) * scale

    L = DEPTH
    return {
        'x': nrm(ks[0], (BATCH, SEQ, D_MODEL), 1.0),
        'w_in': nrm(ks[1], (L, D_MODEL, D_IN), D_MODEL ** -0.5),
        'b_igate': nrm(ks[2], (L, B_HEADS), 0.1),
        'b_fgate': jnp.linspace(3.0, 6.0, B_HEADS, dtype=jnp.float32)[None] + nrm(ks[3], (L, B_HEADS), 0.01),
        'qk_conv_w': nrm(ks[4], (L, QK_CONV, 2 * D_QK), QK_CONV ** -0.5),
        'qk_conv_b': nrm(ks[5], (L, 2 * D_QK), 0.02),
        'sgu_w': nrm(ks[6], (L, A_HEADS, SGU_BLOCK, SGU_BLOCK), SGU_BLOCK ** -0.5),
        'sgu_b': 1.0 + nrm(ks[7], (L, A_HEADS, SGU_BLOCK), 0.02),
        'sgu_ln_g': 1.0 + nrm(ks[8], (L, A_HEADS, A_HEAD_DIM), 0.02),
        'sgu_ln_b': nrm(ks[9], (L, A_HEADS, A_HEAD_DIM), 0.02),
        'mh_norm_g': 1.0 + nrm(ks[10], (L, B_HEADS, B_V_DIM), 0.02),
        'w_out': nrm(ks[11], (L, D_MIX, D_MODEL), DEEPNORM_BETA * D_MIX ** -0.5),
        'ln1_g': 1.0 + nrm(ks[12], (L, D_MODEL), 0.02),
        'ln1_b': nrm(ks[13], (L, D_MODEL), 0.02),
        'ffn_w_up': nrm(ks[14], (L, D_MODEL, 2 * D_FF), D_MODEL ** -0.5),
        'ffn_conv_w': nrm(ks[15], (L, FFN_CONV, D_FF), FFN_CONV ** -0.5),
        'ffn_conv_b': nrm(ks[16], (L, D_FF), 0.02),
        'ffn_w_down': nrm(ks[17], (L, D_FF, D_MODEL), DEEPNORM_BETA * D_FF ** -0.5),
        'ln2_g': 1.0 + nrm(ks[18], (L, D_MODEL), 0.02),
        'ln2_b': nrm(ks[19], (L, D_MODEL), 0.02),
    }


def reference(x, w_in, b_igate, b_fgate, qk_conv_w, qk_conv_b, sgu_w, sgu_b, sgu_ln_g, sgu_ln_b,
              mh_norm_g, w_out, ln1_g, ln1_b, ffn_w_up, ffn_conv_w, ffn_conv_b, ffn_w_down,
              ln2_g, ln2_b):
    for l in range(DEPTH):
        mix = hybrid_mixer(x, w_in[l], b_igate[l], b_fgate[l], qk_conv_w[l], qk_conv_b[l], sgu_w[l],
                           sgu_b[l], sgu_ln_g[l], sgu_ln_b[l], mh_norm_g[l], w_out[l])
        x = layer_norm(DEEPNORM_ALPHA * x + mix, ln1_g[l], ln1_b[l])
        ffn = conv_glu_ffn(x, ffn_w_up[l], ffn_conv_w[l], ffn_conv_b[l], ffn_w_down[l])
        x = layer_norm(DEEPNORM_ALPHA * x + ffn, ln2_g[l], ln2_b[l])
    return x
```

```cpp
#include <hip/hip_runtime.h>
#include <cstdint>
#include <cstdio>

constexpr int BATCH = 4, SEQ = 8192, DM = 1024, M = BATCH * SEQ, DEPTH = 2;
constexpr int DA = 512, DQK = 256, DB = 512, NH = 4;
constexpr int DIN = 2568, ZW = 2560, DFF = 2816;
constexpr float LN_EPS = 1e-5f, ALPHA = 1.41421356237f;

typedef unsigned short bf16;
typedef unsigned u32x4 __attribute__((ext_vector_type(4)));

__device__ __forceinline__ float bf2f(bf16 v) { return __uint_as_float(((unsigned)v) << 16); }
__device__ __forceinline__ bf16 f2bf(float f) { unsigned u = __float_as_uint(f); return (bf16)((u + 0x7fffu + ((u >> 16) & 1u)) >> 16); }
__device__ __forceinline__ float gelu_f(float x) { return 0.5f * x * (1.0f + erff(x * 0.70710678118f)); }
__device__ __forceinline__ float silu_f(float x) { return x / (1.0f + expf(-x)); }
__device__ __forceinline__ float sigmoid_f(float x) { return 1.0f / (1.0f + expf(-x)); }
__device__ __forceinline__ float logsigmoid_f(float x) { return fminf(x, 0.f) - log1pf(expf(-fabsf(x))); }

constexpr size_t MiB = 1u << 20;
constexpr size_t WS_XN = 0;
constexpr size_t WS_Z = 64 * MiB;
constexpr size_t WS_GT = 224 * MiB;
constexpr size_t WS_Y = 225 * MiB;
constexpr size_t WS_HM = 289 * MiB;
constexpr size_t WS_QC = 353 * MiB;
constexpr size_t WS_KC = 385 * MiB;
constexpr size_t WS_IG = 417 * MiB;
constexpr size_t WS_LF = 417 * MiB + 512 * 1024;
constexpr size_t WS_T3 = 64 * MiB;
constexpr size_t WS_H = 64 * MiB;
constexpr size_t WS_T4 = 240 * MiB;
constexpr size_t WS_T5 = 240 * MiB;

__global__ void k_cvt_x(const float* __restrict__ x, bf16* __restrict__ xn, size_t n) {
    size_t i = (size_t)blockIdx.x * blockDim.x + threadIdx.x;
    if (i < n) xn[i] = f2bf(x[i]);
}

template <int EPI>
__global__ void __launch_bounds__(256) k_gemm_naive(const bf16* __restrict__ A, int lda, const float* __restrict__ W, int N, int K,
                                                    float* __restrict__ T, int ldt, bf16* __restrict__ Zo, float* __restrict__ GTo) {
    __shared__ __attribute__((aligned(16))) bf16 as[16][1024];
    const int tid = threadIdx.x, n = blockIdx.x * 256 + tid, m0 = blockIdx.y * 16;
    float acc[16];
#pragma unroll
    for (int r = 0; r < 16; ++r) acc[r] = 0.f;
    for (int kc = 0; kc < K; kc += 1024) {
        const int kl = (K - kc) < 1024 ? (K - kc) : 1024;
        __syncthreads();
        for (int i = tid; i < 16 * (kl / 8); i += 256) { const int r = i / (kl / 8), c8 = i % (kl / 8);
            *(u32x4*)&as[r][c8 * 8] = *(const u32x4*)&A[(size_t)(m0 + r) * lda + kc + c8 * 8]; }
        __syncthreads();
        if (n < N) {
            for (int k = 0; k < kl; k += 8) {
                float b[8];
#pragma unroll
                for (int j = 0; j < 8; ++j) b[j] = W[(size_t)(kc + k + j) * N + n];
#pragma unroll
                for (int r = 0; r < 16; ++r) {
                    const u32x4 av = *(const u32x4*)&as[r][k];
#pragma unroll
                    for (int j = 0; j < 4; ++j) { const unsigned w = av[j];
                        acc[r] += __uint_as_float(w << 16) * b[2 * j]; acc[r] += __uint_as_float(w & 0xffff0000u) * b[2 * j + 1]; }
                }
            }
        }
    }
    if (n >= N) return;
#pragma unroll
    for (int r = 0; r < 16; ++r) { const size_t m = m0 + r; float v = acc[r];
        if (EPI == 0) T[m * ldt + n] = v;
        else { if (n < 1024) v = gelu_f(v); if (n < ZW) Zo[m * ZW + n] = f2bf(v); else GTo[m * 8 + (n - ZW)] = v; } }
}

__global__ void __launch_bounds__(256) k_ln(const float* __restrict__ xr, const float* __restrict__ t, const float* __restrict__ g, const float* __restrict__ b,
                                            float* __restrict__ out, bf16* __restrict__ xn) {
    const int lane = threadIdx.x & 63, row = blockIdx.x * 4 + (threadIdx.x >> 6);
    float v[16]; float s = 0.f;
#pragma unroll
    for (int j = 0; j < 16; ++j) { const size_t o = (size_t)row * DM + j * 64 + lane; v[j] = ALPHA * xr[o] + t[o]; s += v[j]; }
#pragma unroll
    for (int o = 1; o < 64; o <<= 1) s += __shfl_xor(s, o);
    const float mean = s * (1.f / DM); float q = 0.f;
#pragma unroll
    for (int j = 0; j < 16; ++j) { v[j] -= mean; q += v[j] * v[j]; }
#pragma unroll
    for (int o = 1; o < 64; o <<= 1) q += __shfl_xor(q, o);
    const float rstd = rsqrtf(q * (1.f / DM) + LN_EPS);
#pragma unroll
    for (int j = 0; j < 16; ++j) { const int c = j * 64 + lane; const size_t o = (size_t)row * DM + c; const float y = v[j] * rstd * g[c] + b[c]; out[o] = y; xn[o] = f2bf(y); }
}

__global__ void __launch_bounds__(256) k_sgu(const bf16* __restrict__ Z, const float* __restrict__ sw, const float* __restrict__ sb,
                                             const float* __restrict__ lg, const float* __restrict__ lb, bf16* __restrict__ Y) {
    __shared__ float vn[128][129];
    const int tid = threadIdx.x, lane = tid & 63, wv = tid >> 6, h = blockIdx.y; const size_t row0 = (size_t)blockIdx.x * 128;
    for (int j = wv; j < 128; j += 4) {
        const bf16* vp = Z + (row0 + j) * ZW + 512 + h * 128;
        float a = bf2f(vp[lane]), c = bf2f(vp[lane + 64]); float s = a + c;
#pragma unroll
        for (int o = 1; o < 64; o <<= 1) s += __shfl_xor(s, o);
        const float mean = s * (1.f / 128.f); a -= mean; c -= mean; float q = a * a + c * c;
#pragma unroll
        for (int o = 1; o < 64; o <<= 1) q += __shfl_xor(q, o);
        const float rstd = rsqrtf(q * (1.f / 128.f) + LN_EPS);
        vn[j][lane] = a * rstd * lg[h * 128 + lane] + lb[h * 128 + lane];
        vn[j][lane + 64] = c * rstd * lg[h * 128 + lane + 64] + lb[h * 128 + lane + 64];
    }
    __syncthreads();
    const int c = tid & 127, ih = tid >> 7;
    for (int i = ih * 64; i < ih * 64 + 64; ++i) {
        const int lim = (i < 64) ? 64 : 128; const float* wr = sw + ((size_t)h * 128 + i) * 128; float s = sb[h * 128 + i];
        for (int j = 0; j < lim; ++j) s += wr[j] * vn[j][c];
        const float u = bf2f(Z[(row0 + i) * ZW + h * 128 + c]);
        Y[(row0 + i) * DM + h * 128 + c] = f2bf(u * s);
    }
}

__global__ void __launch_bounds__(256) k_mlstm_prep(const bf16* __restrict__ Z, const float* __restrict__ GT, const float* __restrict__ cw, const float* __restrict__ cb,
                                                    const float* __restrict__ bi, const float* __restrict__ bfg, float* __restrict__ QC, float* __restrict__ KC,
                                                    float* __restrict__ IG, float* __restrict__ LF) {
    const size_t idx = (size_t)blockIdx.x * 256 + threadIdx.x; const size_t m = idx / 512; const int c = (int)(idx % 512); const int t = (int)(m % SEQ);
    float a = cb[c];
#pragma unroll
    for (int j = 0; j < 4; ++j) { const int tt = t - 3 + j; if (tt >= 0) a += cw[j * 512 + c] * bf2f(Z[(m - 3 + j) * ZW + 1024 + c]); }
    const float v = silu_f(a);
    if (c < 256) QC[m * 256 + c] = v; else KC[m * 256 + c - 256] = v * 0.125f;
    if (c < 4) { IG[m * 4 + c] = GT[m * 8 + c] + bi[c]; LF[m * 4 + c] = logsigmoid_f(GT[m * 8 + 4 + c] + bfg[c]); }
}

__global__ void __launch_bounds__(256) k_mlstm_rec(const bf16* __restrict__ Z, const float* __restrict__ QC, const float* __restrict__ KC,
                                                   const float* __restrict__ IG, const float* __restrict__ LF, float* __restrict__ HM) {
    __shared__ float qs[64], ks[64], vs[128], part[2][128], partd[2];
    const int tid = threadIdx.x, dv = tid & 127, half = tid >> 7, b = blockIdx.x >> 2, h = blockIdx.x & 3;
    float C[32], nv[32];
#pragma unroll
    for (int i = 0; i < 32; ++i) { C[i] = 0.f; nv[i] = 0.f; }
    float mst = 0.f;
    for (int t = 0; t < SEQ; ++t) {
        const size_t row = (size_t)b * SEQ + t;
        if (tid < 64) qs[tid] = QC[row * 256 + h * 64 + tid];
        else if (tid < 128) ks[tid - 64] = KC[row * 256 + h * 64 + tid - 64];
        else vs[tid - 128] = bf2f(Z[row * ZW + 1536 + h * 128 + tid - 128]);
        const float ig = IG[row * 4 + h], lf = LF[row * 4 + h];
        __syncthreads();
        const float mn = fmaxf(lf + mst, ig), dec = expf(lf + mst - mn), iw = expf(ig - mn); mst = mn;
        float pn = 0.f, pd = 0.f; const float vv = vs[dv];
#pragma unroll
        for (int i = 0; i < 32; ++i) { const int dk = half * 32 + i; const float kk = ks[dk] * iw, qq = qs[dk];
            C[i] = dec * C[i] + kk * vv; nv[i] = dec * nv[i] + kk; pn += qq * C[i]; pd += qq * nv[i]; }
        part[half][dv] = pn; if (dv == 0) partd[half] = pd;
        __syncthreads();
        if (half == 0) { const float num = part[0][dv] + part[1][dv], den = partd[0] + partd[1];
            HM[row * 512 + h * 128 + dv] = num / fmaxf(fabsf(den), expf(-mst)); }
    }
}

__global__ void __launch_bounds__(256) k_mlstm_fin(const bf16* __restrict__ Z, const float* __restrict__ HM, const float* __restrict__ g, bf16* __restrict__ Y) {
    const int lane = threadIdx.x & 63; const size_t wid = (size_t)blockIdx.x * 4 + (threadIdx.x >> 6); const size_t m = wid >> 2; const int h = (int)(wid & 3);
    float a = HM[m * 512 + h * 128 + lane], c = HM[m * 512 + h * 128 + 64 + lane]; float s = a + c;
#pragma unroll
    for (int o = 1; o < 64; o <<= 1) s += __shfl_xor(s, o);
    const float mean = s * (1.f / 128.f); a -= mean; c -= mean; float q = a * a + c * c;
#pragma unroll
    for (int o = 1; o < 64; o <<= 1) q += __shfl_xor(q, o);
    const float rstd = rsqrtf(q * (1.f / 128.f) + LN_EPS);
    const float o0 = sigmoid_f(bf2f(Z[m * ZW + 2048 + h * 128 + lane])), o1 = sigmoid_f(bf2f(Z[m * ZW + 2048 + h * 128 + 64 + lane]));
    Y[m * DM + 512 + h * 128 + lane] = f2bf(a * rstd * g[h * 128 + lane] * o0);
    Y[m * DM + 512 + h * 128 + 64 + lane] = f2bf(c * rstd * g[h * 128 + 64 + lane] * o1);
}

__global__ void __launch_bounds__(256) k_convglu(const float* __restrict__ T, const float* __restrict__ cw, const float* __restrict__ cb, bf16* __restrict__ H) {
    const size_t idx = (size_t)blockIdx.x * 256 + threadIdx.x; const int t = (int)(idx / DFF), c = (int)(idx % DFF);
    float a = cb[c];
#pragma unroll
    for (int j = 0; j < 3; ++j) { const int tt = t - 2 + j; if (tt >= 0) a += cw[j * DFF + c] * T[(size_t)tt * (2 * DFF) + c]; }
    H[(size_t)t * DFF + c] = f2bf(gelu_f(a) * T[(size_t)t * (2 * DFF) + DFF + c]);
}

extern "C" void kernel_launch(void* const* d_in, const int* in_sizes, int n_in, void* d_out, int out_size, void* d_ws, size_t ws_size, hipStream_t stream) {
    unsigned char* ws = (unsigned char*)d_ws;
    const float* x = (const float*)d_in[0];
    float* out = (float*)d_out;
    bf16* XN = (bf16*)(ws + WS_XN); bf16* Z = (bf16*)(ws + WS_Z); float* GT = (float*)(ws + WS_GT); bf16* Y = (bf16*)(ws + WS_Y);
    float* HM = (float*)(ws + WS_HM); float* QC = (float*)(ws + WS_QC); float* KC = (float*)(ws + WS_KC); float* IG = (float*)(ws + WS_IG); float* LF = (float*)(ws + WS_LF);
    bf16* H = (bf16*)(ws + WS_H);
    k_cvt_x<<<(M * DM) / 256, 256, 0, stream>>>(x, XN, (size_t)M * DM);
    for (int l = 0; l < DEPTH; ++l) {
        const float* w_in = (const float*)d_in[1] + (size_t)l * DM * DIN;
        const float* b_i = (const float*)d_in[2] + l * 4; const float* b_f = (const float*)d_in[3] + l * 4;
        const float* qcw = (const float*)d_in[4] + (size_t)l * 4 * 512; const float* qcb = (const float*)d_in[5] + l * 512;
        const float* sgw = (const float*)d_in[6] + (size_t)l * 4 * 128 * 128; const float* sgb = (const float*)d_in[7] + l * 512;
        const float* slg = (const float*)d_in[8] + l * 512; const float* slb = (const float*)d_in[9] + l * 512;
        const float* mhg = (const float*)d_in[10] + l * 512;
        const float* w_out = (const float*)d_in[11] + (size_t)l * DM * DM;
        const float* l1g = (const float*)d_in[12] + l * DM; const float* l1b = (const float*)d_in[13] + l * DM;
        const float* w_up = (const float*)d_in[14] + (size_t)l * DM * 2 * DFF;
        const float* fcw = (const float*)d_in[15] + (size_t)l * 3 * DFF; const float* fcb = (const float*)d_in[16] + l * DFF;
        const float* w_dn = (const float*)d_in[17] + (size_t)l * DFF * DM;
        const float* l2g = (const float*)d_in[18] + l * DM; const float* l2b = (const float*)d_in[19] + l * DM;
        const float* xr = (l == 0) ? x : out;
        k_gemm_naive<1><<<dim3((DIN + 255) / 256, M / 16), 256, 0, stream>>>(XN, DM, w_in, DIN, DM, nullptr, 0, Z, GT);
        k_sgu<<<dim3(M / 128, 4), 256, 0, stream>>>(Z, sgw, sgb, slg, slb, Y);
        k_mlstm_prep<<<(M * 512) / 256, 256, 0, stream>>>(Z, GT, qcw, qcb, b_i, b_f, QC, KC, IG, LF);
        k_mlstm_rec<<<16, 256, 0, stream>>>(Z, QC, KC, IG, LF, HM);
        k_mlstm_fin<<<M, 256, 0, stream>>>(Z, HM, mhg, Y);
        float* T3 = (float*)(ws + WS_T3);
        k_gemm_naive<0><<<dim3(DM / 256, M / 16), 256, 0, stream>>>(Y, DM, w_out, DM, DM, T3, DM, nullptr, nullptr);
        k_ln<<<M / 4, 256, 0, stream>>>(xr, T3, l1g, l1b, out, XN);
        float* T4 = (float*)(ws + WS_T4);
        for (int b = 0; b < BATCH; ++b) {
            k_gemm_naive<0><<<dim3(2 * DFF / 256, SEQ / 16), 256, 0, stream>>>(XN + (size_t)b * SEQ * DM, DM, w_up, 2 * DFF, DM, T4, 2 * DFF, nullptr, nullptr);
            k_convglu<<<(SEQ * DFF) / 256, 256, 0, stream>>>(T4, fcw, fcb, H + (size_t)b * SEQ * DFF);
        }
        float* T5 = (float*)(ws + WS_T5);
        k_gemm_naive<0><<<dim3(DM / 256, M / 16), 256, 0, stream>>>(H, DFF, w_dn, DM, DFF, T5, DM, nullptr, nullptr);
        k_ln<<<M / 4, 256, 0, stream>>>(out, T5, l2g, l2b, out, XN);
    }
}
```

```cpp
constexpr int PROBE_CLK = 0;
constexpr int PROBE_NULL = 0;
constexpr int DUP_MASK = 0;
#include <hip/hip_runtime.h>
#include <cstdint>
#include <cstdio>

constexpr int BATCH = 4, SEQ = 8192, DM = 1024, M = BATCH * SEQ, DEPTH = 2;
constexpr int DA = 512, DQK = 256, DB = 512, NH = 4;
constexpr int DIN = 2568, ZW = 2560, DFF = 2816;
constexpr float LN_EPS = 1e-5f, ALPHA = 1.41421356237f;

typedef unsigned short bf16;
typedef unsigned u32x4 __attribute__((ext_vector_type(4)));

__device__ __forceinline__ float bf2f(bf16 v) { return __uint_as_float(((unsigned)v) << 16); }
__device__ __forceinline__ bf16 f2bf(float f) { unsigned u = __float_as_uint(f); return (bf16)((u + 0x7fffu + ((u >> 16) & 1u)) >> 16); }
__device__ __forceinline__ float gelu_f(float x) { return 0.5f * x * (1.0f + erff(x * 0.70710678118f)); }
__device__ __forceinline__ float silu_f(float x) { return x / (1.0f + expf(-x)); }
__device__ __forceinline__ float sigmoid_f(float x) { return 1.0f / (1.0f + expf(-x)); }
__device__ __forceinline__ float logsigmoid_f(float x) { return fminf(x, 0.f) - log1pf(expf(-fabsf(x))); }

constexpr size_t MiB = 1u << 20;
constexpr size_t WS_XN = 0;
constexpr size_t WS_Z = 64 * MiB;
constexpr size_t WS_GT = 224 * MiB;
constexpr size_t WS_Y = 225 * MiB;
constexpr size_t WS_HM = 289 * MiB;
constexpr size_t WS_QC = 353 * MiB;
constexpr size_t WS_KC = 385 * MiB;
constexpr size_t WS_IG = 417 * MiB;
constexpr size_t WS_LF = 417 * MiB + 512 * 1024;
constexpr size_t WS_T3 = 64 * MiB;
constexpr size_t WS_H = 64 * MiB;
constexpr size_t WS_T4 = 240 * MiB;
constexpr size_t WS_T5 = 240 * MiB;


__device__ __forceinline__ int mk_lane() { return (int)__builtin_amdgcn_mbcnt_hi(~0u, __builtin_amdgcn_mbcnt_lo(~0u, 0u)); }
namespace pg8 {
#define PG8_LAS __attribute__((address_space(3)))
typedef unsigned short bf16_t;
typedef short bf16x8 __attribute__((ext_vector_type(8)));
typedef float f32x4 __attribute__((ext_vector_type(4)));
typedef unsigned u32x4 __attribute__((ext_vector_type(4)));
typedef int i32x4 __attribute__((ext_vector_type(4)));
constexpr int BM = 256, BK = 64, HALF = 128, HTB = HALF * BK * 2  , STAGE_BYTES = 8 * HTB, NXCD = 8, WGM = 8;

__host__ __device__ __forceinline__ int lds_byte(int r, int c) { const int st = (r >> 4) * 2 + (c >> 5), rr = r & 15, cc = c & 31, ob = rr * 64 + cc * 2; return st * 1024 + (ob ^ (((ob >> 9) & 1) << 5)); }
__host__ __device__ __forceinline__ void stage_rc(int b, int& R, int& C) { const int st = b / 1024, sb = b % 1024, swz = sb ^ (((sb >> 9) & 1) << 5); R = (st >> 1) * 16 + swz / 64; C = (st & 1) * 32 + (swz % 64) / 2; }
__host__ __device__ __forceinline__ int perm32(int rho) { const int n = rho >> 4, i = rho & 15; return 8 * (i >> 2) + 4 * n + (i & 3); }

struct Unit { int pm, pn; };
struct Gemm { const bf16_t* A; const bf16_t* Bt; int M, N, K; };

struct StaticOrder {
    int nM, nN, nwg, G, c;
    __host__ __device__ void init(int M, int N, int G_, int c_) { nM = M / BM; nN = N / BM; nwg = nM * nN; G = G_; c = c_; }
    __host__ __device__ bool next(int i, Unit& u) const {
        const long L = (long)i * G + c; if (L >= nwg) return false;
        int wgid = (int)L; { const int q = nwg / NXCD, r = nwg % NXCD, xcd = wgid % NXCD, off = wgid / NXCD; wgid = (xcd < r ? xcd * (q + 1) : r * (q + 1) + (xcd - r) * q) + off; }
        const int nig = WGM * nN, gid = wgid / nig, fm = gid * WGM, gsz = (nM - fm) < WGM ? (nM - fm) : WGM;
        u.pm = fm + ((wgid % nig) % gsz); u.pn = (wgid % nig) / gsz; return true;
    }
    __device__ __forceinline__ void a_ready(const Unit&) const {}
    __device__ __forceinline__ void done(const Unit&) const {}
};

__device__ __forceinline__ unsigned cvt_pk_bf16(float lo, float hi) { unsigned r; asm volatile("v_cvt_pk_bf16_f32 %0, %1, %2" : "=v"(r) : "v"(lo), "v"(hi)); return r; }
typedef float f32x2 __attribute__((ext_vector_type(2)));
__device__ __forceinline__ f32x2 gelu_pk(f32x2 v) {
    const f32x2 av = __builtin_elementwise_abs(v), d = av * 0.2316418882f + 1.0f;
    f32x2 t; t.x = __builtin_amdgcn_rcpf(d.x); t.y = __builtin_amdgcn_rcpf(d.y);
    f32x2 q = t * 0.5307027145f + (-0.7265760135f); q = q * t + 0.7107068705f; q = q * t + (-0.142248368f); q = q * t + 0.127414796f; q = q * t;
    const f32x2 s = (v * v) * (-0.72134752044f);
    f32x2 e; e.x = __builtin_amdgcn_exp2f(s.x); e.y = __builtin_amdgcn_exp2f(s.y);
    const f32x2 m = v * (q * e), r = v - m;
    f32x2 o; o.x = v.x < 0.f ? m.x : r.x; o.y = v.y < 0.f ? m.y : r.y; return o;
}

constexpr float K_EPS = 1e-5f, K_ALPHA = 1.41421356237f;
struct RowStat { float nmr, r; };
constexpr int TAB_STAT = 0, TAB_CONST = 8192, TAB_P = 12288, TAB_P2 = 20480, TAB_SW = 12288, TAB_R4 = 24576, TAB_SA = 28672;
__device__ __forceinline__ void glds16(const void* gsrc, PG8_LAS unsigned char* ldst) { __builtin_amdgcn_global_load_lds((const unsigned*)gsrc, (PG8_LAS unsigned*)ldst, 16, 0, 0); }
__device__ __forceinline__ void prefetch_stats(const float* part, int pm, PG8_LAS unsigned char* tab, int wid, int lane) {
    glds16(part + ((size_t)pm * BM + 32 * wid) * 8 + 4 * lane, tab + TAB_STAT + wid * 1024);
}
__device__ __forceinline__ RowStat row_stat_lds(const PG8_LAS unsigned char* tab, int rloc, float eps) {
    const f32x4 a = *(const PG8_LAS f32x4*)(tab + TAB_STAT + rloc * 32), b = *(const PG8_LAS f32x4*)(tab + TAB_STAT + rloc * 32 + 16);
    const float mean = ((a[0] + a[2]) + (b[0] + b[2])) * 0.25f;
    const float d0 = a[0] - mean, d1 = a[2] - mean, d2 = b[0] - mean, d3 = b[2] - mean;
    const float m2 = ((a[1] + a[3]) + (b[1] + b[3])) + 256.0f * ((d0 * d0 + d1 * d1) + (d2 * d2 + d3 * d3));
    RowStat o; o.r = __builtin_amdgcn_rsqf(m2 * (1.0f / 1024.0f) + eps); o.nmr = -mean * o.r; return o;
}
__device__ __forceinline__ void finalize_stats(PG8_LAS unsigned char* tab, int tid, int slot = TAB_P) {
    typedef float f32x2v __attribute__((ext_vector_type(2)));
    if (tid < 256) { const RowStat rs = row_stat_lds(tab, tid, K_EPS); *(PG8_LAS f32x2v*)(tab + slot + 8 * tid) = (f32x2v){rs.nmr, rs.r}; }
}
__device__ __forceinline__ RowStat stat_tab(const PG8_LAS unsigned char* tab, int rloc, int slot = TAB_P) {
    typedef float f32x2v __attribute__((ext_vector_type(2)));
    const f32x2v v = *(const PG8_LAS f32x2v*)(tab + slot + 8 * rloc); RowStat o; o.nmr = v.x; o.r = v.y; return o;
}
__device__ __forceinline__ float sum_fq4(float x) {
    auto a = __builtin_amdgcn_permlane16_swap(__float_as_uint(x), __float_as_uint(x), false, false); const float y = __uint_as_float(a[0]) + __uint_as_float(a[1]);
    auto b = __builtin_amdgcn_permlane32_swap(__float_as_uint(y), __float_as_uint(y), false, false); return __uint_as_float(b[0]) + __uint_as_float(b[1]);
}
__device__ __forceinline__ RowStat row_stat(const float* part, size_t row, float eps) {
    const f32x4 a = *(const f32x4*)(part + row * 8), b = *(const f32x4*)(part + row * 8 + 4);
    const float mean = ((a[0] + a[2]) + (b[0] + b[2])) * 0.25f;
    const float d0 = a[0] - mean, d1 = a[2] - mean, d2 = b[0] - mean, d3 = b[2] - mean;
    const float m2 = ((a[1] + a[3]) + (b[1] + b[3])) + 256.0f * ((d0 * d0 + d1 * d1) + (d2 * d2 + d3 * d3));
    RowStat o; o.r = 1.0f / sqrtf(m2 * (1.0f / 1024.0f) + eps); o.nmr = -mean * o.r; return o;
}
__device__ __forceinline__ f32x2 gelu_ns_pk(f32x2 v) {
    const f32x2 av = __builtin_elementwise_abs(v), d = av * 0.2316418882f + 1.0f;
    f32x2 t; t.x = __builtin_amdgcn_rcpf(d.x); t.y = __builtin_amdgcn_rcpf(d.y);
    f32x2 q = t * 0.5307027145f + (-0.7265760135f); q = q * t + 0.7107068705f; q = q * t + (-0.142248368f); q = q * t + 0.127414796f; q = q * t;
    const f32x2 s = (v * v) * (-0.72134752044f);
    f32x2 e; e.x = __builtin_amdgcn_exp2f(s.x); e.y = __builtin_amdgcn_exp2f(s.y);
    return __builtin_elementwise_max(v, (f32x2){0.f, 0.f}) - av * (q * e);
}
struct EpiZ {
    static constexpr bool PERM = true, AFTER_DRAIN = false, PERM_A = false, I8 = false;
    bf16_t* O; int ldc; const float* part; const float* c1; const float* c0; PG8_LAS unsigned char* tab;
    __device__ __forceinline__ void prefetch(const Unit& u, int wid, int lane) const {
        if (part) { prefetch_stats(part, u.pm, tab, wid, lane);
            if (wid < 2) glds16((wid ? c0 : c1) + u.pn * BM + 4 * lane, tab + TAB_CONST + wid * 1024); }
    }
    __device__ __forceinline__ void operator()(f32x4 (&acc)[2][2][4][2], const Unit& u, int wr, int wc, int fr, int fq) const {
        const int row0 = u.pm * BM + wr * 64 + fr, col0 = u.pn * BM + wc * 32 + 8 * fq, cl0 = wc * 32 + 8 * fq;
        const bool act = u.pn < 4;
        if (part) { finalize_stats(tab, (wr * 4 + wc) * 64 + fr + 16 * fq); asm volatile("s_waitcnt lgkmcnt(0)" ::: "memory"); __builtin_amdgcn_s_barrier(); asm volatile("" ::: "memory"); }
#pragma unroll
        for (int ai = 0; ai < 2; ++ai)
#pragma unroll
            for (int m = 0; m < 4; ++m) { const int rloc = ai * HALF + wr * 64 + m * 16 + fr; bf16_t* rowp = O + (size_t)(u.pm * BM + rloc) * ldc + col0;
                RowStat rs; rs.r = 1.f; rs.nmr = 0.f; if (part) rs = stat_tab(tab, rloc);
#pragma unroll
                for (int bj = 0; bj < 2; ++bj) { u32x4 w;
#pragma unroll
                    for (int n = 0; n < 2; ++n) { f32x4 v = acc[ai][bj][m][n];
                        if (part) { const f32x4 k1 = *(const PG8_LAS f32x4*)(tab + TAB_CONST + (cl0 + bj * HALF + 4 * n) * 4), k0 = *(const PG8_LAS f32x4*)(tab + TAB_CONST + 1024 + (cl0 + bj * HALF + 4 * n) * 4);
                            v = v * rs.r + (k1 * rs.nmr + k0); }
                        if (act) { const f32x2 a = gelu_ns_pk((f32x2){v[0], v[1]}), b = gelu_ns_pk((f32x2){v[2], v[3]}); v = (f32x4){a.x, a.y, b.x, b.y}; }
                        w[2 * n] = cvt_pk_bf16(v[0], v[1]); w[2 * n + 1] = cvt_pk_bf16(v[2], v[3]); }
                    __builtin_nontemporal_store(w, (u32x4*)(rowp + bj * HALF)); }
                asm volatile("" ::: "memory"); }
    }
};

struct EpiRes {
    static constexpr bool PERM = true, AFTER_DRAIN = false, PERM_A = false, I8 = false;
    bf16_t* V; bf16_t* Vout; int ldc; const float* part_prev; const float* gp; const float* bp; float* part_new; PG8_LAS unsigned char* tab;
    __device__ __forceinline__ void prefetch(const Unit& u, int wid, int lane) const {
        if (part_prev) { prefetch_stats(part_prev, u.pm, tab, wid, lane);
            if (wid < 2) glds16((wid ? bp : gp) + u.pn * BM + 4 * lane, tab + TAB_CONST + wid * 1024); }
    }
    __device__ __forceinline__ void operator()(f32x4 (&acc)[2][2][4][2], const Unit& u, int wr, int wc, int fr, int fq) const {
        typedef float f32x2v __attribute__((ext_vector_type(2)));
        const int col0 = u.pn * BM + wc * 32 + 8 * fq, cl0 = wc * 32 + 8 * fq, lane = fr + 16 * fq, wid = wr * 4 + wc;
        PG8_LAS f32x2v* P = (PG8_LAS f32x2v*)(tab + TAB_P);
        if (part_prev) { finalize_stats(tab, wid * 64 + lane, TAB_P2); asm volatile("s_waitcnt lgkmcnt(0)" ::: "memory"); __builtin_amdgcn_s_barrier(); asm volatile("" ::: "memory"); }
#pragma unroll
        for (int ai = 0; ai < 2; ++ai)
#pragma unroll
            for (int m = 0; m < 4; ++m) { const int rloc = ai * HALF + wr * 64 + m * 16 + fr; bf16_t* rowp = V + (size_t)(u.pm * BM + rloc) * ldc + col0; bf16_t* rowo = Vout + (size_t)(u.pm * BM + rloc) * ldc + col0;
                RowStat rs; rs.r = 1.f; rs.nmr = 0.f; if (part_prev) rs = stat_tab(tab, rloc, TAB_P2);
                float sm = 0.f;
#pragma unroll
                for (int bj = 0; bj < 2; ++bj) { const u32x4 bw = *(const u32x4*)(rowp + bj * HALF);
#pragma unroll
                    for (int n = 0; n < 2; ++n) { const unsigned lo = bw[2 * n], hi = bw[2 * n + 1];
                        f32x4 xs = (f32x4){__uint_as_float(lo << 16), __uint_as_float(lo & 0xffff0000u), __uint_as_float(hi << 16), __uint_as_float(hi & 0xffff0000u)};
                        if (part_prev) { const f32x4 gv = *(const PG8_LAS f32x4*)(tab + TAB_CONST + (cl0 + bj * HALF + 4 * n) * 4), bv = *(const PG8_LAS f32x4*)(tab + TAB_CONST + 1024 + (cl0 + bj * HALF + 4 * n) * 4);
                            xs = (xs * rs.r + rs.nmr) * gv + bv; }
                        const f32x4 v = xs * K_ALPHA + acc[ai][bj][m][n]; acc[ai][bj][m][n] = v; sm += (v[0] + v[1]) + (v[2] + v[3]); } }
                sm = sum_fq4(sm);
                const float mw = sm * (1.0f / 64.0f); float q = 0.f;
#pragma unroll
                for (int bj = 0; bj < 2; ++bj)
#pragma unroll
                    for (int n = 0; n < 2; ++n) { const f32x4 d = acc[ai][bj][m][n] - mw; q += (d[0] * d[0] + d[1] * d[1]) + (d[2] * d[2] + d[3] * d[3]); }
                q = sum_fq4(q);
                if (fq == 0) P[rloc * 4 + wc] = (f32x2v){mw, q};
#pragma unroll
                for (int bj = 0; bj < 2; ++bj) { const f32x4 v0 = acc[ai][bj][m][0], v1 = acc[ai][bj][m][1];
                    u32x4 w; w.x = cvt_pk_bf16(v0[0], v0[1]); w.y = cvt_pk_bf16(v0[2], v0[3]); w.z = cvt_pk_bf16(v1[0], v1[1]); w.w = cvt_pk_bf16(v1[2], v1[3]);
                    __builtin_nontemporal_store(w, (u32x4*)(rowo + bj * HALF)); }
                asm volatile("" ::: "memory"); }
        asm volatile("s_waitcnt lgkmcnt(0)" ::: "memory"); __builtin_amdgcn_s_barrier(); asm volatile("" ::: "memory");
        { const int row = wid * 32 + (lane & 31);
          if (lane < 32) { const f32x2v a = P[row * 4 + 0], b = P[row * 4 + 1], c = P[row * 4 + 2], d = P[row * 4 + 3];
            const float mt = (a.x + b.x + c.x + d.x) * 0.25f; const float da = a.x - mt, db = b.x - mt, dc = c.x - mt, dd = d.x - mt;
            const float m2 = (a.y + b.y) + (c.y + d.y) + 64.0f * ((da * da + db * db) + (dc * dc + dd * dd));
            *(f32x2v*)(part_new + (size_t)(u.pm * BM + row) * 8 + 2 * u.pn) = (f32x2v){mt, m2}; } }
    }
};

#define PG8_DPP0(src, ctrl) __builtin_bit_cast(float, __builtin_amdgcn_update_dpp(0, __builtin_bit_cast(int, (float)(src)), (ctrl), 0xf, 0xf, true))
__device__ __forceinline__ f32x2 gelu_mul_pk(f32x2 v, f32x2 u) {
    const f32x2 av = __builtin_elementwise_abs(v), d = av * 0.2316418882f + 1.0f;
    f32x2 t; t.x = __builtin_amdgcn_rcpf(d.x); t.y = __builtin_amdgcn_rcpf(d.y);
    f32x2 q = t * 0.5307027145f + (-0.7265760135f); q = q * t + 0.7107068705f; q = q * t + (-0.142248368f); q = q * t + 0.127414796f; q = q * t;
    const f32x2 s = (v * v) * (-0.72134752044f);
    f32x2 e; e.x = __builtin_amdgcn_exp2f(s.x); e.y = __builtin_amdgcn_exp2f(s.y);
    const f32x2 r = __builtin_elementwise_max(v, (f32x2){0.f, 0.f}) - av * (q * e);
    return r * u;
}
template <int MODE  , bool I8_ = false> struct EpiGluT {
    static constexpr bool PERM = true, AFTER_DRAIN = false, PERM_A = true, I8 = I8_;
    bf16_t* H; const float* cw; const float* cb; float* G0; float* UP0; int dff; int ngrp; const float* part; const float* c1; const float* c0; PG8_LAS unsigned char* tab; const float* sw; const float* sa;
    __device__ __forceinline__ void prefetch(const Unit& u, int wid, int lane) const {
        prefetch_stats(part, u.pm, tab, wid, lane);
        if (wid < 4) { const int v = 2 * wid + (lane >> 5), c4 = (lane & 31) * 4;
            const float* src = (v < 3) ? cw + v * dff : (v == 3) ? cb : (v & 1) ? c0 + ((v - 4) >> 1) * dff : c1 + ((v - 4) >> 1) * dff;
            glds16(src + u.pn * HALF + c4, tab + TAB_CONST + wid * 1024); }
        if (I8_) {
            if (wid == 4) glds16(sw + (lane >> 5) * dff + u.pn * HALF + (lane & 31) * 4, tab + TAB_SW);
            if (wid == 5) glds16(sa + (size_t)u.pm * BM + 4 * lane, tab + TAB_SA); }
    }
    __device__ __forceinline__ void operator()(f32x4 (&acc)[2][2][4][2], const Unit& u, int wr, int wc, int fr, int fq) const {
        const int hc0 = u.pn * HALF + wc * 32 + 8 * fq;
        const PG8_LAS unsigned char* wt_ = tab + TAB_CONST + (wc * 32 + 8 * fq) * 4;
#define PG8_TABV(v_, n_) (*(const PG8_LAS f32x4*)(wt_ + (v_) * 512 + (4 * (n_)) * 4))
        if (MODE == 0 && !I8_) { finalize_stats(tab, (wr * 4 + wc) * 64 + fr + 16 * fq); asm volatile("s_waitcnt lgkmcnt(0)" ::: "memory"); __builtin_amdgcn_s_barrier(); asm volatile("" ::: "memory"); }
        if (MODE == 0 && I8_) { const int tid_ = (wr * 4 + wc) * 64 + fr + 16 * fq;
            if (tid_ < 256) { const RowStat rs = row_stat_lds(tab, tid_, K_EPS); const float sa_ = *(const PG8_LAS float*)(tab + TAB_SA + 4 * tid_); *(PG8_LAS f32x4*)(tab + TAB_R4 + 16 * tid_) = (f32x4){rs.nmr, rs.r, rs.r * sa_, 0.f}; }
            asm volatile("s_waitcnt lgkmcnt(0)" ::: "memory"); __builtin_amdgcn_s_barrier(); asm volatile("" ::: "memory"); }
#pragma unroll
        for (int ai = 0; ai < 2; ++ai) {
            const int tb = u.pm * BM + ai * HALF + wr * 64, grp = tb >> 6;
            if (MODE == 0 && I8_) {
                f32x4 r4[4];
#pragma unroll
                for (int m = 0; m < 4; ++m) r4[m] = *(const PG8_LAS f32x4*)(tab + TAB_R4 + 16 * (ai * HALF + wr * 64 + 4 * fr + m));
#pragma unroll
                for (int bj = 0; bj < 2; ++bj)
#pragma unroll
                    for (int n = 0; n < 2; ++n) { const f32x4 k1 = PG8_TABV(4 + 2 * bj, n), k0 = PG8_TABV(5 + 2 * bj, n), swv = PG8_TABV(8 + bj, n);
#pragma unroll
                        for (int m = 0; m < 4; ++m) { const f32x4 fv = __builtin_convertvector(__builtin_bit_cast(i32x4, acc[ai][bj][m][n]), f32x4);
                            acc[ai][bj][m][n] = fv * (swv * r4[m][2]) + (k1 * r4[m][0] + k0); } }
                asm volatile("" ::: "memory");
            }
            if (MODE == 0 && !I8_) {
                RowStat rs[4];
#pragma unroll
                for (int m = 0; m < 4; ++m) rs[m] = stat_tab(tab, ai * HALF + wr * 64 + 4 * fr + m);
#pragma unroll
                for (int bj = 0; bj < 2; ++bj)
#pragma unroll
                    for (int n = 0; n < 2; ++n) { const f32x4 k1 = PG8_TABV(4 + 2 * bj, n), k0 = PG8_TABV(5 + 2 * bj, n);
#pragma unroll
                        for (int m = 0; m < 4; ++m) acc[ai][bj][m][n] = acc[ai][bj][m][n] * rs[m].r + (k1 * rs[m].nmr + k0); }
                asm volatile("" ::: "memory");
            }
            unsigned hp[4][2];
#pragma unroll
            for (int n = 0; n < 2; ++n) {
                const f32x4 w0 = PG8_TABV(0, n), w1 = PG8_TABV(1, n), w2 = PG8_TABV(2, n), cbv = PG8_TABV(3, n);
#pragma unroll
                for (int m = 0; m < 4; ++m) {
                    const int t = tb + 4 * fr + m; const f32x4 gg = acc[ai][0][m][n], up = acc[ai][1][m][n]; f32x4 hv;
                    if (MODE == 1) { hv = gg * up; } else {
                    f32x4 g1, g2;
                    if (m == 0) {
#pragma unroll
                        for (int e = 0; e < 4; ++e) { g1[e] = PG8_DPP0(acc[ai][0][3][n][e], 0x111); g2[e] = PG8_DPP0(acc[ai][0][2][n][e], 0x111); } }
                    else if (m == 1) { g1 = acc[ai][0][0][n];
#pragma unroll
                        for (int e = 0; e < 4; ++e) g2[e] = PG8_DPP0(acc[ai][0][3][n][e], 0x111); }
                    else { g1 = acc[ai][0][m - 1][n]; g2 = acc[ai][0][m - 2][n]; }
                    const f32x4 cv = cbv + w0 * g2 + w1 * g1 + w2 * gg;
                    const f32x2 a = gelu_mul_pk((f32x2){cv[0], cv[1]}, (f32x2){up[0], up[1]}), b = gelu_mul_pk((f32x2){cv[2], cv[3]}, (f32x2){up[2], up[3]});
                    hv = (f32x4){a.x, a.y, b.x, b.y}; }
                    if (MODE == 0 && fr == 0 && m < 2) {
                        *(f32x4*)(G0 + ((size_t)grp * 4 + 2 + m) * dff + hc0 + 4 * n) = gg; *(f32x4*)(UP0 + ((size_t)grp * 2 + m) * dff + hc0 + 4 * n) = up; }
                    if (MODE == 0 && fr == 15 && m >= 2 && grp + 1 < ngrp)
                        *(f32x4*)(G0 + ((size_t)(grp + 1) * 4 + (m - 2)) * dff + hc0 + 4 * n) = gg;
                    const unsigned p0 = cvt_pk_bf16(hv[0], hv[1]), p1 = cvt_pk_bf16(hv[2], hv[3]);
                    if (n == 0) { hp[m][0] = p0; hp[m][1] = p1; }
                    else if (MODE == 2) { asm volatile("" :: "v"(p0), "v"(p1), "v"(hp[m][0]), "v"(hp[m][1])); }
                    else if (m >= 2 || fr > 0) { u32x4 w; w.x = hp[m][0]; w.y = hp[m][1]; w.z = p0; w.w = p1; __builtin_nontemporal_store(w, (u32x4*)(H + (size_t)t * dff + hc0)); }
                }
            }
            asm volatile("" ::: "memory");
        }
#undef PG8_TABV
    }
};
typedef EpiGluT<0> EpiGlu;
typedef EpiGluT<0, true> EpiGlu8;
struct EpiNull {
    static constexpr bool PERM = true, AFTER_DRAIN = false, PERM_A = false, I8 = false;
    __device__ __forceinline__ void prefetch(const Unit&, int, int) const {}
    __device__ __forceinline__ void operator()(f32x4 (&acc)[2][2][4][2], const Unit& u, int wr, int wc, int fr, int fq) const {
#pragma unroll
        for (int ai = 0; ai < 2; ++ai)
#pragma unroll
            for (int bj = 0; bj < 2; ++bj)
#pragma unroll
                for (int m = 0; m < 4; ++m) asm volatile("" :: "v"(acc[ai][bj][m][0]), "v"(acc[ai][bj][m][1]));
    }
};
template <class Epi, class Sched, bool ALIGN_EPI = false, bool SP2 = false>
__device__ __forceinline__ void gemm_phase(PG8_LAS unsigned char* lds, const Gemm g, const Sched& S, const Epi& E, int tid_in) {
    int tid_ = tid_in; asm volatile("" : "+v"(tid_));
    const int tid = tid_, wid = __builtin_amdgcn_readfirstlane(tid >> 6), lane = tid & 63, wr = wid >> 2, wc = wid & 3, fr = lane & 15, fq = lane >> 4;
    const int K = g.K, nt = K / BK;
    unsigned voffA[2], voffB[2];
#pragma unroll
    for (int i = 0; i < 2; ++i) { int R, C; stage_rc(tid * 16 + i * 8192, R, C); const int Rb = Epi::PERM ? ((R & ~31) + perm32(R & 31)) : R;
        const int Ra = Epi::PERM_A ? ((R & ~63) + 4 * (R & 15) + ((R >> 4) & 3)) : R;
        voffA[i] = (unsigned)(Ra * K + C) * 2u; voffB[i] = (unsigned)(Rb * K + C) * 2u; }
    const size_t kstep = (size_t)(BK * 2);
    const size_t hstep = (size_t)HALF * K * 2;
    const size_t tstep = 2 * hstep;
    const unsigned ldsw = (unsigned)wid * 1024u;
    const int aoff = lds_byte(wr * 64 + fr, fq * 8), boff = lds_byte(wc * 32 + fr, fq * 8);
#define PG8_SA(b, h) (((b) * 2 + (h)) * HTB)
#define PG8_SB(b, h) ((4 + (b) * 2 + (h)) * HTB)
#define PG8_STAGE(bufoff, gbase, voff) do { _Pragma("unroll") for (int _i = 0; _i < 2; ++_i) \
        __builtin_amdgcn_global_load_lds((const unsigned*)((const char*)(gbase) + (voff)[_i]), (PG8_LAS unsigned*)(lds + (bufoff) + ldsw + _i * 8192), 16, 0, 0); } while (0)
#define PG8_LDA(dst, b, h) do { _Pragma("unroll") for (int m = 0; m < 4; ++m) _Pragma("unroll") for (int k = 0; k < 2; ++k) dst[m][k] = *(const PG8_LAS bf16x8*)(lds + PG8_SA(b, h) + aoff + m * 2048 + k * 1024); } while (0)
#define PG8_LDB(dst, b, h) do { _Pragma("unroll") for (int n = 0; n < 2; ++n) _Pragma("unroll") for (int k = 0; k < 2; ++k) dst[n][k] = *(const PG8_LAS bf16x8*)(lds + PG8_SB(b, h) + boff + n * 2048 + k * 1024); } while (0)
#define PG8_MMA(ai, bj, At, Bt) do { __builtin_amdgcn_s_setprio(1); _Pragma("unroll") for (int m = 0; m < 4; ++m) _Pragma("unroll") for (int n = 0; n < 2; ++n) _Pragma("unroll") for (int k = 0; k < 2; ++k) \
        { if constexpr (Epi::I8) acc[ai][bj][m][n] = __builtin_bit_cast(f32x4, __builtin_amdgcn_mfma_i32_16x16x64_i8(__builtin_bit_cast(i32x4, Bt[n][k]), __builtin_bit_cast(i32x4, At[m][k]), __builtin_bit_cast(i32x4, acc[ai][bj][m][n]), 0, 0, 0)); \
          else acc[ai][bj][m][n] = __builtin_amdgcn_mfma_f32_16x16x32_bf16(Bt[n][k], At[m][k], acc[ai][bj][m][n], 0, 0, 0); } __builtin_amdgcn_s_setprio(0); } while (0)
#define PG8_WAIT_V(n) asm volatile("s_waitcnt vmcnt(" #n ")" ::: "memory")
#define PG8_WAIT_L(n) asm volatile("s_waitcnt lgkmcnt(" #n ")" ::: "memory")
#define PG8_BAR __builtin_amdgcn_s_barrier()
#define PG8_SCHED __builtin_amdgcn_sched_barrier(0)
    Unit cur, nxt; int ui = 0;
    if (!S.next(0, cur)) return;
    f32x4 acc[2][2][4][2];
    bf16x8 At[4][2], B0[2][2], B1[2][2];
    const char* cA = (const char*)g.A + (size_t)cur.pm * tstep; const char* cB = (const char*)g.Bt + (size_t)cur.pn * tstep;
    S.a_ready(cur);
    if constexpr (SP2) {
        PG8_STAGE(PG8_SB(0, 0), cB, voffB); PG8_STAGE(PG8_SB(0, 1), cB + hstep, voffB); PG8_STAGE(PG8_SA(0, 0), cA, voffA); PG8_STAGE(PG8_SA(0, 1), cA + hstep, voffA);
        if (wr == 1) PG8_BAR;
        PG8_WAIT_V(2); PG8_BAR;
        PG8_STAGE(PG8_SB(1, 0), cB + kstep, voffB); PG8_STAGE(PG8_SA(1, 0), cA + kstep, voffA); PG8_STAGE(PG8_SB(1, 1), cB + hstep + kstep, voffB);
        PG8_WAIT_V(6); PG8_BAR;
    } else {
        PG8_STAGE(PG8_SB(0, 0), cB, voffB); PG8_STAGE(PG8_SA(0, 0), cA, voffA); PG8_STAGE(PG8_SB(0, 1), cB + hstep, voffB); PG8_STAGE(PG8_SA(0, 1), cA + hstep, voffA);
        if (wr == 1) PG8_BAR;
        PG8_WAIT_V(4); PG8_BAR;
        PG8_STAGE(PG8_SB(1, 0), cB + kstep, voffB); PG8_STAGE(PG8_SA(1, 0), cA + kstep, voffA); PG8_STAGE(PG8_SB(1, 1), cB + hstep + kstep, voffB);
        PG8_WAIT_V(6); PG8_BAR;
    }
#pragma unroll
    for (int a = 0; a < 2; ++a)
#pragma unroll
        for (int b = 0; b < 2; ++b)
#pragma unroll
            for (int m = 0; m < 4; ++m)
#pragma unroll
                for (int n = 0; n < 2; ++n) acc[a][b][m][n] = (f32x4){0.f, 0.f, 0.f, 0.f};
    for (;;) {
        const bool has_next = S.next(ui + 1, nxt);
        const char* nA = has_next ? (const char*)g.A + (size_t)nxt.pm * tstep : cA; const char* nB = has_next ? (const char*)g.Bt + (size_t)nxt.pn * tstep : cB;
        { PG8_BAR; int ln_ = (int)__builtin_amdgcn_mbcnt_hi(~0u, __builtin_amdgcn_mbcnt_lo(~0u, 0u)); asm volatile("" : "+v"(ln_)); E.prefetch(cur, wid, ln_); }
        for (int t = 0; t < nt; t += 2) {
            const bool last = (t == nt - 2);
            const char* a1 = cA + (size_t)(t + 1) * kstep;
            const char* a2 = last ? nA : cA + (size_t)(t + 2) * kstep; const char* b2 = last ? nB : cB + (size_t)(t + 2) * kstep;
            const char* a3 = a2 + kstep; const char* b3 = b2 + kstep;
            if (last && has_next) S.a_ready(nxt);
            if constexpr (SP2) {
            PG8_LDB(B0, 0, 0); PG8_LDB(B1, 0, 1); PG8_SCHED; PG8_LDA(At, 0, 0); PG8_STAGE(PG8_SA(1, 1), a1 + hstep, voffA);
            PG8_WAIT_V(8); PG8_WAIT_L(0); PG8_BAR; PG8_MMA(0, 0, At, B0); PG8_MMA(0, 1, At, B1); PG8_BAR; PG8_SCHED;
            PG8_LDA(At, 0, 1); PG8_STAGE(PG8_SB(0, 0), b2, voffB); PG8_STAGE(PG8_SB(0, 1), b2 + hstep, voffB); PG8_STAGE(PG8_SA(0, 0), a2, voffA);
            PG8_WAIT_V(8); PG8_WAIT_L(0); PG8_BAR; PG8_MMA(1, 0, At, B0); PG8_MMA(1, 1, At, B1); PG8_BAR; PG8_SCHED;
            PG8_LDB(B0, 1, 0); PG8_LDB(B1, 1, 1); PG8_SCHED; PG8_LDA(At, 1, 0); PG8_STAGE(PG8_SA(0, 1), a2 + hstep, voffA);
            PG8_WAIT_V(8); PG8_WAIT_L(0); PG8_BAR; PG8_MMA(0, 0, At, B0); PG8_MMA(0, 1, At, B1); PG8_BAR; PG8_SCHED;
            PG8_LDA(At, 1, 1); PG8_STAGE(PG8_SB(1, 0), b3, voffB); PG8_STAGE(PG8_SB(1, 1), b3 + hstep, voffB); PG8_STAGE(PG8_SA(1, 0), a3, voffA);
            PG8_WAIT_V(8); PG8_WAIT_L(0); PG8_BAR; PG8_MMA(1, 0, At, B0); PG8_MMA(1, 1, At, B1); PG8_BAR; PG8_SCHED;
            } else {
            PG8_LDB(B0, 0, 0); PG8_SCHED; PG8_LDA(At, 0, 0); PG8_STAGE(PG8_SA(1, 1), a1 + hstep, voffA);
            PG8_WAIT_L(8); PG8_BAR; PG8_WAIT_L(0); PG8_MMA(0, 0, At, B0); PG8_BAR; PG8_SCHED;
            PG8_LDB(B1, 0, 1); PG8_STAGE(PG8_SB(0, 0), b2, voffB);
            PG8_BAR; PG8_WAIT_L(0); PG8_MMA(0, 1, At, B1); PG8_BAR;
            PG8_LDA(At, 0, 1); PG8_STAGE(PG8_SA(0, 0), a2, voffA);
            PG8_BAR; PG8_WAIT_L(0); PG8_MMA(1, 0, At, B0); PG8_BAR; PG8_SCHED;
            PG8_STAGE(PG8_SB(0, 1), b2 + hstep, voffB);
            PG8_WAIT_V(6); PG8_BAR; PG8_MMA(1, 1, At, B1); PG8_BAR;
            PG8_LDB(B0, 1, 0); PG8_SCHED; PG8_LDA(At, 1, 0); PG8_STAGE(PG8_SA(0, 1), a2 + hstep, voffA);
            PG8_WAIT_L(8); PG8_BAR; PG8_WAIT_L(0); PG8_MMA(0, 0, At, B0); PG8_BAR; PG8_SCHED;
            PG8_LDB(B1, 1, 1); PG8_STAGE(PG8_SB(1, 0), b3, voffB);
            PG8_BAR; PG8_WAIT_L(0); PG8_MMA(0, 1, At, B1); PG8_BAR;
            PG8_LDA(At, 1, 1); PG8_STAGE(PG8_SA(1, 0), a3, voffA);
            PG8_BAR; PG8_WAIT_L(0); PG8_MMA(1, 0, At, B0); PG8_BAR; PG8_SCHED;
            PG8_STAGE(PG8_SB(1, 1), b3 + hstep, voffB);
            PG8_WAIT_V(6); PG8_BAR; PG8_MMA(1, 1, At, B1); PG8_BAR;
            }
        }
        if constexpr (ALIGN_EPI) { if (wr == 0) PG8_BAR; }
        if constexpr (!Epi::AFTER_DRAIN) { int ln_ = (int)__builtin_amdgcn_mbcnt_hi(~0u, __builtin_amdgcn_mbcnt_lo(~0u, 0u)); asm volatile("" : "+v"(ln_));
            E(acc, cur, wr, wc, ln_ & 15, ln_ >> 4); S.done(cur); }
        if (!has_next) break;
#pragma unroll
        for (int a = 0; a < 2; ++a)
#pragma unroll
            for (int b = 0; b < 2; ++b)
#pragma unroll
                for (int m = 0; m < 4; ++m)
#pragma unroll
                    for (int n = 0; n < 2; ++n) acc[a][b][m][n] = (f32x4){0.f, 0.f, 0.f, 0.f};
        cur = nxt; cA = nA; cB = nB; ++ui;
        if constexpr (ALIGN_EPI) { if (wr == 1) PG8_BAR; }
    }
    PG8_WAIT_V(0);
    if constexpr (!ALIGN_EPI) { if (wr == 0) PG8_BAR; }
    PG8_BAR;
    if constexpr (Epi::AFTER_DRAIN) { E.fused(acc, cur, wr, wc, fr, fq, lds, wid, lane); S.done(cur); }
#undef PG8_SA
#undef PG8_SB
#undef PG8_STAGE
#undef PG8_LDA
#undef PG8_LDB
#undef PG8_MMA
#undef PG8_WAIT_V
#undef PG8_WAIT_L
#undef PG8_BAR
#undef PG8_SCHED
}
}
#define GAS __attribute__((address_space(1)))
#define LAS __attribute__((address_space(3)))
typedef unsigned short bf16;
typedef unsigned v4u __attribute__((ext_vector_type(4)));
typedef float f32x4 __attribute__((ext_vector_type(4)));
typedef short bf16x8 __attribute__((ext_vector_type(8)));
typedef GAS unsigned gu32;
typedef GAS unsigned long long gu64;
#define RLX_AGENT __ATOMIC_RELAXED, __HIP_MEMORY_SCOPE_AGENT
#define LDS_WAIT() asm volatile("s_waitcnt lgkmcnt(0)" ::: "memory")
#define VM_WAIT() asm volatile("s_waitcnt vmcnt(0)" ::: "memory")
__device__ __forceinline__ unsigned long long rt() { return __builtin_amdgcn_s_memrealtime(); }

#define XB_TMO      128
#define XB_XCNT(j)  (256  + 64 * (j))
#define XB_XSUB(j)  (1280 + 64 * (j))
#define XB_XGEN(j)  (2304 + 64 * (j))
#define XB_TOP      3328
#define XB_TOPGEN   3392
#define XCD_BAR_WORDS 3456
#define XB_SPIN_CAP (1u << 18)

__device__ __forceinline__ unsigned xb_ld(unsigned* p)              { return __hip_atomic_load(p, __ATOMIC_RELAXED, __HIP_MEMORY_SCOPE_AGENT); }
__device__ __forceinline__ unsigned xb_add(unsigned* p, unsigned v) { return __hip_atomic_fetch_add(p, v, __ATOMIC_RELAXED, __HIP_MEMORY_SCOPE_AGENT); }
__device__ __forceinline__ unsigned xb_xcc_id() { return (unsigned)__builtin_amdgcn_s_getreg((3 << 11) | 20) & 0xFu; }
#define XB_SPIN(cond, bar) do { unsigned _sp = 0; while (cond) { __builtin_amdgcn_s_sleep(1); \
    if ((++_sp & 255u) == 0u) { if (xb_ld(&(bar)[XB_TMO])) break; if (_sp > XB_SPIN_CAP) { atomicAdd(&(bar)[XB_TMO], 1u); break; } } } } while (0)

struct XcdBarrier {
    unsigned* bar; unsigned x;
    volatile LAS unsigned* st;
};

__device__ __forceinline__ XcdBarrier xcd_barrier_post(unsigned* bar, volatile LAS unsigned* st) {
    XcdBarrier b; b.bar = bar; b.x = xb_xcc_id(); b.st = st;
    if (threadIdx.x == 0) (void)xb_add(&bar[XB_XCNT(b.x)], 1u);
    return b;
}
__device__ __forceinline__ void xcd_barrier_complete(unsigned* bar, unsigned x, unsigned& nloc, unsigned& nx) {
    const unsigned G = gridDim.x * gridDim.y * gridDim.z;
    unsigned sum, cnt, mine, sp = 0u;
    for (;;) {
        sum = 0u; cnt = 0u; mine = 0u;
#pragma unroll
        for (unsigned j = 0; j < 16; ++j) { const unsigned c = xb_ld(&bar[XB_XCNT(j)]); sum += c; cnt += (c > 0u) ? 1u : 0u; mine = (j == x) ? c : mine; }
        if (sum == G) break;
        __builtin_amdgcn_s_sleep(1);
        if ((++sp & 255u) == 0u) { if (xb_ld(&bar[XB_TMO])) break; if (sp > XB_SPIN_CAP) { atomicAdd(&bar[XB_TMO], 1u); break; } }
    }
    nloc = mine > 0u ? mine : 1u; nx = cnt > 0u ? cnt : 1u;
}

__device__ __forceinline__ void xcd_barrier(const XcdBarrier& b, bool leader_thread) {
    asm volatile("s_waitcnt vmcnt(0)" ::: "memory");
    __syncthreads();
    if (leader_thread) {
        unsigned* bar = b.bar;
        __builtin_amdgcn_s_waitcnt(0);
        unsigned nloc = b.st[0], nx = b.st[1];
        if (nloc == 0u) { xcd_barrier_complete(bar, b.x, nloc, nx); b.st[0] = nloc; b.st[1] = nx; }
        const unsigned old = xb_add(&bar[XB_XSUB(b.x)], 1u);
        const unsigned gen = old / nloc;
        if (old + 1u == (gen + 1u) * nloc) {
            __builtin_amdgcn_fence(__ATOMIC_RELEASE, "agent");
            asm volatile("s_waitcnt vmcnt(0)" ::: "memory");
            const unsigned og = xb_add(&bar[XB_TOP], 1u);
            const unsigned tg = og / nx;
            if (og + 1u == (tg + 1u) * nx) xb_add(&bar[XB_TOPGEN], 1u);
            else XB_SPIN(xb_ld(&bar[XB_TOPGEN]) == tg, bar);
            __builtin_amdgcn_fence(__ATOMIC_ACQUIRE, "agent");
            xb_add(&bar[XB_XGEN(b.x)], 1u);
            asm volatile("s_waitcnt vmcnt(0)" ::: "memory");
        } else {
            XB_SPIN(xb_ld(&bar[XB_XGEN(b.x)]) == gen, bar);
            __builtin_amdgcn_fence(__ATOMIC_ACQUIRE, "agent");
            asm volatile("s_waitcnt vmcnt(0)" ::: "memory");
        }
    }
    __syncthreads();
}

constexpr int NWAVES = 8;
constexpr size_t WS_CTL = 420 * MiB, CTL_ZERO_BYTES = 64 * 1024;
constexpr size_t WS_XCH = 421 * MiB;
constexpr size_t WS_PARTA = WS_XCH, WS_PARTB = WS_XCH + 1 * MiB, WS_CV = WS_XCH + 2 * MiB, WS_CPART = WS_CV + 256 * 1024;
constexpr int CV_IN1 = 0, CV_UP0 = 2 * 2576, CV_UP1 = CV_UP0 + 2 * 5632, CV_END = CV_UP1 + 2 * 5632;
constexpr int CP_IN1 = 0, CP_UP0 = 16 * 2 * 2576, CP_UP1 = CP_UP0 + 16 * 2 * 5632, CP_END = CP_UP1 + 16 * 2 * 5632;
static_assert(CV_END * 4 <= 256 * 1024 && WS_CPART + (size_t)CP_END * 4 <= WS_XCH + 4 * MiB, "deferred-LN map");
constexpr size_t WS_G0 = 425 * MiB;
constexpr size_t WS_UP0 = 447 * MiB;
constexpr size_t WS_WT = 458 * MiB;
constexpr size_t WT_IN = 0, WT_G = (size_t)2560 * 1024 * 2, WT_OUT = WT_G + 16 * 1024 * 2, WT_UP = WT_OUT + (size_t)1024 * 1024 * 2, WT_DN = WT_UP + (size_t)5632 * 1024 * 2, WT_LAYER = WT_DN + (size_t)1024 * 2816 * 2;
constexpr size_t WS_W8 = 302 * MiB, WS_SWC = 314 * MiB, WS_V8 = 320 * MiB, WS_SA = 353 * MiB;
constexpr size_t WS_MST = 289 * MiB;
static_assert(WS_WT + 2 * WT_LAYER <= 512 * MiB, "ws map");
constexpr int CW_TMO = 0, CW_CODE = 1, CW_BAR = 4096, CW_SEAM = 16384, SEAM_BANK = 128 * 64;
constexpr int MX_TAB = 131072 + 512;
constexpr int RING_OFF = 0, RING_BYTES = 131072, LDSCTL_OFF = RING_BYTES, MISC_OFF = LDSCTL_OFF + 320, LDS_BYTES = 163840;
constexpr int NPHASE = 18;

struct Frame {
    LAS unsigned char* lds; volatile LAS unsigned* MISC; gu32* ctl; unsigned char* ws; int tid, lane, wave, vcu, G;
};
constexpr int PT_OFF = LDSCTL_OFF + 64;
#define INP(i) inptr(F, (i))
__device__ __forceinline__ const float* inptr(const Frame& F, int i) {
    const volatile LAS unsigned* p = (const volatile LAS unsigned*)(F.lds + PT_OFF) + 2 * i;
    const unsigned lo = __builtin_amdgcn_readfirstlane(p[0]), hi = __builtin_amdgcn_readfirstlane(p[1]);
    return (const float*)(const GAS float*)(((unsigned long long)hi << 32) | lo);
}
struct Args { const float* in[20]; float* out; unsigned char* ws; int ph_lo, ph_hi, bar_region, pad; };

__device__ __forceinline__ unsigned pk2(float lo, float hi) { return f2bf(lo) | ((unsigned)f2bf(hi) << 16); }

__device__ __forceinline__ void p0_transpose_item(const float* W, int K, int N, bf16* WT, int k0, int n0, int drow0, LAS float* scr, int lane, const float* gs, const float* bs, float* cp1, float* cp0) {
    float tv[32];
#pragma unroll
    for (int i = 0; i < 32; ++i) { const int kk = 2 * i + (lane >> 5); tv[i] = W[(size_t)(k0 + kk) * N + n0 + (lane & 31)]; }
    if (gs) {
        float s1 = 0.f, s0 = 0.f;
#pragma unroll
        for (int i = 0; i < 32; ++i) { const int kk = 2 * i + (lane >> 5); const float gk = gs[k0 + kk], bk = bs[k0 + kk]; s0 = __builtin_fmaf(bk, tv[i], s0); tv[i] *= gk; s1 += tv[i]; }
        s1 += __shfl_xor(s1, 32); s0 += __shfl_xor(s0, 32);
        if (lane < 32) { cp1[n0 + lane] = s1; cp0[n0 + lane] = s0; }
    }
#pragma unroll
    for (int i = 0; i < 32; ++i) { const int kk = 2 * i + (lane >> 5); scr[kk * 33 + (lane & 31)] = tv[i]; }
    LDS_WAIT(); asm volatile("" ::: "memory");
    const int c = lane & 7;
#pragma unroll
    for (int j = 0; j < 4; ++j) { const int n = (lane >> 3) + 8 * j; const LAS float* s = scr + (8 * c) * 33 + n;
        v4u o; o.x = pk2(s[0 * 33], s[1 * 33]); o.y = pk2(s[2 * 33], s[3 * 33]); o.z = pk2(s[4 * 33], s[5 * 33]); o.w = pk2(s[6 * 33], s[7 * 33]);
        *(GAS v4u*)(WT + (size_t)(drow0 + n) * K + k0 + 8 * c) = o; }
    LDS_WAIT(); asm volatile("" ::: "memory");
}

__device__ __forceinline__ void p0_prologue(Frame& F, const Args& a) {
    LAS float* scr = (LAS float*)(F.lds + RING_OFF + F.wave * 16384);
    const int gw = F.vcu * NWAVES + F.wave, NGW = F.G * NWAVES;
    constexpr int I_IN = 16 * 80, I_OUT = 16 * 32, I_UP = 16 * 176, I_DN = 44 * 32, I_LAYER = I_IN + I_OUT + I_UP + I_DN;
    for (int it = gw; it < DEPTH * I_LAYER; it += NGW) {
        const int l = it / I_LAYER; int r = it % I_LAYER; unsigned char* wt = F.ws + WS_WT + (size_t)l * WT_LAYER;
        float* cpart = (float*)(F.ws + WS_CPART);
        if (r < I_IN) { const int kb = r / 80, nb = r % 80; const bool sc = l > 0;
            p0_transpose_item(INP(1) + (size_t)l * DM * DIN, DM, DIN, (bf16*)(wt + WT_IN), 64 * kb, 32 * nb, 32 * nb, scr, F.lane, sc ? INP(18) + (l - 1) * DM : nullptr, sc ? INP(19) + (l - 1) * DM : nullptr,
                              cpart + CP_IN1 + kb * 2 * 2576, cpart + CP_IN1 + kb * 2 * 2576 + 2576); continue; } r -= I_IN;
        if (r < I_OUT) { const int kb = r / 32, nb = r % 32; p0_transpose_item(INP(11) + (size_t)l * DM * DM, DM, DM, (bf16*)(wt + WT_OUT), 64 * kb, 32 * nb, 32 * nb, scr, F.lane, nullptr, nullptr, nullptr, nullptr); continue; } r -= I_OUT;
        if (r < I_UP) { const int kb = r / 176, nb = r % 176, n0 = 32 * nb; const int isup = n0 >= DFF, c = isup ? n0 - DFF : n0; const int drow = (c >> 7) * 256 + isup * 128 + (c & 127);
            float* cp = cpart + (l == 0 ? CP_UP0 : CP_UP1) + kb * 2 * 5632;
            p0_transpose_item(INP(14) + (size_t)l * DM * 2 * DFF, DM, 2 * DFF, (bf16*)(wt + WT_UP), 64 * kb, n0, drow, scr, F.lane, INP(12) + l * DM, INP(13) + l * DM, cp, cp + 5632); continue; } r -= I_UP;
        { const int kb = r / 32, nb = r % 32; p0_transpose_item(INP(17) + (size_t)l * DFF * DM, DFF, DM, (bf16*)(wt + WT_DN), 64 * kb, 32 * nb, 32 * nb, scr, F.lane, nullptr, nullptr, nullptr, nullptr); }
    }
    for (int i = gw * 64 + F.lane; i < DEPTH * 16 * DM; i += NGW * 64) { const int l = i / (16 * DM), j = (i / DM) % 16, k = i % DM;
        float v = j < 8 ? INP(1)[(size_t)l * DM * DIN + (size_t)k * DIN + ZW + j] : 0.f; if (l > 0) v *= INP(18)[(l - 1) * DM + k];
        ((bf16*)(F.ws + WS_WT + (size_t)l * WT_LAYER + WT_G))[j * DM + k] = f2bf(v); }
    for (int j = gw; j < 8; j += NGW) { float s1 = 0.f, s0 = 0.f;
        for (int k = F.lane; k < DM; k += 64) { const float wv = INP(1)[(size_t)1 * DM * DIN + (size_t)k * DIN + ZW + j]; s1 = __builtin_fmaf(INP(18)[k], wv, s1); s0 = __builtin_fmaf(INP(19)[k], wv, s0); }
#pragma unroll
        for (int o = 1; o < 64; o <<= 1) { s1 += __shfl_xor(s1, o); s0 += __shfl_xor(s0, o); }
        if (F.lane == 0) { float* cv = (float*)(F.ws + WS_CV); cv[CV_IN1 + ZW + j] = s1; cv[CV_IN1 + 2576 + ZW + j] = s0; } }
    const float* x = INP(0); bf16* XN = (bf16*)(F.ws + WS_XN);
    for (size_t i0 = (size_t)gw * 64 + F.lane; i0 < (size_t)M * DM / 8; i0 += (size_t)NGW * 64 * 4) {
        f32x4 v0[4], v1[4];
#pragma unroll
        for (int q = 0; q < 4; ++q) { const size_t i = i0 + (size_t)q * NGW * 64; v0[q] = *(const GAS f32x4*)(x + i * 8); v1[q] = *(const GAS f32x4*)(x + i * 8 + 4); }
#pragma unroll
        for (int q = 0; q < 4; ++q) { const size_t i = i0 + (size_t)q * NGW * 64;
            v4u o; o.x = pk2(v0[q][0], v0[q][1]); o.y = pk2(v0[q][2], v0[q][3]); o.z = pk2(v1[q][0], v1[q][1]); o.w = pk2(v1[q][2], v1[q][3]);
            *(GAS v4u*)(XN + i * 8) = o; } }
}

__device__ __forceinline__ void cvec_finalize(Frame& F, const Args& a) {
    const float* cp = (const float*)(F.ws + WS_CPART); float* cv = (float*)(F.ws + WS_CV);
    const int gt = (F.vcu * NWAVES + F.wave) * 64 + F.lane, NT = F.G * NWAVES * 64;
    for (int i = gt; i < 2 * ZW + 4 * 5632; i += NT) {
        int src, dst, stride, idx = i;
        if (idx < 2 * ZW) { const int v = idx / ZW, n = idx % ZW; src = CP_IN1 + v * 2576 + n; dst = CV_IN1 + v * 2576 + n; stride = 2 * 2576; }
        else { idx -= 2 * ZW; const int m = idx / (2 * 5632), e = idx % (2 * 5632); src = (m ? CP_UP1 : CP_UP0) + e; dst = (m ? CV_UP1 : CV_UP0) + e; stride = 2 * 5632; }
        float sacc = 0.f;
#pragma unroll
        for (int kb = 0; kb < 16; ++kb) sacc += cp[src + kb * stride];
        cv[dst] = sacc; }
}
__device__ __forceinline__ float wave_max(float x) {
#pragma unroll
    for (int o = 32; o > 0; o >>= 1) x = fmaxf(x, __shfl_xor(x, o)); return x; }
__device__ __forceinline__ int wave_isum(int x) {
#pragma unroll
    for (int o = 32; o > 0; o >>= 1) x += __shfl_xor(x, o); return x; }
__device__ __forceinline__ void quant_unpack(const v4u a, const v4u b, float (&x)[16]) {
#pragma unroll
    for (int e = 0; e < 4; ++e) { x[2 * e] = __uint_as_float(a[e] << 16); x[2 * e + 1] = __uint_as_float(a[e] & 0xffff0000u); x[8 + 2 * e] = __uint_as_float(b[e] << 16); x[8 + 2 * e + 1] = __uint_as_float(b[e] & 0xffff0000u); }
}
__device__ __forceinline__ float quant_row16(const float (&x)[16], unsigned (&q8)[4], int& isum) {
    float am = 0.f;
#pragma unroll
    for (int e = 0; e < 16; ++e) am = fmaxf(am, fabsf(x[e]));
    am = wave_max(am);
    const float inv = am > 0.f ? 127.0f / am : 0.f;
    isum = 0;
#pragma unroll
    for (int j = 0; j < 4; ++j) { unsigned w = 0u;
#pragma unroll
        for (int e = 0; e < 4; ++e) { const int q = (int)__builtin_rintf(x[4 * j + e] * inv); isum += q; w |= ((unsigned)q & 0xffu) << (8 * e); }
        q8[j] = w; }
    return am * (1.0f / 127.0f);
}
typedef unsigned v2u __attribute__((ext_vector_type(2)));
__device__ __forceinline__ void quant_w_step(Frame& F) {
    const int gw = F.vcu * NWAVES + F.wave, NGW = F.G * NWAVES, lane = F.lane;
    for (int rr = gw; rr < DEPTH * 2 * DFF; rr += NGW) {
        const int l = rr / (2 * DFF), n = rr % (2 * DFF);
        const bf16* src = (const bf16*)(F.ws + WS_WT + (size_t)l * WT_LAYER + WT_UP) + (size_t)n * DM;
        const v4u a = *(const GAS v4u*)(src + 8 * lane), b = *(const GAS v4u*)(src + 512 + 8 * lane);
        float x[16]; quant_unpack(a, b, x);
        unsigned q8[4]; int isum; const float sc = quant_row16(x, q8, isum);
        isum = wave_isum(isum);
        unsigned char* dst = F.ws + WS_W8 + ((size_t)l * 2 * DFF + n) * DM;
        *(GAS v2u*)(dst + 8 * lane) = (v2u){q8[0], q8[1]}; *(GAS v2u*)(dst + 512 + 8 * lane) = (v2u){q8[2], q8[3]};
        if (lane == 0) { float* swc = (float*)(F.ws + WS_SWC) + (size_t)l * 4 * DFF; const int idx = ((n & 255) >= 128 ? DFF : 0) + 128 * (n >> 8) + (n & 127);
            swc[idx] = sc; swc[2 * DFF + idx] = sc * (float)isum; }
    }
}
__device__ __forceinline__ void quant_a_phase(Frame& F, const bf16* V) {
    const int gw = F.vcu * NWAVES + F.wave, NGW = F.G * NWAVES, lane = F.lane;
    unsigned char* V8 = F.ws + WS_V8; float* SA = (float*)(F.ws + WS_SA);
    for (int m0 = gw * 4; m0 < M; m0 += NGW * 4) {
        v4u a[4], b[4];
#pragma unroll
        for (int q = 0; q < 4; ++q) { const bf16* src = V + (size_t)(m0 + q) * DM; a[q] = *(const GAS v4u*)(src + 8 * lane); b[q] = *(const GAS v4u*)(src + 512 + 8 * lane); }
#pragma unroll
        for (int q = 0; q < 4; ++q) { float x[16]; quant_unpack(a[q], b[q], x);
            unsigned q8[4]; int isum; const float sc = quant_row16(x, q8, isum);
            unsigned char* dst = V8 + (size_t)(m0 + q) * DM;
            *(GAS v2u*)(dst + 8 * lane) = (v2u){q8[0], q8[1]}; *(GAS v2u*)(dst + 512 + 8 * lane) = (v2u){q8[2], q8[3]};
            if (lane == 0) SA[m0 + q] = sc; }
    }
}
__device__ __forceinline__ void gates_phase(Frame& F, const bf16* XN, const bf16* WG, float* GT, const float* part, const float* c1, const float* c0) {
    const int gw = F.vcu * NWAVES + F.wave, NGW = F.G * NWAVES, l15 = F.lane & 15, lq = F.lane >> 4;
    for (int blk = gw; blk < M / 16; blk += NGW) {
        const bf16* ap = XN + (size_t)(blk * 16 + l15) * DM + 8 * lq; const bf16* bp = WG + (size_t)l15 * DM + 8 * lq;
        f32x4 acc = (f32x4){0.f, 0.f, 0.f, 0.f};
#pragma unroll 16
        for (int ks = 0; ks < DM / 32; ++ks) { const bf16x8 av = *(const GAS bf16x8*)(ap + ks * 32), bv = *(const GAS bf16x8*)(bp + ks * 32);
            acc = __builtin_amdgcn_mfma_f32_16x16x32_bf16(av, bv, acc, 0, 0, 0); }
        if (l15 < 8) {
            float k1 = 0.f, k0 = 0.f; if (part) { k1 = c1[l15]; k0 = c0[l15]; }
#pragma unroll
            for (int r = 0; r < 4; ++r) { const size_t row = (size_t)(blk * 16 + 4 * lq + r); float v = acc[r];
                if (part) { const pg8::RowStat rs = pg8::row_stat(part, row, LN_EPS); v = v * rs.r + (k1 * rs.nmr + k0); }
                GT[row * 8 + l15] = v; } }
    }
}

__device__ __forceinline__ void glu_fixup_phase(Frame& F, const float* G0, const float* UP0, const float* cw, const float* cb, bf16* H) {
    const int gt = (F.vcu * NWAVES + F.wave) * 64 + F.lane, NT = F.G * NWAVES * 64;
    constexpr int C4 = DFF / 4, NIT = (M / 64) * 2 * C4;
    for (int i0 = gt; i0 < NIT; i0 += 2 * NT) {
        f32x4 s0[2], s1[2], s2[2], up[2], w0[2], w1[2], w2[2], bb[2]; int rr[2], gg[2], cc[2]; bool ok[2];
#pragma unroll
        for (int q = 0; q < 2; ++q) { const int i = i0 + q * NT; ok[q] = i < NIT; const int ii = ok[q] ? i : gt;
            const int c = (ii % C4) * 4, r = (ii / C4) & 1, grp = ii / (2 * C4); rr[q] = r; gg[q] = grp; cc[q] = c;
            const float* gp = G0 + ((size_t)grp * 4 + r) * DFF + c;
            s0[q] = *(const GAS f32x4*)gp; s1[q] = *(const GAS f32x4*)(gp + DFF); s2[q] = *(const GAS f32x4*)(gp + 2 * DFF);
            up[q] = *(const GAS f32x4*)(UP0 + ((size_t)grp * 2 + r) * DFF + c);
            w0[q] = *(const GAS f32x4*)(cw + c); w1[q] = *(const GAS f32x4*)(cw + DFF + c); w2[q] = *(const GAS f32x4*)(cw + 2 * DFF + c); bb[q] = *(const GAS f32x4*)(cb + c); }
#pragma unroll
        for (int q = 0; q < 2; ++q) { if (!ok[q]) continue;
            const bool bs = (gg[q] & (SEQ / 64 - 1)) == 0;
            const f32x4 z = (f32x4){0.f, 0.f, 0.f, 0.f}; const f32x4 a0 = bs ? z : s0[q], a1 = (bs && rr[q] == 0) ? z : s1[q];
            const f32x4 cv = bb[q] + w0[q] * a0 + w1[q] * a1 + w2[q] * s2[q];
            const pg8::f32x2 ha = pg8::gelu_mul_pk((pg8::f32x2){cv[0], cv[1]}, (pg8::f32x2){up[q][0], up[q][1]}), hb = pg8::gelu_mul_pk((pg8::f32x2){cv[2], cv[3]}, (pg8::f32x2){up[q][2], up[q][3]});
            unsigned long long o = (unsigned long long)pg8::cvt_pk_bf16(ha.x, ha.y) | ((unsigned long long)pg8::cvt_pk_bf16(hb.x, hb.y) << 32);
            *(GAS unsigned long long*)(H + (size_t)(gg[q] * 64 + rr[q]) * DFF + cc[q]) = o; }
    }
}

struct SameTileOrder {
    int n, pm0, pn0;
    __device__ bool next(int i, pg8::Unit& u) const { if (i >= n) return false; u.pm = pm0; u.pn = pn0; return true; }
    __device__ __forceinline__ void a_ready(const pg8::Unit&) const {}
    __device__ __forceinline__ void done(const pg8::Unit&) const {}
};
struct OneUnit {
    int pm, pn;
    __device__ bool next(int i, pg8::Unit& u) const { if (i != 0) return false; u.pm = pm; u.pn = pn; return true; }
    __device__ __forceinline__ void a_ready(const pg8::Unit&) const {}
    __device__ __forceinline__ void done(const pg8::Unit&) const {}
};

__device__ __forceinline__ void res_gemm_phase(Frame& F, const bf16* A, const bf16* Bt, int K, bf16* V, bf16* Vout, const float* part_prev, const float* gp, const float* bp, float* part_new) {
    pg8::Gemm gm{A, Bt, M, DM, K}; pg8::StaticOrder S; S.init(M, DM, F.G, (int)blockIdx.x);
    pg8::EpiRes E{V, Vout, DM, part_prev, gp, bp, part_new, F.lds + MX_TAB};
    pg8::gemm_phase<pg8::EpiRes, pg8::StaticOrder, true, true>(F.lds + RING_OFF, gm, S, E, F.tid);
}
__device__ __forceinline__ void final_ln_phase(Frame& F, const bf16* V, const float* part, const float* g, const float* b, float* out) {
    const int gw = F.vcu * NWAVES + F.wave, NGW = F.G * NWAVES;
    f32x4 gv[4], bv[4];
#pragma unroll
    for (int j = 0; j < 4; ++j) { gv[j] = *(const GAS f32x4*)(g + 256 * j + 4 * F.lane); bv[j] = *(const GAS f32x4*)(b + 256 * j + 4 * F.lane); }
    for (int m0 = gw * 4; m0 < M; m0 += NGW * 4) {
        unsigned long long w[4][4]; pg8::RowStat rs[4];
#pragma unroll
        for (int q = 0; q < 4; ++q) { rs[q] = pg8::row_stat(part, (size_t)(m0 + q), LN_EPS);
#pragma unroll
            for (int j = 0; j < 4; ++j) w[q][j] = *(const GAS unsigned long long*)(V + (size_t)(m0 + q) * DM + 256 * j + 4 * F.lane); }
#pragma unroll
        for (int q = 0; q < 4; ++q)
#pragma unroll
            for (int j = 0; j < 4; ++j) { const unsigned lo = (unsigned)w[q][j], hi = (unsigned)(w[q][j] >> 32);
                f32x4 x = (f32x4){__uint_as_float(lo << 16), __uint_as_float(lo & 0xffff0000u), __uint_as_float(hi << 16), __uint_as_float(hi & 0xffff0000u)};
                x = (x * rs[q].r + rs[q].nmr) * gv[j] + bv[j];
                __builtin_nontemporal_store(x, (GAS f32x4*)(out + (size_t)(m0 + q) * DM + 256 * j + 4 * F.lane)); }
    }
}
constexpr int MX_RAWQK = 0, MX_RAWV = 18496, MX_HS = 0, MX_QS = 35904, MX_KS = 45120, MX_QP = 54336, MX_SS = 63552, MX_KWT = 72768, MX_VST = 81984, MX_CST = 102720, MX_CWB = 123456, MX_DEN = 126016;
constexpr int MX_GA = LDSCTL_OFF + 512;
constexpr int ST_FLOATS = 64 * 144 + 64;
typedef short s16x4v __attribute__((ext_vector_type(4)));

__device__ __forceinline__ float fexp(float x) { return __expf(x); }
__device__ __forceinline__ unsigned pkbf(float lo, float hi) { return pg8::cvt_pk_bf16(lo, hi); }
#define MX_DPPF(x, ctrl) __builtin_bit_cast(float, __builtin_amdgcn_update_dpp(0, __builtin_bit_cast(int, (float)(x)), (ctrl), 0xf, 0xf, true))
__device__ __forceinline__ float row_sum16(float x) {
    x += MX_DPPF(x, 0xB1); x += MX_DPPF(x, 0x4E); x += MX_DPPF(x, 0x141); x += MX_DPPF(x, 0x140); return x;
}
#define MX_LDS_FENCE() asm volatile("s_waitcnt lgkmcnt(0)" ::: "memory")

template <bool OUT>
__device__ __forceinline__ void mlstm_phase(Frame& F, const Args& args, int l) {
    const int tid = F.tid, lane = F.lane, w = F.wave, l15 = lane & 15, lq = lane >> 4;
    unsigned char* ws = F.ws;
    const bf16* Z = (const bf16*)(ws + WS_Z); const float* GT = (const float*)(ws + WS_GT); bf16* Y = (bf16*)(ws + WS_Y); float* ST = (float*)(ws + WS_MST);
    const int u = F.vcu, b = u >> 6, h = (u >> 4) & 3, seg = u & 15;
    const size_t gr_seg = (size_t)b * SEQ + (size_t)seg * 512;
    LAS unsigned char* L = F.lds;
    LAS float* gA = (LAS float*)(L + MX_GA); LAS float* gMX = gA + 512; LAS float* gFL = gA + 1024; LAS float* gBend = gA + 1536; LAS float* gAmax = gA + 1544; LAS float* gMP = gA + 1552; LAS float* gMXE = gA + 1560;
    LAS float* cwb = (LAS float*)(L + MX_CWB);
    const float* qcw = INP(4) + (size_t)l * 4 * 512; const float* qcb = INP(5) + l * 512;
    for (int i = tid; i < 640; i += 512) { const int j = i >> 7, c = i & 127; const int ch = (c < 64) ? (64 * h + c) : (256 + 64 * h + c - 64);
        cwb[i] = (j < 4) ? qcw[j * 512 + ch] : qcb[ch]; }
    for (int i = tid; i < 16 * 72; i += 512) { const int r = i / 72, c = i % 72; ((LAS bf16*)(L + MX_VST))[(128 + r) * 72 + c] = (r == 0 && c < 64) ? (bf16)0x3F80 : (bf16)0; }
    for (int i = tid; i < 144 * 72 / 2; i += 512) ((LAS unsigned*)(L + MX_CST))[i] = 0u;
    float bpos, apos, cmax;
    {
        const size_t t = gr_seg + 64 * w + lane; const float bi = INP(2)[l * 4 + h], bfg = INP(3)[l * 4 + h];
        const float ig = GT[t * 8 + h] + bi, lf = logsigmoid_f(GT[t * 8 + 4 + h] + bfg);
        float s = lf;
#pragma unroll
        for (int o = 1; o < 64; o <<= 1) { const float v = __shfl_up(s, o); if (lane >= o) s += v; }
        bpos = s; apos = ig - s; float c = apos;
#pragma unroll
        for (int o = 1; o < 64; o <<= 1) { const float v = __shfl_up(c, o); if (lane >= o) c = fmaxf(c, v); }
        cmax = c;
        gA[64 * w + lane] = apos;
        if (lane == 63) { gBend[w] = bpos; gAmax[w] = cmax; }
    }
    __syncthreads();
    float m_init = -INFINITY; asm volatile("" : "+v"(m_init));
    f32x4 cacc[4], nacc;
#pragma unroll
    for (int i = 0; i < 4; ++i) cacc[i] = (f32x4){0.f, 0.f, 0.f, 0.f};
    nacc = (f32x4){0.f, 0.f, 0.f, 0.f};
    if (OUT) {
        float ml_l = -INFINITY, bs_l = 0.f;
        if (lane < seg) { const float* sp_ = ST + (size_t)(u - seg + lane) * ST_FLOATS + 64 * 144; ml_l = sp_[0]; bs_l = sp_[1]; }
        float m_run = 0.f;
        for (int sp = 0; sp < seg; ++sp) m_run = fmaxf(__shfl(bs_l, sp) + m_run, __shfl(ml_l, sp));
        float pre = bs_l;
#pragma unroll
        for (int o = 1; o < 16; o <<= 1) { const float v = __shfl_up(pre, o); if (lane >= o) pre += v; }
        const float tot = __shfl(pre, 15);
        const float wgt_l = (lane < seg) ? fexp(ml_l + (tot - pre) - m_run) : 0.f;
#pragma unroll 1
        for (int sp0 = 0; sp0 < seg; sp0 += 3) {
            float v[3][16], vn[3][4], wj[3];
#pragma unroll
            for (int j = 0; j < 3; ++j) { const int sp = (sp0 + j < seg) ? sp0 + j : seg - 1; const float* st = ST + (size_t)(u - seg + sp) * ST_FLOATS;
                wj[j] = (sp0 + j < seg) ? __shfl(wgt_l, sp) : 0.f;
#pragma unroll
                for (int mt = 0; mt < 4; ++mt)
#pragma unroll
                    for (int r = 0; r < 4; ++r) v[j][4 * mt + r] = st[(16 * mt + 4 * lq + r) * 144 + 16 * w + l15];
#pragma unroll
                for (int r = 0; r < 4; ++r) vn[j][r] = (w < 4) ? st[(16 * w + 4 * lq + r) * 144 + 128 + l15] : 0.f; }
#pragma unroll
            for (int j = 0; j < 3; ++j) {
#pragma unroll
                for (int mt = 0; mt < 4; ++mt)
#pragma unroll
                    for (int r = 0; r < 4; ++r) cacc[mt][r] += wj[j] * v[j][4 * mt + r];
#pragma unroll
                for (int r = 0; r < 4; ++r) nacc[r] += wj[j] * vn[j][r]; }
        }
        m_init = m_run;
    }
    { float mp = m_init, mpw = m_init;
#pragma unroll
      for (int n = 0; n < 8; ++n) { const float mxe = fmaxf(mp, gAmax[n]); if (tid == 0) { gMP[n] = mp; gMXE[n] = mxe; } mpw = (w == n) ? mp : mpw; mp = gBend[n] + mxe; }
      if (!OUT) { if (tid == 0) { float bsum = 0.f;
#pragma unroll
            for (int n = 0; n < 8; ++n) bsum += gBend[n];
            ST[(size_t)u * ST_FLOATS + 64 * 144] = mp; ST[(size_t)u * ST_FLOATS + 64 * 144 + 1] = bsum; } }
      if (OUT) {
        const float mx = fmaxf(cmax, mpw); gMX[64 * w + lane] = mx; gFL[64 * w + lane] = fexp(-(bpos + mx));
#pragma unroll
        for (int mt = 0; mt < 4; ++mt) { unsigned long long v = (unsigned long long)pkbf(cacc[mt][0], cacc[mt][1]) | ((unsigned long long)pkbf(cacc[mt][2], cacc[mt][3]) << 32);
            *(LAS unsigned long long*)(L + MX_CST + ((16 * w + l15) * 72 + 16 * mt + 4 * lq) * 2) = v; }
        if (w < 4) { unsigned long long v = (unsigned long long)pkbf(nacc[0], nacc[1]) | ((unsigned long long)pkbf(nacc[2], nacc[3]) << 32);
            *(LAS unsigned long long*)(L + MX_CST + ((128 + l15) * 72 + 16 * w + 4 * lq) * 2) = v; }
      } }
    float gain[8];
    if (OUT) {
#pragma unroll
        for (int e = 0; e < 8; ++e) gain[e] = INP(10)[l * 512 + h * 128 + 8 * (tid & 15) + e]; }
    v4u rq[2][3], rv[2][2], ro[2];
#define MX_LOAD_RAW(n_, ps_) do { \
        const size_t gr0 = gr_seg + 64 * (n_); const int tc = seg * 512 + 64 * (n_); \
        _Pragma("unroll") \
        for (int k = 0; k < 3; ++k) { const int p = tid + 512 * k; const int r = p >> 4, c = p & 15; v4u v = (v4u){0u, 0u, 0u, 0u}; \
            if (p < 67 * 16 && tc - 3 + r >= 0) v = *(const GAS v4u*)(Z + (gr0 + r - 3) * ZW + (c < 8 ? 1024 + 64 * h + 8 * c : 1280 + 64 * h + 8 * (c - 8))); \
            rq[ps_][k] = v; } \
        _Pragma("unroll") \
        for (int k = 0; k < 2; ++k) { const int p = tid + 512 * k; const int r = p >> 4, c = p & 15; \
            rv[ps_][k] = *(const GAS v4u*)(Z + (gr0 + r) * ZW + 1536 + 128 * h + 8 * c); \
            } \
    } while (0)
#define MX_LOAD_O(n_) do { _Pragma("unroll") for (int k = 0; k < 2; ++k) { const int p = tid + 512 * k; ro[k] = *(const GAS v4u*)(Z + (gr_seg + 64 * (n_) + (p >> 4)) * ZW + 2048 + 128 * h + 8 * (p & 15)); } } while (0)
    MX_LOAD_RAW(0, 0); MX_LOAD_RAW(1, 1);
    if (OUT) MX_LOAD_O(0);
    __syncthreads();
#pragma unroll 1
    for (int n2 = 0; n2 < 8; n2 += 2) {
#pragma unroll
    for (int par = 0; par < 2; ++par) { const int n = n2 + par;
        int tid_ = F.tid; asm volatile("" : "+v"(tid_));
        const int tid = tid_, lane = tid & 63, l15 = lane & 15, lq = lane >> 4;
#pragma unroll
        for (int k = 0; k < 3; ++k) { const int p = tid + 512 * k; if (p < 67 * 16) *(LAS v4u*)(L + MX_RAWQK + (p >> 4) * 272 + (p & 15) * 16) = rq[par][k]; }
#pragma unroll
        for (int k = 0; k < 2; ++k) { const int p = tid + 512 * k; *(LAS v4u*)(L + MX_RAWV + (p >> 4) * 272 + (p & 15) * 16) = rv[par][k]; }
        __syncthreads();
        if (n + 2 < 8) MX_LOAD_RAW(n + 2, par);
        {
            const int s = lane;
            const float mxe = gMXE[n], mpv = gMP[n], a_s = gA[64 * n + s]; float mxs = 0.f; if (OUT) mxs = gMX[64 * n + s];
            v4u rvv[2];
#pragma unroll
            for (int cc = 0; cc < 2; ++cc) rvv[cc] = *(const LAS v4u*)(L + MX_RAWV + s * 272 + (2 * w + cc) * 16);
#pragma unroll
            for (int qk = (OUT ? 0 : 1); qk < 2; ++qk) {
                const int cb0 = 64 * qk + 8 * w;
                v4u rw[4]; f32x4 cw4[5][2];
#pragma unroll
                for (int j = 0; j < 4; ++j) rw[j] = *(const LAS v4u*)(L + MX_RAWQK + (s + j) * 272 + cb0 * 2);
#pragma unroll
                for (int j = 0; j < 5; ++j) { cw4[j][0] = *(const LAS f32x4*)(cwb + j * 128 + cb0); cw4[j][1] = *(const LAS f32x4*)(cwb + j * 128 + cb0 + 4); }
                MX_LDS_FENCE();
                float acc[8];
#pragma unroll
                for (int e = 0; e < 8; ++e) acc[e] = cw4[4][e >> 2][e & 3];
#pragma unroll
                for (int j = 0; j < 4; ++j)
#pragma unroll
                    for (int e2 = 0; e2 < 4; ++e2) { const unsigned x = rw[j][e2];
                        acc[2 * e2] = __builtin_fmaf(cw4[j][(2 * e2) >> 2][(2 * e2) & 3], __uint_as_float(x << 16), acc[2 * e2]);
                        acc[2 * e2 + 1] = __builtin_fmaf(cw4[j][(2 * e2 + 1) >> 2][(2 * e2 + 1) & 3], __uint_as_float(x & 0xffff0000u), acc[2 * e2 + 1]); }
#pragma unroll
                for (int e = 0; e < 8; ++e) acc[e] = acc[e] * __builtin_amdgcn_rcpf(1.0f + fexp(-acc[e]));
                if (qk == 0) {
                    const float wi = fexp(mpv - mxs);
                    v4u o; o.x = pkbf(acc[0], acc[1]); o.y = pkbf(acc[2], acc[3]); o.z = pkbf(acc[4], acc[5]); o.w = pkbf(acc[6], acc[7]);
                    *(LAS v4u*)(L + MX_QS + (s * 72 + 8 * w) * 2) = o;
                    v4u p; p.x = pkbf(acc[0] * wi, acc[1] * wi); p.y = pkbf(acc[2] * wi, acc[3] * wi); p.z = pkbf(acc[4] * wi, acc[5] * wi); p.w = pkbf(acc[6] * wi, acc[7] * wi);
                    *(LAS v4u*)(L + MX_QP + (s * 72 + 8 * w) * 2) = p;
                } else {
                    const float kwt = 0.125f * fexp(a_s - mxe);
                    if (OUT) { v4u o; o.x = pkbf(acc[0] * 0.125f, acc[1] * 0.125f); o.y = pkbf(acc[2] * 0.125f, acc[3] * 0.125f); o.z = pkbf(acc[4] * 0.125f, acc[5] * 0.125f); o.w = pkbf(acc[6] * 0.125f, acc[7] * 0.125f);
                        *(LAS v4u*)(L + MX_KS + (s * 72 + 8 * w) * 2) = o; }
#pragma unroll
                    for (int e2 = 0; e2 < 4; ++e2) { const unsigned pk = pkbf(acc[2 * e2] * kwt, acc[2 * e2 + 1] * kwt);
                        ((LAS bf16*)(L + MX_KWT))[(8 * w + 2 * e2) * 72 + s] = (bf16)(pk & 0xffffu); ((LAS bf16*)(L + MX_KWT))[(8 * w + 2 * e2 + 1) * 72 + s] = (bf16)(pk >> 16); }
                }
            }
#pragma unroll
            for (int cc = 0; cc < 2; ++cc) { const int c = 2 * w + cc; const v4u rw = rvv[cc];
#pragma unroll
                for (int e2 = 0; e2 < 4; ++e2) { ((LAS bf16*)(L + MX_VST))[(8 * c + 2 * e2) * 72 + s] = (bf16)(rw[e2] & 0xffffu); ((LAS bf16*)(L + MX_VST))[(8 * c + 2 * e2 + 1) * 72 + s] = (bf16)(rw[e2] >> 16); } }
        }
        __syncthreads();
        if (OUT) {
            const int mt = w >> 1;
#pragma unroll
            for (int ni = 0; ni < 2; ++ni) { const int nt = 2 * (w & 1) + ni; f32x4 sa = (f32x4){0.f, 0.f, 0.f, 0.f};
#pragma unroll
                for (int ks = 0; ks < 2; ++ks) { const bf16x8 av = *(const LAS bf16x8*)(L + MX_QS + ((16 * mt + l15) * 72 + 32 * ks + 8 * lq) * 2), bv = *(const LAS bf16x8*)(L + MX_KS + ((16 * nt + l15) * 72 + 32 * ks + 8 * lq) * 2);
                    sa = __builtin_amdgcn_mfma_f32_16x16x32_bf16(av, bv, sa, 0, 0, 0); }
                const int s = 16 * nt + l15; const float a_s = gA[64 * n + s]; const f32x4 mx4 = *(const LAS f32x4*)(gMX + 64 * n + 16 * mt + 4 * lq);
                float sw[4];
#pragma unroll
                for (int r = 0; r < 4; ++r) { const int t = 16 * mt + 4 * lq + r; sw[r] = (s <= t) ? sa[r] * fexp(a_s - mx4[r]) : 0.f; }
                const unsigned p01 = pkbf(sw[0], sw[1]), p23 = pkbf(sw[2], sw[3]); const int t0 = 16 * mt + 4 * lq;
                ((LAS bf16*)(L + MX_SS))[(t0 + 0) * 72 + s] = (bf16)(p01 & 0xffffu); ((LAS bf16*)(L + MX_SS))[(t0 + 1) * 72 + s] = (bf16)(p01 >> 16);
                ((LAS bf16*)(L + MX_SS))[(t0 + 2) * 72 + s] = (bf16)(p23 & 0xffffu); ((LAS bf16*)(L + MX_SS))[(t0 + 3) * 72 + s] = (bf16)(p23 >> 16); }
            __syncthreads();
            f32x4 na[4], da = (f32x4){0.f, 0.f, 0.f, 0.f};
#pragma unroll
            for (int i = 0; i < 4; ++i) na[i] = (f32x4){0.f, 0.f, 0.f, 0.f};
#pragma unroll
            for (int ks = 0; ks < 4; ++ks) {
                const int aoff = (ks < 2 ? MX_SS : MX_QP) + ((16 * mt + l15) * 72 + 32 * (ks & 1) + 8 * lq) * 2, bbase = (ks < 2 ? MX_VST : MX_CST) + (32 * (ks & 1) + 8 * lq) * 2;
                const bf16x8 av = *(const LAS bf16x8*)(L + aoff);
#pragma unroll
                for (int i = 0; i < 4; ++i) { const int nt = 4 * (w & 1) + i; const bf16x8 bv = *(const LAS bf16x8*)(L + bbase + (16 * nt + l15) * 144);
                    na[i] = __builtin_amdgcn_mfma_f32_16x16x32_bf16(av, bv, na[i], 0, 0, 0); }
                if ((w & 1) == 0) { const bf16x8 bv = *(const LAS bf16x8*)(L + bbase + (128 + l15) * 144); da = __builtin_amdgcn_mfma_f32_16x16x32_bf16(av, bv, da, 0, 0, 0); }
            }
#pragma unroll
            for (int i = 0; i < 4; ++i) { const int nt = 4 * (w & 1) + i;
#pragma unroll
                for (int r = 0; r < 4; ++r) ((LAS float*)(L + MX_HS))[(16 * mt + 4 * lq + r) * 132 + 16 * nt + l15] = na[i][r]; }
            if ((w & 1) == 0 && l15 == 0) {
#pragma unroll
                for (int r = 0; r < 4; ++r) ((LAS float*)(L + MX_DEN))[16 * mt + 4 * lq + r] = da[r]; }
        }
        {
            const float dec = fexp(gMP[n] - gMXE[n]);
#pragma unroll
            for (int mt2 = 0; mt2 < 4; ++mt2) cacc[mt2] = cacc[mt2] * dec;
            nacc = nacc * dec;
#pragma unroll
            for (int ks = 0; ks < 2; ++ks) { const bf16x8 bv = *(const LAS bf16x8*)(L + MX_VST + ((16 * w + l15) * 72 + 32 * ks + 8 * lq) * 2);
#pragma unroll
                for (int mt2 = 0; mt2 < 4; ++mt2) { const bf16x8 av = *(const LAS bf16x8*)(L + MX_KWT + ((16 * mt2 + l15) * 72 + 32 * ks + 8 * lq) * 2);
                    cacc[mt2] = __builtin_amdgcn_mfma_f32_16x16x32_bf16(av, bv, cacc[mt2], 0, 0, 0); }
                if (w < 4) { const bf16x8 av = *(const LAS bf16x8*)(L + MX_KWT + ((16 * w + l15) * 72 + 32 * ks + 8 * lq) * 2), bn = *(const LAS bf16x8*)(L + MX_VST + ((128 + l15) * 72 + 32 * ks + 8 * lq) * 2);
                    nacc = __builtin_amdgcn_mfma_f32_16x16x32_bf16(av, bn, nacc, 0, 0, 0); } }
        }
        __syncthreads();
        if (OUT) {
#pragma unroll
            for (int mt2 = 0; mt2 < 4; ++mt2) { unsigned long long v = (unsigned long long)pkbf(cacc[mt2][0], cacc[mt2][1]) | ((unsigned long long)pkbf(cacc[mt2][2], cacc[mt2][3]) << 32);
                *(LAS unsigned long long*)(L + MX_CST + ((16 * w + l15) * 72 + 16 * mt2 + 4 * lq) * 2) = v; }
            if (w < 4) { unsigned long long v = (unsigned long long)pkbf(nacc[0], nacc[1]) | ((unsigned long long)pkbf(nacc[2], nacc[3]) << 32);
                *(LAS unsigned long long*)(L + MX_CST + ((128 + l15) * 72 + 16 * w + 4 * lq) * 2) = v; }
            f32x4 hh[2][2]; float dn[2], flr[2];
#pragma unroll
            for (int k = 0; k < 2; ++k) { const int id = tid + 512 * k, t = id >> 4, c = id & 15;
                hh[k][0] = *(const LAS f32x4*)(L + MX_HS + (t * 132 + 8 * c) * 4); hh[k][1] = *(const LAS f32x4*)(L + MX_HS + (t * 132 + 8 * c + 4) * 4);
                dn[k] = ((const LAS float*)(L + MX_DEN))[t]; flr[k] = gFL[64 * n + t]; }
            MX_LDS_FENCE();
#pragma unroll
            for (int k = 0; k < 2; ++k) { const int id = tid + 512 * k, t = id >> 4, c = id & 15;
                const float inv = __builtin_amdgcn_rcpf(fmaxf(fabsf(dn[k]), flr[k]));
                float hv[8] = {hh[k][0][0] * inv, hh[k][0][1] * inv, hh[k][0][2] * inv, hh[k][0][3] * inv, hh[k][1][0] * inv, hh[k][1][1] * inv, hh[k][1][2] * inv, hh[k][1][3] * inv};
                float sm = 0.f;
#pragma unroll
                for (int e = 0; e < 8; ++e) sm += hv[e];
                sm = row_sum16(sm);
                const float mean = sm * (1.f / 128.f); float q = 0.f;
#pragma unroll
                for (int e = 0; e < 8; ++e) { hv[e] -= mean; q = __builtin_fmaf(hv[e], hv[e], q); }
                q = row_sum16(q);
                const float rstd = rsqrtf(q * (1.f / 128.f) + LN_EPS);
                float yv[8];
#pragma unroll
                for (int e2 = 0; e2 < 4; ++e2) { const unsigned x = ro[k][e2]; const float o0 = __uint_as_float(x << 16), o1 = __uint_as_float(x & 0xffff0000u);
                    yv[2 * e2] = hv[2 * e2] * rstd * gain[2 * e2] * __builtin_amdgcn_rcpf(1.0f + fexp(-o0)); yv[2 * e2 + 1] = hv[2 * e2 + 1] * rstd * gain[2 * e2 + 1] * __builtin_amdgcn_rcpf(1.0f + fexp(-o1)); }
                v4u o; o.x = pkbf(yv[0], yv[1]); o.y = pkbf(yv[2], yv[3]); o.z = pkbf(yv[4], yv[5]); o.w = pkbf(yv[6], yv[7]);
                __builtin_nontemporal_store(o, (GAS v4u*)(Y + (gr_seg + 64 * n + t) * DM + 512 + 128 * h + 8 * c)); }
            if (n + 1 < 8) MX_LOAD_O(n + 1);
            __syncthreads();
        }
    }
    }
    if (!OUT) {
        float* st = ST + (size_t)u * ST_FLOATS;
#pragma unroll
        for (int mt = 0; mt < 4; ++mt)
#pragma unroll
            for (int r = 0; r < 4; ++r) st[(16 * mt + 4 * lq + r) * 144 + 16 * w + l15] = cacc[mt][r];
        if (w < 4) {
#pragma unroll
            for (int r = 0; r < 4; ++r) st[(16 * w + 4 * lq + r) * 144 + 128 + l15] = nacc[r]; }
    }
    __syncthreads();
}

constexpr int SG_VNT = 0, SG_SOUT = 34816, SG_RAW = 34816;
__device__ __forceinline__ void sgu_phase(Frame& F, const Args& args, int l) {
    const int tid = F.tid, lane = F.lane, w = F.wave, l15 = lane & 15, lq = lane >> 4;
    unsigned char* ws = F.ws; const bf16* Z = (const bf16*)(ws + WS_Z); bf16* Y = (bf16*)(ws + WS_Y);
    LAS unsigned char* L = F.lds;
    const int h = F.vcu & 3;
    const float* sw = INP(6) + ((size_t)l * 4 + h) * 128 * 128; const float* sb = INP(7) + (l * 4 + h) * 128;
    const float* lg = INP(8) + (l * 4 + h) * 128; const float* lb = INP(9) + (l * 4 + h) * 128;
    bf16x8 wa[4];
#pragma unroll
    for (int ks = 0; ks < 4; ++ks) { const float* p = sw + (size_t)(16 * w + l15) * 128 + 32 * ks + 8 * lq; const f32x4 a = *(const GAS f32x4*)p, b = *(const GAS f32x4*)(p + 4);
        v4u o; o.x = pkbf(a[0], a[1]); o.y = pkbf(a[2], a[3]); o.z = pkbf(b[0], b[1]); o.w = pkbf(b[2], b[3]);
        if (w < 4 && ks >= 2) o = (v4u){0u, 0u, 0u, 0u};
        wa[ks] = __builtin_bit_cast(bf16x8, o); }
    float bsr[4];
#pragma unroll
    for (int r = 0; r < 4; ++r) bsr[r] = sb[16 * w + 4 * lq + r];
    float lgv[8], lbv[8];
#pragma unroll
    for (int e = 0; e < 8; ++e) { lgv[e] = lg[8 * (tid & 15) + e]; lbv[e] = lb[8 * (tid & 15) + e]; }
    v4u pv_[4], pu_[4];
#pragma unroll
    for (int k = 0; k < 4; ++k) { const int id = tid + 512 * k; pv_[k] = *(const GAS v4u*)(Z + ((size_t)((F.vcu >> 2) * 4) * 128 + (id >> 4)) * ZW + 512 + 128 * h + 8 * (id & 15)); }
#pragma unroll 1
    for (int it = 0; it < 4; ++it) {
        const int blk = (F.vcu >> 2) * 4 + it;
        const size_t r0 = (size_t)blk * 128;
#pragma unroll
        for (int k = 0; k < 4; ++k) { const int id = tid + 512 * k; pu_[k] = *(const GAS v4u*)(Z + (r0 + (id >> 4)) * ZW + 128 * h + 8 * (id & 15)); }
#pragma unroll
        for (int k = 0; k < 4; ++k) { const int id = tid + 512 * k, j = id >> 4, c = id & 15;
            const v4u rw = pv_[k];
            float v[8];
#pragma unroll
            for (int e2 = 0; e2 < 4; ++e2) { v[2 * e2] = __uint_as_float(rw[e2] << 16); v[2 * e2 + 1] = __uint_as_float(rw[e2] & 0xffff0000u); }
            float sm = 0.f;
#pragma unroll
            for (int e = 0; e < 8; ++e) sm += v[e];
            sm = row_sum16(sm);
            const float mean = sm * (1.f / 128.f); float q = 0.f;
#pragma unroll
            for (int e = 0; e < 8; ++e) { v[e] -= mean; q = __builtin_fmaf(v[e], v[e], q); }
            q = row_sum16(q);
            const float rstd = rsqrtf(q * (1.f / 128.f) + LN_EPS);
#pragma unroll
            for (int e = 0; e < 8; ++e) v[e] = v[e] * rstd * lgv[e] + lbv[e];
            v4u o; o.x = pkbf(v[0], v[1]); o.y = pkbf(v[2], v[3]); o.z = pkbf(v[4], v[5]); o.w = pkbf(v[6], v[7]);
            *(LAS v4u*)(L + SG_RAW + j * 272 + c * 16) = o; }
        if (it + 1 < 4) {
#pragma unroll
            for (int k = 0; k < 4; ++k) { const int id = tid + 512 * k; pv_[k] = *(const GAS v4u*)(Z + (r0 + 128 + (id >> 4)) * ZW + 512 + 128 * h + 8 * (id & 15)); } }
        __syncthreads();
#pragma unroll
        for (int k = 0; k < 4; ++k) { const int id = w + 8 * k;
            const int c = id & 15, j = 64 * (id >> 4) + lane; const v4u rw = *(const LAS v4u*)(L + SG_RAW + j * 272 + c * 16);
#pragma unroll
            for (int e2 = 0; e2 < 4; ++e2) { ((LAS bf16*)(L + SG_VNT))[(8 * c + 2 * e2) * 136 + j] = (bf16)(rw[e2] & 0xffffu); ((LAS bf16*)(L + SG_VNT))[(8 * c + 2 * e2 + 1) * 136 + j] = (bf16)(rw[e2] >> 16); } }
        __syncthreads();
        {
            f32x4 sa[8];
#pragma unroll
            for (int nt = 0; nt < 8; ++nt) sa[nt] = (f32x4){0.f, 0.f, 0.f, 0.f};
#pragma unroll
            for (int ks = 0; ks < 4; ++ks) {
                if (ks < 2 || w >= 4) {
#pragma unroll
                    for (int nt = 0; nt < 8; ++nt) { const bf16x8 bv = *(const LAS bf16x8*)(L + SG_VNT + ((16 * nt + l15) * 136 + 32 * ks + 8 * lq) * 2);
                        sa[nt] = __builtin_amdgcn_mfma_f32_16x16x32_bf16(wa[ks], bv, sa[nt], 0, 0, 0); } } }
#pragma unroll
            for (int nt = 0; nt < 8; ++nt)
#pragma unroll
                for (int r = 0; r < 4; ++r) ((LAS float*)(L + SG_SOUT))[(16 * w + 4 * lq + r) * 132 + 16 * nt + l15] = sa[nt][r] + bsr[r];
        }
        __syncthreads();
#pragma unroll
        for (int k = 0; k < 4; ++k) { const int id = tid + 512 * k, i = id >> 4, c = id & 15;
            const v4u rw = pu_[k];
            const f32x4 s0 = *(const LAS f32x4*)(L + SG_SOUT + (i * 132 + 8 * c) * 4), s1 = *(const LAS f32x4*)(L + SG_SOUT + (i * 132 + 8 * c + 4) * 4);
            v4u o; o.x = pkbf(__uint_as_float(rw[0] << 16) * s0[0], __uint_as_float(rw[0] & 0xffff0000u) * s0[1]); o.y = pkbf(__uint_as_float(rw[1] << 16) * s0[2], __uint_as_float(rw[1] & 0xffff0000u) * s0[3]);
            o.z = pkbf(__uint_as_float(rw[2] << 16) * s1[0], __uint_as_float(rw[2] & 0xffff0000u) * s1[1]); o.w = pkbf(__uint_as_float(rw[3] << 16) * s1[2], __uint_as_float(rw[3] & 0xffff0000u) * s1[3]);
            __builtin_nontemporal_store(o, (GAS v4u*)(Y + (r0 + i) * DM + 128 * h + 8 * c)); }
        __syncthreads();
    }
}
#define MIXER_PASS1 mlstm_phase<false>(F, args, l);
#define MIXER_PASS2 { mlstm_phase<true>(F, args, l); sgu_phase(F, args, l); }
__global__ void __launch_bounds__(NWAVES * 64, 2) mk_fwd(Args args) {
    extern __shared__ __attribute__((aligned(16))) unsigned char lds[];
    Frame F;
    F.lds = (LAS unsigned char*)lds;
    F.MISC = (volatile LAS unsigned*)(F.lds + MISC_OFF);
    F.tid = threadIdx.x; F.lane = F.tid & 63; F.wave = __builtin_amdgcn_readfirstlane(F.tid >> 6);
    F.G = gridDim.x; { const int bx = blockIdx.x; F.vcu = (F.G % 8 == 0) ? (bx % 8) * (F.G / 8) + bx / 8 : bx; }
    F.ws = args.ws;
    F.ctl = (gu32*)(F.ws + WS_CTL);
    for (int u = F.tid; u < (LDS_BYTES - LDSCTL_OFF) / 4; u += NWAVES * 64) ((LAS unsigned*)(F.lds + LDSCTL_OFF))[u] = 0u;
    __syncthreads();
    if (F.tid == 0) {
#pragma unroll
        for (int i = 0; i < 20; ++i) ((LAS unsigned long long*)(F.lds + PT_OFF))[i] = (unsigned long long)args.in[i];
        ((LAS unsigned long long*)(F.lds + PT_OFF))[20] = (unsigned long long)args.out; }
    __syncthreads();
    const int lo = args.ph_lo, hi = args.ph_hi;
    XcdBarrier bar; bar.bar = (unsigned*)(F.ctl + CW_BAR) + args.bar_region * XCD_BAR_WORDS; bar.x = 0; bar.st = nullptr;
    if (hi - lo > 1) bar = xcd_barrier_post((unsigned*)(F.ctl + CW_BAR) + args.bar_region * XCD_BAR_WORDS, F.MISC + 8);

#pragma unroll 1
    for (int ph = lo; ph < hi; ++ph) {
        const int l = (ph - 1) / 8, sub = (ph - 1) % 8;
        int nrep = 1;
        if (DUP_MASK && ph < NPHASE - 1) { if (ph == 0) nrep += (DUP_MASK >> 7) & 1; else nrep += (DUP_MASK >> sub) & 1; }
#pragma unroll 1
        for (int rep = 0; rep < nrep; ++rep) {
        if (ph > lo || rep) xcd_barrier(bar, F.wave == 0 && mk_lane() == 0);
        if (PROBE_CLK >= 10 && blockIdx.x == 0 && F.tid == 0) ((unsigned long long*)(F.ws + WS_CTL + 16384))[ph] = __builtin_amdgcn_s_memrealtime();
#define FRESH_LANE() do { F.lane = mk_lane(); asm volatile("" : "+v"(F.lane)); F.tid = F.wave * 64 + F.lane; } while (0)
        asm volatile("" : "+s"(F.vcu), "+s"(F.wave), "+s"(F.G));
        { unsigned long long wsi = (unsigned long long)F.ws; asm volatile("" : "+s"(wsi)); F.ws = (unsigned char*)(GAS unsigned char*)wsi; }
        unsigned char* ws = F.ws;
        bf16* XN = (bf16*)(ws + WS_XN); bf16* Z = (bf16*)(ws + WS_Z); float* GT = (float*)(ws + WS_GT); bf16* Y = (bf16*)(ws + WS_Y); bf16* H = (bf16*)(ws + WS_H);
        float* G0 = (float*)(ws + WS_G0); float* UP0 = (float*)(ws + WS_UP0);
        if (ph == 0) { FRESH_LANE(); p0_prologue(F, args); continue; }
        if (ph == NPHASE - 1) { FRESH_LANE(); final_ln_phase(F, XN, (const float*)(ws + WS_PARTB), INP(18) + (DEPTH - 1) * DM, INP(19) + (DEPTH - 1) * DM, ((float*)INP(20))); continue; }
        const unsigned char* wt = ws + WS_WT + (size_t)l * WT_LAYER;
        const float* cv = (const float*)(ws + WS_CV); float* partA = (float*)(ws + WS_PARTA); float* partB = (float*)(ws + WS_PARTB);
        if (sub == 0) {
#ifndef NO_Z
            FRESH_LANE();
            if (l == 0) cvec_finalize(F, args);
            const float* part = l > 0 ? partB : nullptr;
            pg8::Gemm g{XN, (const bf16*)(wt + WT_IN), M, ZW, DM}; pg8::StaticOrder S; S.init(M, ZW, F.G, (int)blockIdx.x);
            pg8::EpiZ E{Z, ZW, part, cv + CV_IN1, cv + CV_IN1 + 2576, F.lds + MX_TAB};
            pg8::gemm_phase<pg8::EpiZ, pg8::StaticOrder, true, true>(F.lds + RING_OFF, g, S, E, F.tid);
            FRESH_LANE();
            gates_phase(F, XN, (const bf16*)(wt + WT_G), GT, part, cv + CV_IN1 + ZW, cv + CV_IN1 + 2576 + ZW);
            if (l == 0) { FRESH_LANE(); quant_w_step(F); }
#endif
        } else if (sub == 1) {
#ifndef NO_MIX
            FRESH_LANE();
            MIXER_PASS1
#endif
        } else if (sub == 2) {
#ifndef NO_MIX
            FRESH_LANE();
            MIXER_PASS2
#endif
        } else if (sub == 3) {
#ifndef NO_RES
            FRESH_LANE();
            res_gemm_phase(F, Y, (const bf16*)(wt + WT_OUT), DM, XN, (DUP_MASK && rep == 0 && nrep == 2) ? (bf16*)(ws + 295 * MiB) : XN, l > 0 ? partB : (const float*)nullptr, INP(18) + (l > 0 ? l - 1 : 0) * DM, INP(19) + (l > 0 ? l - 1 : 0) * DM, (DUP_MASK && rep == 0 && nrep == 2) ? (float*)(ws + 400 * MiB) : partA);
#endif
        } else if (sub == 4) {
            FRESH_LANE();
            quant_a_phase(F, XN);
        } else if (sub == 5) {
#ifndef NO_GLU
            FRESH_LANE();
            pg8::Gemm g{(const bf16*)(ws + WS_V8), (const bf16*)(ws + WS_W8 + (size_t)l * 2 * DFF * DM), M, 2 * DFF, DM / 2}; pg8::StaticOrder S; S.init(M, 2 * DFF, F.G, (int)blockIdx.x);
            const float* cu = cv + (l == 0 ? CV_UP0 : CV_UP1); const float* swc = (const float*)(ws + WS_SWC) + (size_t)l * 4 * DFF;
            pg8::EpiGlu8 E{H, INP(15) + (size_t)l * 3 * DFF, INP(16) + l * DFF, G0, UP0, DFF, M / 64, partA, swc + 2 * DFF, cu + 5632, F.lds + MX_TAB, swc, (const float*)(ws + WS_SA)};
            pg8::gemm_phase<pg8::EpiGlu8, pg8::StaticOrder, true, true>(F.lds + RING_OFF, g, S, E, F.tid);
#endif
        } else if (sub == 6) {
            FRESH_LANE();
            glu_fixup_phase(F, G0, UP0, INP(15) + (size_t)l * 3 * DFF, INP(16) + l * DFF, H);
        } else {
#ifndef NO_RES
            FRESH_LANE();
            res_gemm_phase(F, H, (const bf16*)(wt + WT_DN), DFF, XN, (DUP_MASK && rep == 0 && nrep == 2) ? (bf16*)(ws + WS_T4) : XN, partA, INP(12) + l * DM, INP(13) + l * DM, (DUP_MASK && rep == 0 && nrep == 2) ? (float*)(ws + WS_T4 + 128 * MiB) : partB);
#endif
        }
        }
    }
    if (PROBE_CLK && hi == NPHASE) { xcd_barrier(bar, F.wave == 0 && mk_lane() == 0); if (blockIdx.x == 0 && F.tid == 0) {
        if (PROBE_CLK >= 10) { unsigned long long* ts = (unsigned long long*)(F.ws + WS_CTL + 16384); ts[NPHASE] = __builtin_amdgcn_s_memrealtime(); const int k = PROBE_CLK - 10;
            ((float*)INP(20))[0] += 0.1f + 1e-5f * (float)(ts[k + 1] - ts[k]); }
        else ((float*)INP(20))[0] += ((float*)(F.ws + WS_CTL))[2048]; } }
}

static void launch_mk(const Args& base, int lo, int hi, int region, hipStream_t stream) {
    Args a = base; a.ph_lo = lo; a.ph_hi = hi; a.bar_region = region; a.pad = 0;
    hipLaunchKernelGGL(mk_fwd, dim3(256), dim3(NWAVES * 64), LDS_BYTES, stream, a);
}

extern "C" void kernel_launch(void* const* d_in, const int* in_sizes, int n_in, void* d_out, int out_size, void* d_ws, size_t ws_size, hipStream_t stream) {
    static int inited = 0;
    if (!inited) {
        if (hipFuncSetAttribute((const void*)mk_fwd, hipFuncAttributeMaxDynamicSharedMemorySize, LDS_BYTES) != hipSuccess) fprintf(stderr, "kernel_launch: hipFuncSetAttribute failed\n");
        int dev = 0, cus = 0, per_cu = 0;
        if (hipGetDevice(&dev) != hipSuccess || hipDeviceGetAttribute(&cus, hipDeviceAttributeMultiprocessorCount, dev) != hipSuccess) cus = 0;
        if (hipOccupancyMaxActiveBlocksPerMultiprocessor(&per_cu, (const void*)mk_fwd, NWAVES * 64, LDS_BYTES) != hipSuccess) per_cu = 0;
        (void)hipGetLastError();
        if (cus * per_cu < 256) fprintf(stderr, "kernel_launch: %d CUs x %d resident workgroups per CU < the 256 workgroups this kernel's grid barriers need\n", cus, per_cu);
        inited = 1;
    }
    unsigned char* ws = (unsigned char*)d_ws;
    (void)hipMemsetAsync(ws + WS_CTL, 0, CTL_ZERO_BYTES, stream);
    Args a{};
    for (int i = 0; i < 20; ++i) a.in[i] = (const float*)d_in[i];
    a.out = (float*)d_out; a.ws = ws;
    launch_mk(a, 0, NPHASE, 0, stream);
}
```

```cpp
constexpr int PROBE_CLK = 0;
constexpr int PROBE_NULL = 0;
constexpr int DUP_MASK = 0;
#include <hip/hip_runtime.h>
#include <cstdint>
#include <cstdio>

constexpr int BATCH = 4, SEQ = 8192, DM = 1024, M = BATCH * SEQ, DEPTH = 2;
constexpr int DA = 512, DQK = 256, DB = 512, NH = 4;
constexpr int DIN = 2568, ZW = 2560, DFF = 2816;
constexpr float LN_EPS = 1e-5f, ALPHA = 1.41421356237f;

typedef unsigned short bf16;
typedef unsigned u32x4 __attribute__((ext_vector_type(4)));

__device__ __forceinline__ float bf2f(bf16 v) { return __uint_as_float(((unsigned)v) << 16); }
__device__ __forceinline__ bf16 f2bf(float f) { unsigned u = __float_as_uint(f); return (bf16)((u + 0x7fffu + ((u >> 16) & 1u)) >> 16); }
__device__ __forceinline__ float gelu_f(float x) { return 0.5f * x * (1.0f + erff(x * 0.70710678118f)); }
__device__ __forceinline__ float silu_f(float x) { return x / (1.0f + expf(-x)); }
__device__ __forceinline__ float sigmoid_f(float x) { return 1.0f / (1.0f + expf(-x)); }
__device__ __forceinline__ float logsigmoid_f(float x) { return fminf(x, 0.f) - log1pf(expf(-fabsf(x))); }

constexpr size_t MiB = 1u << 20;
constexpr size_t WS_XN = 0;
constexpr size_t WS_Z = 64 * MiB;
constexpr size_t WS_GT = 224 * MiB;
constexpr size_t WS_Y = 225 * MiB;
constexpr size_t WS_HM = 289 * MiB;
constexpr size_t WS_QC = 353 * MiB;
constexpr size_t WS_KC = 385 * MiB;
constexpr size_t WS_IG = 417 * MiB;
constexpr size_t WS_LF = 417 * MiB + 512 * 1024;
constexpr size_t WS_T3 = 64 * MiB;
constexpr size_t WS_H = 64 * MiB;
constexpr size_t WS_T4 = 240 * MiB;
constexpr size_t WS_T5 = 240 * MiB;


__device__ __forceinline__ int mk_lane() { return (int)__builtin_amdgcn_mbcnt_hi(~0u, __builtin_amdgcn_mbcnt_lo(~0u, 0u)); }
namespace pg8 {
#define PG8_LAS __attribute__((address_space(3)))
typedef unsigned short bf16_t;
typedef short bf16x8 __attribute__((ext_vector_type(8)));
typedef float f32x4 __attribute__((ext_vector_type(4)));
typedef unsigned u32x4 __attribute__((ext_vector_type(4)));
typedef int i32x4 __attribute__((ext_vector_type(4)));
constexpr int BM = 256, BK = 64, HALF = 128, HTB = HALF * BK * 2  , STAGE_BYTES = 8 * HTB, NXCD = 8, WGM = 8;

__host__ __device__ __forceinline__ int lds_byte(int r, int c) { const int st = (r >> 4) * 2 + (c >> 5), rr = r & 15, cc = c & 31, ob = rr * 64 + cc * 2; return st * 1024 + (ob ^ (((ob >> 9) & 1) << 5)); }
__host__ __device__ __forceinline__ void stage_rc(int b, int& R, int& C) { const int st = b / 1024, sb = b % 1024, swz = sb ^ (((sb >> 9) & 1) << 5); R = (st >> 1) * 16 + swz / 64; C = (st & 1) * 32 + (swz % 64) / 2; }
__host__ __device__ __forceinline__ int perm32(int rho) { const int n = rho >> 4, i = rho & 15; return 8 * (i >> 2) + 4 * n + (i & 3); }

struct Unit { int pm, pn; };
struct Gemm { const bf16_t* A; const bf16_t* Bt; int M, N, K; };

struct StaticOrder {
    int nM, nN, nwg, G, c;
    __host__ __device__ void init(int M, int N, int G_, int c_) { nM = M / BM; nN = N / BM; nwg = nM * nN; G = G_; c = c_; }
    __host__ __device__ bool next(int i, Unit& u) const {
        const long L = (long)i * G + c; if (L >= nwg) return false;
        int wgid = (int)L; { const int q = nwg / NXCD, r = nwg % NXCD, xcd = wgid % NXCD, off = wgid / NXCD; wgid = (xcd < r ? xcd * (q + 1) : r * (q + 1) + (xcd - r) * q) + off; }
        const int nig = WGM * nN, gid = wgid / nig, fm = gid * WGM, gsz = (nM - fm) < WGM ? (nM - fm) : WGM;
        u.pm = fm + ((wgid % nig) % gsz); u.pn = (wgid % nig) / gsz; return true;
    }
    __device__ __forceinline__ void a_ready(const Unit&) const {}
    __device__ __forceinline__ void done(const Unit&) const {}
};

__device__ __forceinline__ unsigned cvt_pk_bf16(float lo, float hi) { unsigned r; asm volatile("v_cvt_pk_bf16_f32 %0, %1, %2" : "=v"(r) : "v"(lo), "v"(hi)); return r; }
typedef float f32x2 __attribute__((ext_vector_type(2)));
__device__ __forceinline__ f32x2 gelu_pk(f32x2 v) {
    const f32x2 av = __builtin_elementwise_abs(v), d = av * 0.2316418882f + 1.0f;
    f32x2 t; t.x = __builtin_amdgcn_rcpf(d.x); t.y = __builtin_amdgcn_rcpf(d.y);
    f32x2 q = t * 0.5307027145f + (-0.7265760135f); q = q * t + 0.7107068705f; q = q * t + (-0.142248368f); q = q * t + 0.127414796f; q = q * t;
    const f32x2 s = (v * v) * (-0.72134752044f);
    f32x2 e; e.x = __builtin_amdgcn_exp2f(s.x); e.y = __builtin_amdgcn_exp2f(s.y);
    const f32x2 m = v * (q * e), r = v - m;
    f32x2 o; o.x = v.x < 0.f ? m.x : r.x; o.y = v.y < 0.f ? m.y : r.y; return o;
}

constexpr float K_EPS = 1e-5f, K_ALPHA = 1.41421356237f;
struct RowStat { float nmr, r; };
constexpr int TAB_STAT = 0, TAB_CONST = 8192, TAB_P = 12288, TAB_P2 = 20480, TAB_SW = 12288, TAB_R4 = 24576, TAB_SA = 28672;
__device__ __forceinline__ void glds16(const void* gsrc, PG8_LAS unsigned char* ldst) { __builtin_amdgcn_global_load_lds((const unsigned*)gsrc, (PG8_LAS unsigned*)ldst, 16, 0, 0); }
__device__ __forceinline__ void prefetch_stats(const float* part, int pm, PG8_LAS unsigned char* tab, int wid, int lane) {
    glds16(part + ((size_t)pm * BM + 32 * wid) * 8 + 4 * lane, tab + TAB_STAT + wid * 1024);
}
__device__ __forceinline__ RowStat row_stat_lds(const PG8_LAS unsigned char* tab, int rloc, float eps) {
    const f32x4 a = *(const PG8_LAS f32x4*)(tab + TAB_STAT + rloc * 32), b = *(const PG8_LAS f32x4*)(tab + TAB_STAT + rloc * 32 + 16);
    const float mean = ((a[0] + a[2]) + (b[0] + b[2])) * 0.25f;
    const float d0 = a[0] - mean, d1 = a[2] - mean, d2 = b[0] - mean, d3 = b[2] - mean;
    const float m2 = ((a[1] + a[3]) + (b[1] + b[3])) + 256.0f * ((d0 * d0 + d1 * d1) + (d2 * d2 + d3 * d3));
    RowStat o; o.r = __builtin_amdgcn_rsqf(m2 * (1.0f / 1024.0f) + eps); o.nmr = -mean * o.r; return o;
}
__device__ __forceinline__ void finalize_stats(PG8_LAS unsigned char* tab, int tid, int slot = TAB_P) {
    typedef float f32x2v __attribute__((ext_vector_type(2)));
    if (tid < 256) { const RowStat rs = row_stat_lds(tab, tid, K_EPS); *(PG8_LAS f32x2v*)(tab + slot + 8 * tid) = (f32x2v){rs.nmr, rs.r}; }
}
__device__ __forceinline__ RowStat stat_tab(const PG8_LAS unsigned char* tab, int rloc, int slot = TAB_P) {
    typedef float f32x2v __attribute__((ext_vector_type(2)));
    const f32x2v v = *(const PG8_LAS f32x2v*)(tab + slot + 8 * rloc); RowStat o; o.nmr = v.x; o.r = v.y; return o;
}
__device__ __forceinline__ float sum_fq4(float x) {
    auto a = __builtin_amdgcn_permlane16_swap(__float_as_uint(x), __float_as_uint(x), false, false); const float y = __uint_as_float(a[0]) + __uint_as_float(a[1]);
    auto b = __builtin_amdgcn_permlane32_swap(__float_as_uint(y), __float_as_uint(y), false, false); return __uint_as_float(b[0]) + __uint_as_float(b[1]);
}
__device__ __forceinline__ RowStat row_stat(const float* part, size_t row, float eps) {
    const f32x4 a = *(const f32x4*)(part + row * 8), b = *(const f32x4*)(part + row * 8 + 4);
    const float mean = ((a[0] + a[2]) + (b[0] + b[2])) * 0.25f;
    const float d0 = a[0] - mean, d1 = a[2] - mean, d2 = b[0] - mean, d3 = b[2] - mean;
    const float m2 = ((a[1] + a[3]) + (b[1] + b[3])) + 256.0f * ((d0 * d0 + d1 * d1) + (d2 * d2 + d3 * d3));
    RowStat o; o.r = 1.0f / sqrtf(m2 * (1.0f / 1024.0f) + eps); o.nmr = -mean * o.r; return o;
}
__device__ __forceinline__ f32x2 gelu_tail_pk(f32x2 v) {
    f32x2 a; a.x = fminf(fabsf(v.x), 5.0f); a.y = fminf(fabsf(v.y), 5.0f);
    const f32x2 y = a * 0.4f + (-1.0f);
    f32x2 p = y * 8.853518404e-03f + (-2.544437535e-02f);
    p = p * y + (-2.375466377e-02f); p = p * y + 1.315901577e-01f; p = p * y + (-4.990993068e-02f); p = p * y + (-2.514085472e-01f); p = p * y + 3.162307739e-01f; p = p * y + 7.726433873e-02f;
    p = p * y + (-4.806451797e-01f); p = p * y + 4.189891219e-01f; p = p * y + (-1.907058619e-02f); p = p * y + (-2.569682002e-01f); p = p * y + 2.327725887e-01f; p = p * y + (-9.402215481e-02f);
    p = p * y + 1.552435569e-02f;
    return p;
}
__device__ __forceinline__ f32x2 gelu_ns_pk(f32x2 v) {
    return __builtin_elementwise_max(v, (f32x2){0.f, 0.f}) - gelu_tail_pk(v);
}
struct EpiZ {
    static constexpr bool PERM = true, AFTER_DRAIN = false, PERM_A = false, I8 = false;
    bf16_t* O; int ldc; const float* part; const float* c1; const float* c0; PG8_LAS unsigned char* tab;
    __device__ __forceinline__ void prefetch(const Unit& u, int wid, int lane) const {
        if (part) { prefetch_stats(part, u.pm, tab, wid, lane);
            if (wid < 2) glds16((wid ? c0 : c1) + u.pn * BM + 4 * lane, tab + TAB_CONST + wid * 1024); }
    }
    __device__ __forceinline__ void operator()(f32x4 (&acc)[2][2][4][2], const Unit& u, int wr, int wc, int fr, int fq) const {
        const int row0 = u.pm * BM + wr * 64 + fr, col0 = u.pn * BM + wc * 32 + 8 * fq, cl0 = wc * 32 + 8 * fq;
        const bool act = u.pn < 4;
        if (part) { finalize_stats(tab, (wr * 4 + wc) * 64 + fr + 16 * fq); asm volatile("s_waitcnt lgkmcnt(0)" ::: "memory"); __builtin_amdgcn_s_barrier(); asm volatile("" ::: "memory"); }
#pragma unroll
        for (int ai = 0; ai < 2; ++ai)
#pragma unroll
            for (int m = 0; m < 4; ++m) { const int rloc = ai * HALF + wr * 64 + m * 16 + fr; bf16_t* rowp = O + (size_t)(u.pm * BM + rloc) * ldc + col0;
                RowStat rs; rs.r = 1.f; rs.nmr = 0.f; if (part) rs = stat_tab(tab, rloc);
#pragma unroll
                for (int bj = 0; bj < 2; ++bj) { u32x4 w;
#pragma unroll
                    for (int n = 0; n < 2; ++n) { f32x4 v = acc[ai][bj][m][n];
                        if (part) { const f32x4 k1 = *(const PG8_LAS f32x4*)(tab + TAB_CONST + (cl0 + bj * HALF + 4 * n) * 4), k0 = *(const PG8_LAS f32x4*)(tab + TAB_CONST + 1024 + (cl0 + bj * HALF + 4 * n) * 4);
                            v = v * rs.r + (k1 * rs.nmr + k0); }
                        if (act) { const f32x2 a = gelu_ns_pk((f32x2){v[0], v[1]}), b = gelu_ns_pk((f32x2){v[2], v[3]}); v = (f32x4){a.x, a.y, b.x, b.y}; }
                        w[2 * n] = cvt_pk_bf16(v[0], v[1]); w[2 * n + 1] = cvt_pk_bf16(v[2], v[3]); }
                    *(u32x4*)(rowp + bj * HALF) = w; }
                asm volatile("" ::: "memory"); }
    }
};

struct EpiRes {
    static constexpr bool PERM = true, AFTER_DRAIN = false, PERM_A = false, I8 = false;
    bf16_t* V; bf16_t* Vout; int ldc; const float* part_prev; const float* gp; const float* bp; float* part_new; PG8_LAS unsigned char* tab;
    __device__ __forceinline__ void prefetch(const Unit& u, int wid, int lane) const {
        if (part_prev) { prefetch_stats(part_prev, u.pm, tab, wid, lane);
            if (wid < 2) glds16((wid ? bp : gp) + u.pn * BM + 4 * lane, tab + TAB_CONST + wid * 1024); }
    }
    __device__ __forceinline__ void operator()(f32x4 (&acc)[2][2][4][2], const Unit& u, int wr, int wc, int fr, int fq) const {
        typedef float f32x2v __attribute__((ext_vector_type(2)));
        const int col0 = u.pn * BM + wc * 32 + 8 * fq, cl0 = wc * 32 + 8 * fq, lane = fr + 16 * fq, wid = wr * 4 + wc;
        PG8_LAS f32x2v* P = (PG8_LAS f32x2v*)(tab + TAB_P);
        if (part_prev) { finalize_stats(tab, wid * 64 + lane, TAB_P2); asm volatile("s_waitcnt lgkmcnt(0)" ::: "memory"); __builtin_amdgcn_s_barrier(); asm volatile("" ::: "memory"); }
#pragma unroll
        for (int ai = 0; ai < 2; ++ai)
#pragma unroll
            for (int m = 0; m < 4; ++m) { const int rloc = ai * HALF + wr * 64 + m * 16 + fr; bf16_t* rowp = V + (size_t)(u.pm * BM + rloc) * ldc + col0; bf16_t* rowo = Vout + (size_t)(u.pm * BM + rloc) * ldc + col0;
                RowStat rs; rs.r = 1.f; rs.nmr = 0.f; if (part_prev) rs = stat_tab(tab, rloc, TAB_P2);
                float sm = 0.f;
#pragma unroll
                for (int bj = 0; bj < 2; ++bj) { const u32x4 bw = *(const u32x4*)(rowp + bj * HALF);
#pragma unroll
                    for (int n = 0; n < 2; ++n) { const unsigned lo = bw[2 * n], hi = bw[2 * n + 1];
                        f32x4 xs = (f32x4){__uint_as_float(lo << 16), __uint_as_float(lo & 0xffff0000u), __uint_as_float(hi << 16), __uint_as_float(hi & 0xffff0000u)};
                        if (part_prev) { const f32x4 gv = *(const PG8_LAS f32x4*)(tab + TAB_CONST + (cl0 + bj * HALF + 4 * n) * 4), bv = *(const PG8_LAS f32x4*)(tab + TAB_CONST + 1024 + (cl0 + bj * HALF + 4 * n) * 4);
                            xs = (xs * rs.r + rs.nmr) * gv + bv; }
                        const f32x4 v = xs * K_ALPHA + acc[ai][bj][m][n]; acc[ai][bj][m][n] = v; sm += (v[0] + v[1]) + (v[2] + v[3]); } }
                sm = sum_fq4(sm);
                const float mw = sm * (1.0f / 64.0f); float q = 0.f;
#pragma unroll
                for (int bj = 0; bj < 2; ++bj)
#pragma unroll
                    for (int n = 0; n < 2; ++n) { const f32x4 d = acc[ai][bj][m][n] - mw; q += (d[0] * d[0] + d[1] * d[1]) + (d[2] * d[2] + d[3] * d[3]); }
                q = sum_fq4(q);
                if (fq == 0) P[rloc * 4 + wc] = (f32x2v){mw, q};
#pragma unroll
                for (int bj = 0; bj < 2; ++bj) { const f32x4 v0 = acc[ai][bj][m][0], v1 = acc[ai][bj][m][1];
                    u32x4 w; w.x = cvt_pk_bf16(v0[0], v0[1]); w.y = cvt_pk_bf16(v0[2], v0[3]); w.z = cvt_pk_bf16(v1[0], v1[1]); w.w = cvt_pk_bf16(v1[2], v1[3]);
                    *(u32x4*)(rowo + bj * HALF) = w; }
                asm volatile("" ::: "memory"); }
        asm volatile("s_waitcnt lgkmcnt(0)" ::: "memory"); __builtin_amdgcn_s_barrier(); asm volatile("" ::: "memory");
        { const int row = wid * 32 + (lane & 31);
          if (lane < 32) { const f32x2v a = P[row * 4 + 0], b = P[row * 4 + 1], c = P[row * 4 + 2], d = P[row * 4 + 3];
            const float mt = (a.x + b.x + c.x + d.x) * 0.25f; const float da = a.x - mt, db = b.x - mt, dc = c.x - mt, dd = d.x - mt;
            const float m2 = (a.y + b.y) + (c.y + d.y) + 64.0f * ((da * da + db * db) + (dc * dc + dd * dd));
            *(f32x2v*)(part_new + (size_t)(u.pm * BM + row) * 8 + 2 * u.pn) = (f32x2v){mt, m2}; } }
    }
};

#define PG8_DPP0(src, ctrl) __builtin_bit_cast(float, __builtin_amdgcn_update_dpp(0, __builtin_bit_cast(int, (float)(src)), (ctrl), 0xf, 0xf, true))
__device__ __forceinline__ f32x2 gelu_mul_pk(f32x2 v, f32x2 u) {
    return (__builtin_elementwise_max(v, (f32x2){0.f, 0.f}) - gelu_tail_pk(v)) * u;
}
template <int MODE  , bool I8_ = false> struct EpiGluT {
    static constexpr bool PERM = true, AFTER_DRAIN = false, PERM_A = true, I8 = I8_;
    bf16_t* H; const float* cw; const float* cb; float* G0; float* UP0; int dff; int ngrp; const float* part; const float* c1; const float* c0; PG8_LAS unsigned char* tab; const float* sw; const float* sa;
    __device__ __forceinline__ void prefetch(const Unit& u, int wid, int lane) const {
        prefetch_stats(part, u.pm, tab, wid, lane);
        if (wid < 4) { const int v = 2 * wid + (lane >> 5), c4 = (lane & 31) * 4;
            const float* src = (v < 3) ? cw + v * dff : (v == 3) ? cb : (v & 1) ? c0 + ((v - 4) >> 1) * dff : c1 + ((v - 4) >> 1) * dff;
            glds16(src + u.pn * HALF + c4, tab + TAB_CONST + wid * 1024); }
        if (I8_) {
            if (wid == 4) glds16(sw + (lane >> 5) * dff + u.pn * HALF + (lane & 31) * 4, tab + TAB_SW);
            if (wid == 5) glds16(sa + (size_t)u.pm * BM + 4 * lane, tab + TAB_SA); }
    }
    __device__ __forceinline__ void operator()(f32x4 (&acc)[2][2][4][2], const Unit& u, int wr, int wc, int fr, int fq) const {
        const int hc0 = u.pn * HALF + wc * 32 + 8 * fq;
        const PG8_LAS unsigned char* wt_ = tab + TAB_CONST + (wc * 32 + 8 * fq) * 4;
#define PG8_TABV(v_, n_) (*(const PG8_LAS f32x4*)(wt_ + (v_) * 512 + (4 * (n_)) * 4))
        if (MODE == 0 && !I8_) { finalize_stats(tab, (wr * 4 + wc) * 64 + fr + 16 * fq); asm volatile("s_waitcnt lgkmcnt(0)" ::: "memory"); __builtin_amdgcn_s_barrier(); asm volatile("" ::: "memory"); }
        if (MODE == 0 && I8_) { const int tid_ = (wr * 4 + wc) * 64 + fr + 16 * fq;
            if (tid_ < 256) { const RowStat rs = row_stat_lds(tab, tid_, K_EPS); const float sa_ = *(const PG8_LAS float*)(tab + TAB_SA + 4 * tid_); *(PG8_LAS f32x4*)(tab + TAB_R4 + 16 * tid_) = (f32x4){rs.nmr, rs.r, rs.r * sa_, 0.f}; }
            asm volatile("s_waitcnt lgkmcnt(0)" ::: "memory"); __builtin_amdgcn_s_barrier(); asm volatile("" ::: "memory"); }
#pragma unroll
        for (int ai = 0; ai < 2; ++ai) {
            const int tb = u.pm * BM + ai * HALF + wr * 64, grp = tb >> 6;
            if (MODE == 0 && I8_) {
                f32x4 r4[4];
#pragma unroll
                for (int m = 0; m < 4; ++m) r4[m] = *(const PG8_LAS f32x4*)(tab + TAB_R4 + 16 * (ai * HALF + wr * 64 + 4 * fr + m));
#pragma unroll
                for (int bj = 0; bj < 2; ++bj)
#pragma unroll
                    for (int n = 0; n < 2; ++n) { const f32x4 k1 = PG8_TABV(4 + 2 * bj, n), k0 = PG8_TABV(5 + 2 * bj, n), swv = PG8_TABV(8 + bj, n);
#pragma unroll
                        for (int m = 0; m < 4; ++m) { const f32x4 fv = __builtin_convertvector(__builtin_bit_cast(i32x4, acc[ai][bj][m][n]), f32x4);
                            acc[ai][bj][m][n] = fv * (swv * r4[m][2]) + (k1 * r4[m][0] + k0); } }
                asm volatile("" ::: "memory");
            }
            if (MODE == 0 && !I8_) {
                RowStat rs[4];
#pragma unroll
                for (int m = 0; m < 4; ++m) rs[m] = stat_tab(tab, ai * HALF + wr * 64 + 4 * fr + m);
#pragma unroll
                for (int bj = 0; bj < 2; ++bj)
#pragma unroll
                    for (int n = 0; n < 2; ++n) { const f32x4 k1 = PG8_TABV(4 + 2 * bj, n), k0 = PG8_TABV(5 + 2 * bj, n);
#pragma unroll
                        for (int m = 0; m < 4; ++m) acc[ai][bj][m][n] = acc[ai][bj][m][n] * rs[m].r + (k1 * rs[m].nmr + k0); }
                asm volatile("" ::: "memory");
            }
            unsigned hp[4][2];
#pragma unroll
            for (int n = 0; n < 2; ++n) {
                const f32x4 w0 = PG8_TABV(0, n), w1 = PG8_TABV(1, n), w2 = PG8_TABV(2, n), cbv = PG8_TABV(3, n);
#pragma unroll
                for (int m = 0; m < 4; ++m) {
                    const int t = tb + 4 * fr + m; const f32x4 gg = acc[ai][0][m][n], up = acc[ai][1][m][n]; f32x4 hv;
                    if (MODE == 1) { hv = gg * up; } else {
                    f32x4 g1, g2;
                    if (m == 0) {
#pragma unroll
                        for (int e = 0; e < 4; ++e) { g1[e] = PG8_DPP0(acc[ai][0][3][n][e], 0x111); g2[e] = PG8_DPP0(acc[ai][0][2][n][e], 0x111); } }
                    else if (m == 1) { g1 = acc[ai][0][0][n];
#pragma unroll
                        for (int e = 0; e < 4; ++e) g2[e] = PG8_DPP0(acc[ai][0][3][n][e], 0x111); }
                    else { g1 = acc[ai][0][m - 1][n]; g2 = acc[ai][0][m - 2][n]; }
                    const f32x4 cv = cbv + w0 * g2 + w1 * g1 + w2 * gg;
                    const f32x2 a = gelu_mul_pk((f32x2){cv[0], cv[1]}, (f32x2){up[0], up[1]}), b = gelu_mul_pk((f32x2){cv[2], cv[3]}, (f32x2){up[2], up[3]});
                    hv = (f32x4){a.x, a.y, b.x, b.y}; }
                    if (MODE == 0 && fr == 0 && m < 2) {
                        *(f32x4*)(G0 + ((size_t)grp * 4 + 2 + m) * dff + hc0 + 4 * n) = gg; *(f32x4*)(UP0 + ((size_t)grp * 2 + m) * dff + hc0 + 4 * n) = up; }
                    if (MODE == 0 && fr == 15 && m >= 2 && grp + 1 < ngrp)
                        *(f32x4*)(G0 + ((size_t)(grp + 1) * 4 + (m - 2)) * dff + hc0 + 4 * n) = gg;
                    const unsigned p0 = cvt_pk_bf16(hv[0], hv[1]), p1 = cvt_pk_bf16(hv[2], hv[3]);
                    if (n == 0) { hp[m][0] = p0; hp[m][1] = p1; }
                    else if (MODE == 2) { asm volatile("" :: "v"(p0), "v"(p1), "v"(hp[m][0]), "v"(hp[m][1])); }
                    else if (m >= 2 || fr > 0) { u32x4 w; w.x = hp[m][0]; w.y = hp[m][1]; w.z = p0; w.w = p1; __builtin_nontemporal_store(w, (u32x4*)(H + (size_t)t * dff + hc0)); }
                }
            }
            asm volatile("" ::: "memory");
        }
#undef PG8_TABV
    }
};
typedef EpiGluT<0> EpiGlu;
typedef EpiGluT<0, true> EpiGlu8;
struct EpiNull {
    static constexpr bool PERM = true, AFTER_DRAIN = false, PERM_A = false, I8 = false;
    __device__ __forceinline__ void prefetch(const Unit&, int, int) const {}
    __device__ __forceinline__ void operator()(f32x4 (&acc)[2][2][4][2], const Unit& u, int wr, int wc, int fr, int fq) const {
#pragma unroll
        for (int ai = 0; ai < 2; ++ai)
#pragma unroll
            for (int bj = 0; bj < 2; ++bj)
#pragma unroll
                for (int m = 0; m < 4; ++m) asm volatile("" :: "v"(acc[ai][bj][m][0]), "v"(acc[ai][bj][m][1]));
    }
};
template <class Epi, class Sched, bool ALIGN_EPI = false, bool SP2 = false>
__device__ __forceinline__ void gemm_phase(PG8_LAS unsigned char* lds, const Gemm g, const Sched& S, const Epi& E, int tid_in) {
    int tid_ = tid_in; asm volatile("" : "+v"(tid_));
    const int tid = tid_, wid = __builtin_amdgcn_readfirstlane(tid >> 6), lane = tid & 63, wr = wid >> 2, wc = wid & 3, fr = lane & 15, fq = lane >> 4;
    const int K = g.K, nt = K / BK;
    unsigned voffA[2], voffB[2];
#pragma unroll
    for (int i = 0; i < 2; ++i) { int R, C; stage_rc(tid * 16 + i * 8192, R, C); const int Rb = Epi::PERM ? ((R & ~31) + perm32(R & 31)) : R;
        const int Ra = Epi::PERM_A ? ((R & ~63) + 4 * (R & 15) + ((R >> 4) & 3)) : R;
        voffA[i] = (unsigned)(Ra * K + C) * 2u; voffB[i] = (unsigned)(Rb * K + C) * 2u; }
    const size_t kstep = (size_t)(BK * 2);
    const size_t hstep = (size_t)HALF * K * 2;
    const size_t tstep = 2 * hstep;
    const unsigned ldsw = (unsigned)wid * 1024u;
    const int aoff = lds_byte(wr * 64 + fr, fq * 8), boff = lds_byte(wc * 32 + fr, fq * 8);
#define PG8_SA(b, h) (((b) * 2 + (h)) * HTB)
#define PG8_SB(b, h) ((4 + (b) * 2 + (h)) * HTB)
#define PG8_STAGE(bufoff, gbase, voff) do { _Pragma("unroll") for (int _i = 0; _i < 2; ++_i) \
        __builtin_amdgcn_global_load_lds((const unsigned*)((const char*)(gbase) + (voff)[_i]), (PG8_LAS unsigned*)(lds + (bufoff) + ldsw + _i * 8192), 16, 0, 0); } while (0)
#define PG8_LDA(dst, b, h) do { _Pragma("unroll") for (int m = 0; m < 4; ++m) _Pragma("unroll") for (int k = 0; k < 2; ++k) dst[m][k] = *(const PG8_LAS bf16x8*)(lds + PG8_SA(b, h) + aoff + m * 2048 + k * 1024); } while (0)
#define PG8_LDB(dst, b, h) do { _Pragma("unroll") for (int n = 0; n < 2; ++n) _Pragma("unroll") for (int k = 0; k < 2; ++k) dst[n][k] = *(const PG8_LAS bf16x8*)(lds + PG8_SB(b, h) + boff + n * 2048 + k * 1024); } while (0)
#define PG8_MMA(ai, bj, At, Bt) do { __builtin_amdgcn_s_setprio(1); _Pragma("unroll") for (int m = 0; m < 4; ++m) _Pragma("unroll") for (int n = 0; n < 2; ++n) _Pragma("unroll") for (int k = 0; k < 2; ++k) \
        { if constexpr (Epi::I8) acc[ai][bj][m][n] = __builtin_bit_cast(f32x4, __builtin_amdgcn_mfma_i32_16x16x64_i8(__builtin_bit_cast(i32x4, Bt[n][k]), __builtin_bit_cast(i32x4, At[m][k]), __builtin_bit_cast(i32x4, acc[ai][bj][m][n]), 0, 0, 0)); \
          else acc[ai][bj][m][n] = __builtin_amdgcn_mfma_f32_16x16x32_bf16(Bt[n][k], At[m][k], acc[ai][bj][m][n], 0, 0, 0); } __builtin_amdgcn_s_setprio(0); } while (0)
#define PG8_WAIT_V(n) asm volatile("s_waitcnt vmcnt(" #n ")" ::: "memory")
#define PG8_WAIT_L(n) asm volatile("s_waitcnt lgkmcnt(" #n ")" ::: "memory")
#define PG8_BAR __builtin_amdgcn_s_barrier()
#define PG8_SCHED __builtin_amdgcn_sched_barrier(0)
    Unit cur, nxt; int ui = 0;
    if (!S.next(0, cur)) return;
    f32x4 acc[2][2][4][2];
    bf16x8 At[4][2], B0[2][2], B1[2][2];
    const char* cA = (const char*)g.A + (size_t)cur.pm * tstep; const char* cB = (const char*)g.Bt + (size_t)cur.pn * tstep;
    S.a_ready(cur);
    if constexpr (SP2) {
        PG8_STAGE(PG8_SB(0, 0), cB, voffB); PG8_STAGE(PG8_SB(0, 1), cB + hstep, voffB); PG8_STAGE(PG8_SA(0, 0), cA, voffA); PG8_STAGE(PG8_SA(0, 1), cA + hstep, voffA);
        if (wr == 1) PG8_BAR;
        PG8_WAIT_V(2); PG8_BAR;
        PG8_STAGE(PG8_SB(1, 0), cB + kstep, voffB); PG8_STAGE(PG8_SA(1, 0), cA + kstep, voffA); PG8_STAGE(PG8_SB(1, 1), cB + hstep + kstep, voffB);
        PG8_WAIT_V(6); PG8_BAR;
    } else {
        PG8_STAGE(PG8_SB(0, 0), cB, voffB); PG8_STAGE(PG8_SA(0, 0), cA, voffA); PG8_STAGE(PG8_SB(0, 1), cB + hstep, voffB); PG8_STAGE(PG8_SA(0, 1), cA + hstep, voffA);
        if (wr == 1) PG8_BAR;
        PG8_WAIT_V(4); PG8_BAR;
        PG8_STAGE(PG8_SB(1, 0), cB + kstep, voffB); PG8_STAGE(PG8_SA(1, 0), cA + kstep, voffA); PG8_STAGE(PG8_SB(1, 1), cB + hstep + kstep, voffB);
        PG8_WAIT_V(6); PG8_BAR;
    }
#pragma unroll
    for (int a = 0; a < 2; ++a)
#pragma unroll
        for (int b = 0; b < 2; ++b)
#pragma unroll
            for (int m = 0; m < 4; ++m)
#pragma unroll
                for (int n = 0; n < 2; ++n) acc[a][b][m][n] = (f32x4){0.f, 0.f, 0.f, 0.f};
    for (;;) {
        const bool has_next = S.next(ui + 1, nxt);
        const char* nA = has_next ? (const char*)g.A + (size_t)nxt.pm * tstep : cA; const char* nB = has_next ? (const char*)g.Bt + (size_t)nxt.pn * tstep : cB;
        { PG8_BAR; int ln_ = (int)__builtin_amdgcn_mbcnt_hi(~0u, __builtin_amdgcn_mbcnt_lo(~0u, 0u)); asm volatile("" : "+v"(ln_)); E.prefetch(cur, wid, ln_); }
        for (int t = 0; t < nt; t += 2) {
            const bool last = (t == nt - 2);
            const char* a1 = cA + (size_t)(t + 1) * kstep;
            const char* a2 = last ? nA : cA + (size_t)(t + 2) * kstep; const char* b2 = last ? nB : cB + (size_t)(t + 2) * kstep;
            const char* a3 = a2 + kstep; const char* b3 = b2 + kstep;
            if (last && has_next) S.a_ready(nxt);
            if constexpr (SP2) {
            PG8_LDB(B0, 0, 0); PG8_LDB(B1, 0, 1); PG8_SCHED; PG8_LDA(At, 0, 0); PG8_STAGE(PG8_SA(1, 1), a1 + hstep, voffA);
            PG8_WAIT_V(8); PG8_WAIT_L(0); PG8_BAR; PG8_MMA(0, 0, At, B0); PG8_MMA(0, 1, At, B1); PG8_BAR; PG8_SCHED;
            PG8_LDA(At, 0, 1); PG8_STAGE(PG8_SB(0, 0), b2, voffB); PG8_STAGE(PG8_SB(0, 1), b2 + hstep, voffB); PG8_STAGE(PG8_SA(0, 0), a2, voffA);
            PG8_WAIT_V(8); PG8_WAIT_L(0); PG8_BAR; PG8_MMA(1, 0, At, B0); PG8_MMA(1, 1, At, B1); PG8_BAR; PG8_SCHED;
            PG8_LDB(B0, 1, 0); PG8_LDB(B1, 1, 1); PG8_SCHED; PG8_LDA(At, 1, 0); PG8_STAGE(PG8_SA(0, 1), a2 + hstep, voffA);
            PG8_WAIT_V(8); PG8_WAIT_L(0); PG8_BAR; PG8_MMA(0, 0, At, B0); PG8_MMA(0, 1, At, B1); PG8_BAR; PG8_SCHED;
            PG8_LDA(At, 1, 1); PG8_STAGE(PG8_SB(1, 0), b3, voffB); PG8_STAGE(PG8_SB(1, 1), b3 + hstep, voffB); PG8_STAGE(PG8_SA(1, 0), a3, voffA);
            PG8_WAIT_V(8); PG8_WAIT_L(0); PG8_BAR; PG8_MMA(1, 0, At, B0); PG8_MMA(1, 1, At, B1); PG8_BAR; PG8_SCHED;
            } else {
            PG8_LDB(B0, 0, 0); PG8_SCHED; PG8_LDA(At, 0, 0); PG8_STAGE(PG8_SA(1, 1), a1 + hstep, voffA);
            PG8_WAIT_L(8); PG8_BAR; PG8_WAIT_L(0); PG8_MMA(0, 0, At, B0); PG8_BAR; PG8_SCHED;
            PG8_LDB(B1, 0, 1); PG8_STAGE(PG8_SB(0, 0), b2, voffB);
            PG8_BAR; PG8_WAIT_L(0); PG8_MMA(0, 1, At, B1); PG8_BAR;
            PG8_LDA(At, 0, 1); PG8_STAGE(PG8_SA(0, 0), a2, voffA);
            PG8_BAR; PG8_WAIT_L(0); PG8_MMA(1, 0, At, B0); PG8_BAR; PG8_SCHED;
            PG8_STAGE(PG8_SB(0, 1), b2 + hstep, voffB);
            PG8_WAIT_V(6); PG8_BAR; PG8_MMA(1, 1, At, B1); PG8_BAR;
            PG8_LDB(B0, 1, 0); PG8_SCHED; PG8_LDA(At, 1, 0); PG8_STAGE(PG8_SA(0, 1), a2 + hstep, voffA);
            PG8_WAIT_L(8); PG8_BAR; PG8_WAIT_L(0); PG8_MMA(0, 0, At, B0); PG8_BAR; PG8_SCHED;
            PG8_LDB(B1, 1, 1); PG8_STAGE(PG8_SB(1, 0), b3, voffB);
            PG8_BAR; PG8_WAIT_L(0); PG8_MMA(0, 1, At, B1); PG8_BAR;
            PG8_LDA(At, 1, 1); PG8_STAGE(PG8_SA(1, 0), a3, voffA);
            PG8_BAR; PG8_WAIT_L(0); PG8_MMA(1, 0, At, B0); PG8_BAR; PG8_SCHED;
            PG8_STAGE(PG8_SB(1, 1), b3 + hstep, voffB);
            PG8_WAIT_V(6); PG8_BAR; PG8_MMA(1, 1, At, B1); PG8_BAR;
            }
        }
        if constexpr (ALIGN_EPI) { if (wr == 0) PG8_BAR; }
        if constexpr (!Epi::AFTER_DRAIN) { int ln_ = (int)__builtin_amdgcn_mbcnt_hi(~0u, __builtin_amdgcn_mbcnt_lo(~0u, 0u)); asm volatile("" : "+v"(ln_));
            E(acc, cur, wr, wc, ln_ & 15, ln_ >> 4); S.done(cur); }
        if (!has_next) break;
#pragma unroll
        for (int a = 0; a < 2; ++a)
#pragma unroll
            for (int b = 0; b < 2; ++b)
#pragma unroll
                for (int m = 0; m < 4; ++m)
#pragma unroll
                    for (int n = 0; n < 2; ++n) acc[a][b][m][n] = (f32x4){0.f, 0.f, 0.f, 0.f};
        cur = nxt; cA = nA; cB = nB; ++ui;
        if constexpr (ALIGN_EPI) { if (wr == 1) PG8_BAR; }
    }
    PG8_WAIT_V(0);
    if constexpr (!ALIGN_EPI) { if (wr == 0) PG8_BAR; }
    PG8_BAR;
    if constexpr (Epi::AFTER_DRAIN) { E.fused(acc, cur, wr, wc, fr, fq, lds, wid, lane); S.done(cur); }
#undef PG8_SA
#undef PG8_SB
#undef PG8_STAGE
#undef PG8_LDA
#undef PG8_LDB
#undef PG8_MMA
#undef PG8_WAIT_V
#undef PG8_WAIT_L
#undef PG8_BAR
#undef PG8_SCHED
}
}
#define GAS __attribute__((address_space(1)))
#define LAS __attribute__((address_space(3)))
typedef unsigned short bf16;
typedef unsigned v4u __attribute__((ext_vector_type(4)));
typedef float f32x4 __attribute__((ext_vector_type(4)));
typedef short bf16x8 __attribute__((ext_vector_type(8)));
typedef GAS unsigned gu32;
typedef GAS unsigned long long gu64;
#define RLX_AGENT __ATOMIC_RELAXED, __HIP_MEMORY_SCOPE_AGENT
#define LDS_WAIT() asm volatile("s_waitcnt lgkmcnt(0)" ::: "memory")
#define VM_WAIT() asm volatile("s_waitcnt vmcnt(0)" ::: "memory")
__device__ __forceinline__ unsigned long long rt() { return __builtin_amdgcn_s_memrealtime(); }

#define XB_TMO      128
#define XB_XCNT(j)  (256  + 64 * (j))
#define XB_XSUB(j)  (1280 + 64 * (j))
#define XB_XGEN(j)  (2304 + 64 * (j))
#define XB_TOP      3328
#define XB_TOPGEN   3392
#define XCD_BAR_WORDS 3456
#define XB_SPIN_CAP (1u << 18)

__device__ __forceinline__ unsigned xb_ld(unsigned* p)              { return __hip_atomic_load(p, __ATOMIC_RELAXED, __HIP_MEMORY_SCOPE_AGENT); }
__device__ __forceinline__ unsigned xb_add(unsigned* p, unsigned v) { return __hip_atomic_fetch_add(p, v, __ATOMIC_RELAXED, __HIP_MEMORY_SCOPE_AGENT); }
__device__ __forceinline__ unsigned xb_xcc_id() { return (unsigned)__builtin_amdgcn_s_getreg((3 << 11) | 20) & 0xFu; }
#define XB_SPIN(cond, bar) do { unsigned _sp = 0; while (cond) { __builtin_amdgcn_s_sleep(1); \
    if ((++_sp & 255u) == 0u) { if (xb_ld(&(bar)[XB_TMO])) break; if (_sp > XB_SPIN_CAP) { atomicAdd(&(bar)[XB_TMO], 1u); break; } } } } while (0)

struct XcdBarrier {
    unsigned* bar; unsigned x;
    volatile LAS unsigned* st;
};

__device__ __forceinline__ XcdBarrier xcd_barrier_post(unsigned* bar, volatile LAS unsigned* st) {
    XcdBarrier b; b.bar = bar; b.x = xb_xcc_id(); b.st = st;
    if (threadIdx.x == 0) (void)xb_add(&bar[XB_XCNT(b.x)], 1u);
    return b;
}
__device__ __forceinline__ void xcd_barrier_complete(unsigned* bar, unsigned x, unsigned& nloc, unsigned& nx) {
    const unsigned G = gridDim.x * gridDim.y * gridDim.z;
    unsigned sum, cnt, mine, sp = 0u;
    for (;;) {
        sum = 0u; cnt = 0u; mine = 0u;
#pragma unroll
        for (unsigned j = 0; j < 16; ++j) { const unsigned c = xb_ld(&bar[XB_XCNT(j)]); sum += c; cnt += (c > 0u) ? 1u : 0u; mine = (j == x) ? c : mine; }
        if (sum == G) break;
        __builtin_amdgcn_s_sleep(1);
        if ((++sp & 255u) == 0u) { if (xb_ld(&bar[XB_TMO])) break; if (sp > XB_SPIN_CAP) { atomicAdd(&bar[XB_TMO], 1u); break; } }
    }
    nloc = mine > 0u ? mine : 1u; nx = cnt > 0u ? cnt : 1u;
}

__device__ __forceinline__ void xcd_barrier(const XcdBarrier& b, bool leader_thread) {
    asm volatile("s_waitcnt vmcnt(0)" ::: "memory");
    __syncthreads();
    if (leader_thread) {
        unsigned* bar = b.bar;
        __builtin_amdgcn_s_waitcnt(0);
        unsigned nloc = b.st[0], nx = b.st[1];
        if (nloc == 0u) { xcd_barrier_complete(bar, b.x, nloc, nx); b.st[0] = nloc; b.st[1] = nx; }
        const unsigned old = xb_add(&bar[XB_XSUB(b.x)], 1u);
        const unsigned gen = old / nloc;
        if (old + 1u == (gen + 1u) * nloc) {
            __builtin_amdgcn_fence(__ATOMIC_RELEASE, "agent");
            asm volatile("s_waitcnt vmcnt(0)" ::: "memory");
            const unsigned og = xb_add(&bar[XB_TOP], 1u);
            const unsigned tg = og / nx;
            if (og + 1u == (tg + 1u) * nx) xb_add(&bar[XB_TOPGEN], 1u);
            else XB_SPIN(xb_ld(&bar[XB_TOPGEN]) == tg, bar);
            __builtin_amdgcn_fence(__ATOMIC_ACQUIRE, "agent");
            xb_add(&bar[XB_XGEN(b.x)], 1u);
            asm volatile("s_waitcnt vmcnt(0)" ::: "memory");
        } else {
            XB_SPIN(xb_ld(&bar[XB_XGEN(b.x)]) == gen, bar);
            __builtin_amdgcn_fence(__ATOMIC_ACQUIRE, "agent");
            asm volatile("s_waitcnt vmcnt(0)" ::: "memory");
        }
    }
    __syncthreads();
}

constexpr int NWAVES = 8;
constexpr size_t WS_CTL = 420 * MiB, CTL_ZERO_BYTES = 64 * 1024;
constexpr size_t WS_XCH = 421 * MiB;
constexpr size_t WS_PARTA = WS_XCH, WS_PARTB = WS_XCH + 1 * MiB, WS_CV = WS_XCH + 2 * MiB, WS_CPART = WS_CV + 256 * 1024;
constexpr int CV_IN1 = 0, CV_UP0 = 2 * 2576, CV_UP1 = CV_UP0 + 2 * 5632, CV_END = CV_UP1 + 2 * 5632;
constexpr int CP_IN1 = 0, CP_UP0 = 16 * 2 * 2576, CP_UP1 = CP_UP0 + 16 * 2 * 5632, CP_END = CP_UP1 + 16 * 2 * 5632;
static_assert(CV_END * 4 <= 256 * 1024 && WS_CPART + (size_t)CP_END * 4 <= WS_XCH + 4 * MiB, "deferred-LN map");
constexpr size_t WS_G0 = 425 * MiB;
constexpr size_t WS_UP0 = 447 * MiB;
constexpr size_t WS_WT = 458 * MiB;
constexpr size_t WT_IN = 0, WT_G = (size_t)2560 * 1024 * 2, WT_OUT = WT_G + 16 * 1024 * 2, WT_UP = WT_OUT + (size_t)1024 * 1024 * 2, WT_DN = WT_UP + (size_t)5632 * 1024 * 2, WT_LAYER = WT_DN + (size_t)1024 * 2816 * 2;
constexpr size_t WS_W8 = 302 * MiB, WS_SWC = 314 * MiB, WS_V8 = 320 * MiB, WS_SA = 353 * MiB;
constexpr size_t WS_MST = 289 * MiB;
static_assert(WS_WT + 2 * WT_LAYER <= 512 * MiB, "ws map");
constexpr int CW_TMO = 0, CW_CODE = 1, CW_BAR = 4096, CW_SEAM = 16384, SEAM_BANK = 128 * 64;
constexpr int MX_TAB = 131072 + 512;
constexpr int RING_OFF = 0, RING_BYTES = 131072, LDSCTL_OFF = RING_BYTES, MISC_OFF = LDSCTL_OFF + 320, LDS_BYTES = 163840;
constexpr int NPHASE = 18;

struct Frame {
    LAS unsigned char* lds; volatile LAS unsigned* MISC; gu32* ctl; unsigned char* ws; int tid, lane, wave, vcu, G;
};
constexpr int PT_OFF = LDSCTL_OFF + 64;
#define INP(i) inptr(F, (i))
__device__ __forceinline__ const float* inptr(const Frame& F, int i) {
    const volatile LAS unsigned* p = (const volatile LAS unsigned*)(F.lds + PT_OFF) + 2 * i;
    const unsigned lo = __builtin_amdgcn_readfirstlane(p[0]), hi = __builtin_amdgcn_readfirstlane(p[1]);
    return (const float*)(const GAS float*)(((unsigned long long)hi << 32) | lo);
}
struct Args { const float* in[20]; float* out; unsigned char* ws; int ph_lo, ph_hi, bar_region, pad; };

__device__ __forceinline__ unsigned pk2(float lo, float hi) { return f2bf(lo) | ((unsigned)f2bf(hi) << 16); }

__device__ __forceinline__ void p0_transpose_item(const float* W, int K, int N, bf16* WT, int k0, int n0, int drow0, LAS float* scr, int lane, const float* gs, const float* bs, float* cp1, float* cp0) {
    float tv[32];
#pragma unroll
    for (int i = 0; i < 32; ++i) { const int kk = 2 * i + (lane >> 5); tv[i] = W[(size_t)(k0 + kk) * N + n0 + (lane & 31)]; }
    if (gs) {
        float s1 = 0.f, s0 = 0.f;
#pragma unroll
        for (int i = 0; i < 32; ++i) { const int kk = 2 * i + (lane >> 5); const float gk = gs[k0 + kk], bk = bs[k0 + kk]; s0 = __builtin_fmaf(bk, tv[i], s0); tv[i] *= gk; s1 += tv[i]; }
        s1 += __shfl_xor(s1, 32); s0 += __shfl_xor(s0, 32);
        if (lane < 32) { cp1[n0 + lane] = s1; cp0[n0 + lane] = s0; }
    }
#pragma unroll
    for (int i = 0; i < 32; ++i) { const int kk = 2 * i + (lane >> 5); scr[kk * 33 + (lane & 31)] = tv[i]; }
    LDS_WAIT(); asm volatile("" ::: "memory");
    const int c = lane & 7;
#pragma unroll
    for (int j = 0; j < 4; ++j) { const int n = (lane >> 3) + 8 * j; const LAS float* s = scr + (8 * c) * 33 + n;
        v4u o; o.x = pk2(s[0 * 33], s[1 * 33]); o.y = pk2(s[2 * 33], s[3 * 33]); o.z = pk2(s[4 * 33], s[5 * 33]); o.w = pk2(s[6 * 33], s[7 * 33]);
        *(GAS v4u*)(WT + (size_t)(drow0 + n) * K + k0 + 8 * c) = o; }
    LDS_WAIT(); asm volatile("" ::: "memory");
}

__device__ __forceinline__ void p0_prologue(Frame& F, const Args& a) {
    LAS float* scr = (LAS float*)(F.lds + RING_OFF + F.wave * 16384);
    const int gw = F.vcu * NWAVES + F.wave, NGW = F.G * NWAVES;
    constexpr int I_IN = 16 * 80, I_OUT = 16 * 32, I_UP = 16 * 176, I_DN = 44 * 32, I_LAYER = I_IN + I_OUT + I_UP + I_DN;
    for (int it = gw; it < DEPTH * I_LAYER; it += NGW) {
        const int l = it / I_LAYER; int r = it % I_LAYER; unsigned char* wt = F.ws + WS_WT + (size_t)l * WT_LAYER;
        float* cpart = (float*)(F.ws + WS_CPART);
        if (r < I_IN) { const int kb = r / 80, nb = r % 80; const bool sc = l > 0;
            p0_transpose_item(INP(1) + (size_t)l * DM * DIN, DM, DIN, (bf16*)(wt + WT_IN), 64 * kb, 32 * nb, 32 * nb, scr, F.lane, sc ? INP(18) + (l - 1) * DM : nullptr, sc ? INP(19) + (l - 1) * DM : nullptr,
                              cpart + CP_IN1 + kb * 2 * 2576, cpart + CP_IN1 + kb * 2 * 2576 + 2576); continue; } r -= I_IN;
        if (r < I_OUT) { const int kb = r / 32, nb = r % 32; p0_transpose_item(INP(11) + (size_t)l * DM * DM, DM, DM, (bf16*)(wt + WT_OUT), 64 * kb, 32 * nb, 32 * nb, scr, F.lane, nullptr, nullptr, nullptr, nullptr); continue; } r -= I_OUT;
        if (r < I_UP) { const int kb = r / 176, nb = r % 176, n0 = 32 * nb; const int isup = n0 >= DFF, c = isup ? n0 - DFF : n0; const int drow = (c >> 7) * 256 + isup * 128 + (c & 127);
            float* cp = cpart + (l == 0 ? CP_UP0 : CP_UP1) + kb * 2 * 5632;
            p0_transpose_item(INP(14) + (size_t)l * DM * 2 * DFF, DM, 2 * DFF, (bf16*)(wt + WT_UP), 64 * kb, n0, drow, scr, F.lane, INP(12) + l * DM, INP(13) + l * DM, cp, cp + 5632); continue; } r -= I_UP;
        { const int kb = r / 32, nb = r % 32; p0_transpose_item(INP(17) + (size_t)l * DFF * DM, DFF, DM, (bf16*)(wt + WT_DN), 64 * kb, 32 * nb, 32 * nb, scr, F.lane, nullptr, nullptr, nullptr, nullptr); }
    }
    for (int i = gw * 64 + F.lane; i < DEPTH * 16 * DM; i += NGW * 64) { const int l = i / (16 * DM), j = (i / DM) % 16, k = i % DM;
        float v = j < 8 ? INP(1)[(size_t)l * DM * DIN + (size_t)k * DIN + ZW + j] : 0.f; if (l > 0) v *= INP(18)[(l - 1) * DM + k];
        ((bf16*)(F.ws + WS_WT + (size_t)l * WT_LAYER + WT_G))[j * DM + k] = f2bf(v); }
    for (int j = gw; j < 8; j += NGW) { float s1 = 0.f, s0 = 0.f;
        for (int k = F.lane; k < DM; k += 64) { const float wv = INP(1)[(size_t)1 * DM * DIN + (size_t)k * DIN + ZW + j]; s1 = __builtin_fmaf(INP(18)[k], wv, s1); s0 = __builtin_fmaf(INP(19)[k], wv, s0); }
#pragma unroll
        for (int o = 1; o < 64; o <<= 1) { s1 += __shfl_xor(s1, o); s0 += __shfl_xor(s0, o); }
        if (F.lane == 0) { float* cv = (float*)(F.ws + WS_CV); cv[CV_IN1 + ZW + j] = s1; cv[CV_IN1 + 2576 + ZW + j] = s0; } }
    const float* x = INP(0); bf16* XN = (bf16*)(F.ws + WS_XN);
    for (size_t i0 = (size_t)gw * 64 + F.lane; i0 < (size_t)M * DM / 8; i0 += (size_t)NGW * 64 * 4) {
        f32x4 v0[4], v1[4];
#pragma unroll
        for (int q = 0; q < 4; ++q) { const size_t i = i0 + (size_t)q * NGW * 64; v0[q] = *(const GAS f32x4*)(x + i * 8); v1[q] = *(const GAS f32x4*)(x + i * 8 + 4); }
#pragma unroll
        for (int q = 0; q < 4; ++q) { const size_t i = i0 + (size_t)q * NGW * 64;
            v4u o; o.x = pk2(v0[q][0], v0[q][1]); o.y = pk2(v0[q][2], v0[q][3]); o.z = pk2(v1[q][0], v1[q][1]); o.w = pk2(v1[q][2], v1[q][3]);
            *(GAS v4u*)(XN + i * 8) = o; } }
}

__device__ __forceinline__ void cvec_finalize(Frame& F, const Args& a) {
    const float* cp = (const float*)(F.ws + WS_CPART); float* cv = (float*)(F.ws + WS_CV);
    const int gt = (F.vcu * NWAVES + F.wave) * 64 + F.lane, NT = F.G * NWAVES * 64;
    for (int i = gt; i < 2 * ZW + 4 * 5632; i += NT) {
        int src, dst, stride, idx = i;
        if (idx < 2 * ZW) { const int v = idx / ZW, n = idx % ZW; src = CP_IN1 + v * 2576 + n; dst = CV_IN1 + v * 2576 + n; stride = 2 * 2576; }
        else { idx -= 2 * ZW; const int m = idx / (2 * 5632), e = idx % (2 * 5632); src = (m ? CP_UP1 : CP_UP0) + e; dst = (m ? CV_UP1 : CV_UP0) + e; stride = 2 * 5632; }
        float sacc = 0.f;
#pragma unroll
        for (int kb = 0; kb < 16; ++kb) sacc += cp[src + kb * stride];
        cv[dst] = sacc; }
}
__device__ __forceinline__ float wave_max(float x) {
#pragma unroll
    for (int o = 32; o > 0; o >>= 1) x = fmaxf(x, __shfl_xor(x, o)); return x; }
__device__ __forceinline__ int wave_isum(int x) {
#pragma unroll
    for (int o = 32; o > 0; o >>= 1) x += __shfl_xor(x, o); return x; }
__device__ __forceinline__ void quant_unpack(const v4u a, const v4u b, float (&x)[16]) {
#pragma unroll
    for (int e = 0; e < 4; ++e) { x[2 * e] = __uint_as_float(a[e] << 16); x[2 * e + 1] = __uint_as_float(a[e] & 0xffff0000u); x[8 + 2 * e] = __uint_as_float(b[e] << 16); x[8 + 2 * e + 1] = __uint_as_float(b[e] & 0xffff0000u); }
}
__device__ __forceinline__ float quant_row16(const float (&x)[16], unsigned (&q8)[4], int& isum) {
    float am = 0.f;
#pragma unroll
    for (int e = 0; e < 16; ++e) am = fmaxf(am, fabsf(x[e]));
    am = wave_max(am);
    const float inv = am > 0.f ? 127.0f / am : 0.f;
    isum = 0;
#pragma unroll
    for (int j = 0; j < 4; ++j) { unsigned w = 0u;
#pragma unroll
        for (int e = 0; e < 4; ++e) { const int q = (int)__builtin_rintf(x[4 * j + e] * inv); isum += q; w |= ((unsigned)q & 0xffu) << (8 * e); }
        q8[j] = w; }
    return am * (1.0f / 127.0f);
}
typedef unsigned v2u __attribute__((ext_vector_type(2)));
__device__ __forceinline__ void quant_w_step(Frame& F) {
    const int gw = F.vcu * NWAVES + F.wave, NGW = F.G * NWAVES, lane = F.lane;
    for (int rr = gw; rr < DEPTH * 2 * DFF; rr += NGW) {
        const int l = rr / (2 * DFF), n = rr % (2 * DFF);
        const bf16* src = (const bf16*)(F.ws + WS_WT + (size_t)l * WT_LAYER + WT_UP) + (size_t)n * DM;
        const v4u a = *(const GAS v4u*)(src + 8 * lane), b = *(const GAS v4u*)(src + 512 + 8 * lane);
        float x[16]; quant_unpack(a, b, x);
        unsigned q8[4]; int isum; const float sc = quant_row16(x, q8, isum);
        isum = wave_isum(isum);
        unsigned char* dst = F.ws + WS_W8 + ((size_t)l * 2 * DFF + n) * DM;
        *(GAS v2u*)(dst + 8 * lane) = (v2u){q8[0], q8[1]}; *(GAS v2u*)(dst + 512 + 8 * lane) = (v2u){q8[2], q8[3]};
        if (lane == 0) { float* swc = (float*)(F.ws + WS_SWC) + (size_t)l * 4 * DFF; const int idx = ((n & 255) >= 128 ? DFF : 0) + 128 * (n >> 8) + (n & 127);
            swc[idx] = sc; swc[2 * DFF + idx] = sc * (float)isum; }
    }
}
__device__ __forceinline__ void quant_a_phase(Frame& F, const bf16* V) {
    const int gw = F.vcu * NWAVES + F.wave, NGW = F.G * NWAVES, lane = F.lane;
    unsigned char* V8 = F.ws + WS_V8; float* SA = (float*)(F.ws + WS_SA);
    for (int m0 = gw * 4; m0 < M; m0 += NGW * 4) {
        v4u a[4], b[4];
#pragma unroll
        for (int q = 0; q < 4; ++q) { const bf16* src = V + (size_t)(m0 + q) * DM; a[q] = *(const GAS v4u*)(src + 8 * lane); b[q] = *(const GAS v4u*)(src + 512 + 8 * lane); }
#pragma unroll
        for (int q = 0; q < 4; ++q) { float x[16]; quant_unpack(a[q], b[q], x);
            unsigned q8[4]; int isum; const float sc = quant_row16(x, q8, isum);
            unsigned char* dst = V8 + (size_t)(m0 + q) * DM;
            *(GAS v2u*)(dst + 8 * lane) = (v2u){q8[0], q8[1]}; *(GAS v2u*)(dst + 512 + 8 * lane) = (v2u){q8[2], q8[3]};
            if (lane == 0) SA[m0 + q] = sc; }
    }
}
__device__ __forceinline__ void gates_phase(Frame& F, const bf16* XN, const bf16* WG, float* GT, const float* part, const float* c1, const float* c0) {
    const int gw = F.vcu * NWAVES + F.wave, NGW = F.G * NWAVES, l15 = F.lane & 15, lq = F.lane >> 4;
    for (int blk = gw; blk < M / 16; blk += NGW) {
        const bf16* ap = XN + (size_t)(blk * 16 + l15) * DM + 8 * lq; const bf16* bp = WG + (size_t)l15 * DM + 8 * lq;
        f32x4 acc = (f32x4){0.f, 0.f, 0.f, 0.f};
#pragma unroll 16
        for (int ks = 0; ks < DM / 32; ++ks) { const bf16x8 av = *(const GAS bf16x8*)(ap + ks * 32), bv = *(const GAS bf16x8*)(bp + ks * 32);
            acc = __builtin_amdgcn_mfma_f32_16x16x32_bf16(av, bv, acc, 0, 0, 0); }
        if (l15 < 8) {
            float k1 = 0.f, k0 = 0.f; if (part) { k1 = c1[l15]; k0 = c0[l15]; }
#pragma unroll
            for (int r = 0; r < 4; ++r) { const size_t row = (size_t)(blk * 16 + 4 * lq + r); float v = acc[r];
                if (part) { const pg8::RowStat rs = pg8::row_stat(part, row, LN_EPS); v = v * rs.r + (k1 * rs.nmr + k0); }
                GT[row * 8 + l15] = v; } }
    }
}

__device__ __forceinline__ void glu_fixup_phase(Frame& F, const float* G0, const float* UP0, const float* cw, const float* cb, bf16* H) {
    const int gt = (F.vcu * NWAVES + F.wave) * 64 + F.lane, NT = F.G * NWAVES * 64;
    constexpr int C4 = DFF / 4, NIT = (M / 64) * 2 * C4;
    for (int i0 = gt; i0 < NIT; i0 += 2 * NT) {
        f32x4 s0[2], s1[2], s2[2], up[2], w0[2], w1[2], w2[2], bb[2]; int rr[2], gg[2], cc[2]; bool ok[2];
#pragma unroll
        for (int q = 0; q < 2; ++q) { const int i = i0 + q * NT; ok[q] = i < NIT; const int ii = ok[q] ? i : gt;
            const int c = (ii % C4) * 4, r = (ii / C4) & 1, grp = ii / (2 * C4); rr[q] = r; gg[q] = grp; cc[q] = c;
            const float* gp = G0 + ((size_t)grp * 4 + r) * DFF + c;
            s0[q] = *(const GAS f32x4*)gp; s1[q] = *(const GAS f32x4*)(gp + DFF); s2[q] = *(const GAS f32x4*)(gp + 2 * DFF);
            up[q] = *(const GAS f32x4*)(UP0 + ((size_t)grp * 2 + r) * DFF + c);
            w0[q] = *(const GAS f32x4*)(cw + c); w1[q] = *(const GAS f32x4*)(cw + DFF + c); w2[q] = *(const GAS f32x4*)(cw + 2 * DFF + c); bb[q] = *(const GAS f32x4*)(cb + c); }
#pragma unroll
        for (int q = 0; q < 2; ++q) { if (!ok[q]) continue;
            const bool bs = (gg[q] & (SEQ / 64 - 1)) == 0;
            const f32x4 z = (f32x4){0.f, 0.f, 0.f, 0.f}; const f32x4 a0 = bs ? z : s0[q], a1 = (bs && rr[q] == 0) ? z : s1[q];
            const f32x4 cv = bb[q] + w0[q] * a0 + w1[q] * a1 + w2[q] * s2[q];
            const pg8::f32x2 ha = pg8::gelu_mul_pk((pg8::f32x2){cv[0], cv[1]}, (pg8::f32x2){up[q][0], up[q][1]}), hb = pg8::gelu_mul_pk((pg8::f32x2){cv[2], cv[3]}, (pg8::f32x2){up[q][2], up[q][3]});
            unsigned long long o = (unsigned long long)pg8::cvt_pk_bf16(ha.x, ha.y) | ((unsigned long long)pg8::cvt_pk_bf16(hb.x, hb.y) << 32);
            *(GAS unsigned long long*)(H + (size_t)(gg[q] * 64 + rr[q]) * DFF + cc[q]) = o; }
    }
}

struct SameTileOrder {
    int n, pm0, pn0;
    __device__ bool next(int i, pg8::Unit& u) const { if (i >= n) return false; u.pm = pm0; u.pn = pn0; return true; }
    __device__ __forceinline__ void a_ready(const pg8::Unit&) const {}
    __device__ __forceinline__ void done(const pg8::Unit&) const {}
};
struct OneUnit {
    int pm, pn;
    __device__ bool next(int i, pg8::Unit& u) const { if (i != 0) return false; u.pm = pm; u.pn = pn; return true; }
    __device__ __forceinline__ void a_ready(const pg8::Unit&) const {}
    __device__ __forceinline__ void done(const pg8::Unit&) const {}
};

__device__ __forceinline__ void res_gemm_phase(Frame& F, const bf16* A, const bf16* Bt, int K, bf16* V, bf16* Vout, const float* part_prev, const float* gp, const float* bp, float* part_new) {
    pg8::Gemm gm{A, Bt, M, DM, K}; pg8::StaticOrder S; S.init(M, DM, F.G, (int)blockIdx.x);
    pg8::EpiRes E{V, Vout, DM, part_prev, gp, bp, part_new, F.lds + MX_TAB};
    pg8::gemm_phase<pg8::EpiRes, pg8::StaticOrder, true, true>(F.lds + RING_OFF, gm, S, E, F.tid);
}
__device__ __forceinline__ void final_ln_phase(Frame& F, const bf16* V, const float* part, const float* g, const float* b, float* out) {
    const int gw = F.vcu * NWAVES + F.wave, NGW = F.G * NWAVES;
    f32x4 gv[4], bv[4];
#pragma unroll
    for (int j = 0; j < 4; ++j) { gv[j] = *(const GAS f32x4*)(g + 256 * j + 4 * F.lane); bv[j] = *(const GAS f32x4*)(b + 256 * j + 4 * F.lane); }
    for (int m0 = gw * 4; m0 < M; m0 += NGW * 4) {
        unsigned long long w[4][4]; pg8::RowStat rs[4];
#pragma unroll
        for (int q = 0; q < 4; ++q) { rs[q] = pg8::row_stat(part, (size_t)(m0 + q), LN_EPS);
#pragma unroll
            for (int j = 0; j < 4; ++j) w[q][j] = *(const GAS unsigned long long*)(V + (size_t)(m0 + q) * DM + 256 * j + 4 * F.lane); }
#pragma unroll
        for (int q = 0; q < 4; ++q)
#pragma unroll
            for (int j = 0; j < 4; ++j) { const unsigned lo = (unsigned)w[q][j], hi = (unsigned)(w[q][j] >> 32);
                f32x4 x = (f32x4){__uint_as_float(lo << 16), __uint_as_float(lo & 0xffff0000u), __uint_as_float(hi << 16), __uint_as_float(hi & 0xffff0000u)};
                x = (x * rs[q].r + rs[q].nmr) * gv[j] + bv[j];
                *(GAS f32x4*)(out + (size_t)(m0 + q) * DM + 256 * j + 4 * F.lane) = x; }
    }
}
constexpr int MX_RAWQK = 0, MX_RAWV = 18496, MX_HS = 0, MX_QS = 35904, MX_KS = 45120, MX_QP = 54336, MX_SS = 63552, MX_KWT = 72768, MX_VST = 81984, MX_CST = 102720, MX_CWB = 123456, MX_DEN = 126016;
constexpr int MX_GA = LDSCTL_OFF + 512;
constexpr int ST_FLOATS = 64 * 144 + 64;
typedef short s16x4v __attribute__((ext_vector_type(4)));

__device__ __forceinline__ float fexp(float x) { return __expf(x); }
__device__ __forceinline__ unsigned pkbf(float lo, float hi) { return pg8::cvt_pk_bf16(lo, hi); }
#define MX_DPPF(x, ctrl) __builtin_bit_cast(float, __builtin_amdgcn_update_dpp(0, __builtin_bit_cast(int, (float)(x)), (ctrl), 0xf, 0xf, true))
__device__ __forceinline__ float row_sum16(float x) {
    x += MX_DPPF(x, 0xB1); x += MX_DPPF(x, 0x4E); x += MX_DPPF(x, 0x141); x += MX_DPPF(x, 0x140); return x;
}
#define MX_LDS_FENCE() asm volatile("s_waitcnt lgkmcnt(0)" ::: "memory")

template <bool OUT>
__device__ __forceinline__ void mlstm_phase(Frame& F, const Args& args, int l) {
    const int tid = F.tid, lane = F.lane, w = F.wave, l15 = lane & 15, lq = lane >> 4;
    unsigned char* ws = F.ws;
    const bf16* Z = (const bf16*)(ws + WS_Z); const float* GT = (const float*)(ws + WS_GT); bf16* Y = (bf16*)(ws + WS_Y); float* ST = (float*)(ws + WS_MST);
    const int u = F.vcu, b = u >> 6, h = (u >> 4) & 3, seg = u & 15;
    const size_t gr_seg = (size_t)b * SEQ + (size_t)seg * 512;
    LAS unsigned char* L = F.lds;
    LAS float* gA = (LAS float*)(L + MX_GA); LAS float* gMX = gA + 512; LAS float* gFL = gA + 1024; LAS float* gBend = gA + 1536; LAS float* gAmax = gA + 1544; LAS float* gMP = gA + 1552; LAS float* gMXE = gA + 1560;
    LAS float* cwb = (LAS float*)(L + MX_CWB);
    const float* qcw = INP(4) + (size_t)l * 4 * 512; const float* qcb = INP(5) + l * 512;
    for (int i = tid; i < 640; i += 512) { const int j = i >> 7, c = i & 127; const int ch = (c < 64) ? (64 * h + c) : (256 + 64 * h + c - 64);
        cwb[i] = (j < 4) ? qcw[j * 512 + ch] : qcb[ch]; }
    for (int i = tid; i < 16 * 72; i += 512) { const int r = i / 72, c = i % 72; ((LAS bf16*)(L + MX_VST))[(128 + r) * 72 + c] = (r == 0 && c < 64) ? (bf16)0x3F80 : (bf16)0; }
    for (int i = tid; i < 144 * 72 / 2; i += 512) ((LAS unsigned*)(L + MX_CST))[i] = 0u;
    float bpos, apos, cmax;
    {
        const size_t t = gr_seg + 64 * w + lane; const float bi = INP(2)[l * 4 + h], bfg = INP(3)[l * 4 + h];
        const float ig = GT[t * 8 + h] + bi, lf = logsigmoid_f(GT[t * 8 + 4 + h] + bfg);
        float s = lf;
#pragma unroll
        for (int o = 1; o < 64; o <<= 1) { const float v = __shfl_up(s, o); if (lane >= o) s += v; }
        bpos = s; apos = ig - s; float c = apos;
#pragma unroll
        for (int o = 1; o < 64; o <<= 1) { const float v = __shfl_up(c, o); if (lane >= o) c = fmaxf(c, v); }
        cmax = c;
        gA[64 * w + lane] = apos;
        if (lane == 63) { gBend[w] = bpos; gAmax[w] = cmax; }
    }
    __syncthreads();
    float m_init = -INFINITY; asm volatile("" : "+v"(m_init));
    f32x4 cacc[4], nacc;
#pragma unroll
    for (int i = 0; i < 4; ++i) cacc[i] = (f32x4){0.f, 0.f, 0.f, 0.f};
    nacc = (f32x4){0.f, 0.f, 0.f, 0.f};
    if (OUT) {
        float ml_l = -INFINITY, bs_l = 0.f;
        if (lane < seg) { const float* sp_ = ST + (size_t)(u - seg + lane) * ST_FLOATS + 64 * 144; ml_l = sp_[0]; bs_l = sp_[1]; }
        float m_run = 0.f;
        for (int sp = 0; sp < seg; ++sp) m_run = fmaxf(__shfl(bs_l, sp) + m_run, __shfl(ml_l, sp));
        float pre = bs_l;
#pragma unroll
        for (int o = 1; o < 16; o <<= 1) { const float v = __shfl_up(pre, o); if (lane >= o) pre += v; }
        const float tot = __shfl(pre, 15);
        const float wgt_l = (lane < seg) ? fexp(ml_l + (tot - pre) - m_run) : 0.f;
#pragma unroll 1
        for (int sp0 = 0; sp0 < seg; sp0 += 3) {
            float v[3][16], vn[3][4], wj[3];
#pragma unroll
            for (int j = 0; j < 3; ++j) { const int sp = (sp0 + j < seg) ? sp0 + j : seg - 1; const float* st = ST + (size_t)(u - seg + sp) * ST_FLOATS;
                wj[j] = (sp0 + j < seg) ? __shfl(wgt_l, sp) : 0.f;
#pragma unroll
                for (int mt = 0; mt < 4; ++mt)
#pragma unroll
                    for (int r = 0; r < 4; ++r) v[j][4 * mt + r] = st[(16 * mt + 4 * lq + r) * 144 + 16 * w + l15];
#pragma unroll
                for (int r = 0; r < 4; ++r) vn[j][r] = (w < 4) ? st[(16 * w + 4 * lq + r) * 144 + 128 + l15] : 0.f; }
#pragma unroll
            for (int j = 0; j < 3; ++j) {
#pragma unroll
                for (int mt = 0; mt < 4; ++mt)
#pragma unroll
                    for (int r = 0; r < 4; ++r) cacc[mt][r] += wj[j] * v[j][4 * mt + r];
#pragma unroll
                for (int r = 0; r < 4; ++r) nacc[r] += wj[j] * vn[j][r]; }
        }
        m_init = m_run;
    }
    { float mp = m_init, mpw = m_init;
#pragma unroll
      for (int n = 0; n < 8; ++n) { const float mxe = fmaxf(mp, gAmax[n]); if (tid == 0) { gMP[n] = mp; gMXE[n] = mxe; } mpw = (w == n) ? mp : mpw; mp = gBend[n] + mxe; }
      if (!OUT) { if (tid == 0) { float bsum = 0.f;
#pragma unroll
            for (int n = 0; n < 8; ++n) bsum += gBend[n];
            ST[(size_t)u * ST_FLOATS + 64 * 144] = mp; ST[(size_t)u * ST_FLOATS + 64 * 144 + 1] = bsum; } }
      if (OUT) {
        const float mx = fmaxf(cmax, mpw); gMX[64 * w + lane] = mx; gFL[64 * w + lane] = fexp(-(bpos + mx));
#pragma unroll
        for (int mt = 0; mt < 4; ++mt) { unsigned long long v = (unsigned long long)pkbf(cacc[mt][0], cacc[mt][1]) | ((unsigned long long)pkbf(cacc[mt][2], cacc[mt][3]) << 32);
            *(LAS unsigned long long*)(L + MX_CST + ((16 * w + l15) * 72 + 16 * mt + 4 * lq) * 2) = v; }
        if (w < 4) { unsigned long long v = (unsigned long long)pkbf(nacc[0], nacc[1]) | ((unsigned long long)pkbf(nacc[2], nacc[3]) << 32);
            *(LAS unsigned long long*)(L + MX_CST + ((128 + l15) * 72 + 16 * w + 4 * lq) * 2) = v; }
      } }
    float gain[8];
    if (OUT) {
#pragma unroll
        for (int e = 0; e < 8; ++e) gain[e] = INP(10)[l * 512 + h * 128 + 8 * (tid & 15) + e]; }
    v4u rq[2][3], rv[2][2], ro[2];
#define MX_LOAD_RAW(n_, ps_) do { \
        const size_t gr0 = gr_seg + 64 * (n_); const int tc = seg * 512 + 64 * (n_); \
        _Pragma("unroll") \
        for (int k = 0; k < 3; ++k) { const int p = tid + 512 * k; const int r = p >> 4, c = p & 15; v4u v = (v4u){0u, 0u, 0u, 0u}; \
            if (p < 67 * 16 && tc - 3 + r >= 0) v = *(const GAS v4u*)(Z + (gr0 + r - 3) * ZW + (c < 8 ? 1024 + 64 * h + 8 * c : 1280 + 64 * h + 8 * (c - 8))); \
            rq[ps_][k] = v; } \
        _Pragma("unroll") \
        for (int k = 0; k < 2; ++k) { const int p = tid + 512 * k; const int r = p >> 4, c = p & 15; \
            rv[ps_][k] = *(const GAS v4u*)(Z + (gr0 + r) * ZW + 1536 + 128 * h + 8 * c); \
            } \
    } while (0)
#define MX_LOAD_O(n_) do { _Pragma("unroll") for (int k = 0; k < 2; ++k) { const int p = tid + 512 * k; ro[k] = *(const GAS v4u*)(Z + (gr_seg + 64 * (n_) + (p >> 4)) * ZW + 2048 + 128 * h + 8 * (p & 15)); } } while (0)
    MX_LOAD_RAW(0, 0); MX_LOAD_RAW(1, 1);
    if (OUT) MX_LOAD_O(0);
    __syncthreads();
#pragma unroll 1
    for (int n2 = 0; n2 < 8; n2 += 2) {
#pragma unroll
    for (int par = 0; par < 2; ++par) { const int n = n2 + par;
        int tid_ = F.tid; asm volatile("" : "+v"(tid_));
        const int tid = tid_, lane = tid & 63, l15 = lane & 15, lq = lane >> 4;
#pragma unroll
        for (int k = 0; k < 3; ++k) { const int p = tid + 512 * k; if (p < 67 * 16) *(LAS v4u*)(L + MX_RAWQK + (p >> 4) * 272 + (p & 15) * 16) = rq[par][k]; }
#pragma unroll
        for (int k = 0; k < 2; ++k) { const int p = tid + 512 * k; *(LAS v4u*)(L + MX_RAWV + (p >> 4) * 272 + (p & 15) * 16) = rv[par][k]; }
        __syncthreads();
        if (n + 2 < 8) MX_LOAD_RAW(n + 2, par);
        {
            const int s = lane;
            const float mxe = gMXE[n], mpv = gMP[n], a_s = gA[64 * n + s]; float mxs = 0.f; if (OUT) mxs = gMX[64 * n + s];
            v4u rvv[2];
#pragma unroll
            for (int cc = 0; cc < 2; ++cc) rvv[cc] = *(const LAS v4u*)(L + MX_RAWV + s * 272 + (2 * w + cc) * 16);
#pragma unroll
            for (int qk = (OUT ? 0 : 1); qk < 2; ++qk) {
                const int cb0 = 64 * qk + 8 * w;
                v4u rw[4]; f32x4 cw4[5][2];
#pragma unroll
                for (int j = 0; j < 4; ++j) rw[j] = *(const LAS v4u*)(L + MX_RAWQK + (s + j) * 272 + cb0 * 2);
#pragma unroll
                for (int j = 0; j < 5; ++j) { cw4[j][0] = *(const LAS f32x4*)(cwb + j * 128 + cb0); cw4[j][1] = *(const LAS f32x4*)(cwb + j * 128 + cb0 + 4); }
                MX_LDS_FENCE();
                float acc[8];
#pragma unroll
                for (int e = 0; e < 8; ++e) acc[e] = cw4[4][e >> 2][e & 3];
#pragma unroll
                for (int j = 0; j < 4; ++j)
#pragma unroll
                    for (int e2 = 0; e2 < 4; ++e2) { const unsigned x = rw[j][e2];
                        acc[2 * e2] = __builtin_fmaf(cw4[j][(2 * e2) >> 2][(2 * e2) & 3], __uint_as_float(x << 16), acc[2 * e2]);
                        acc[2 * e2 + 1] = __builtin_fmaf(cw4[j][(2 * e2 + 1) >> 2][(2 * e2 + 1) & 3], __uint_as_float(x & 0xffff0000u), acc[2 * e2 + 1]); }
#pragma unroll
                for (int e = 0; e < 8; ++e) acc[e] = acc[e] * __builtin_amdgcn_rcpf(1.0f + fexp(-acc[e]));
                if (qk == 0) {
                    const float wi = fexp(mpv - mxs);
                    v4u o; o.x = pkbf(acc[0], acc[1]); o.y = pkbf(acc[2], acc[3]); o.z = pkbf(acc[4], acc[5]); o.w = pkbf(acc[6], acc[7]);
                    *(LAS v4u*)(L + MX_QS + (s * 72 + 8 * w) * 2) = o;
                    v4u p; p.x = pkbf(acc[0] * wi, acc[1] * wi); p.y = pkbf(acc[2] * wi, acc[3] * wi); p.z = pkbf(acc[4] * wi, acc[5] * wi); p.w = pkbf(acc[6] * wi, acc[7] * wi);
                    *(LAS v4u*)(L + MX_QP + (s * 72 + 8 * w) * 2) = p;
                } else {
                    const float kwt = 0.125f * fexp(a_s - mxe);
                    if (OUT) { v4u o; o.x = pkbf(acc[0] * 0.125f, acc[1] * 0.125f); o.y = pkbf(acc[2] * 0.125f, acc[3] * 0.125f); o.z = pkbf(acc[4] * 0.125f, acc[5] * 0.125f); o.w = pkbf(acc[6] * 0.125f, acc[7] * 0.125f);
                        *(LAS v4u*)(L + MX_KS + (s * 72 + 8 * w) * 2) = o; }
#pragma unroll
                    for (int e2 = 0; e2 < 4; ++e2) { const unsigned pk = pkbf(acc[2 * e2] * kwt, acc[2 * e2 + 1] * kwt);
                        ((LAS bf16*)(L + MX_KWT))[(8 * w + 2 * e2) * 72 + s] = (bf16)(pk & 0xffffu); ((LAS bf16*)(L + MX_KWT))[(8 * w + 2 * e2 + 1) * 72 + s] = (bf16)(pk >> 16); }
                }
            }
#pragma unroll
            for (int cc = 0; cc < 2; ++cc) { const int c = 2 * w + cc; const v4u rw = rvv[cc];
#pragma unroll
                for (int e2 = 0; e2 < 4; ++e2) { ((LAS bf16*)(L + MX_VST))[(8 * c + 2 * e2) * 72 + s] = (bf16)(rw[e2] & 0xffffu); ((LAS bf16*)(L + MX_VST))[(8 * c + 2 * e2 + 1) * 72 + s] = (bf16)(rw[e2] >> 16); } }
        }
        __syncthreads();
        if (OUT) {
            const int mt = w >> 1;
#pragma unroll
            for (int ni = 0; ni < 2; ++ni) { const int nt = 2 * (w & 1) + ni; f32x4 sa = (f32x4){0.f, 0.f, 0.f, 0.f};
#pragma unroll
                for (int ks = 0; ks < 2; ++ks) { const bf16x8 av = *(const LAS bf16x8*)(L + MX_QS + ((16 * mt + l15) * 72 + 32 * ks + 8 * lq) * 2), bv = *(const LAS bf16x8*)(L + MX_KS + ((16 * nt + l15) * 72 + 32 * ks + 8 * lq) * 2);
                    sa = __builtin_amdgcn_mfma_f32_16x16x32_bf16(av, bv, sa, 0, 0, 0); }
                const int s = 16 * nt + l15; const float a_s = gA[64 * n + s]; const f32x4 mx4 = *(const LAS f32x4*)(gMX + 64 * n + 16 * mt + 4 * lq);
                float sw[4];
#pragma unroll
                for (int r = 0; r < 4; ++r) { const int t = 16 * mt + 4 * lq + r; sw[r] = (s <= t) ? sa[r] * fexp(a_s - mx4[r]) : 0.f; }
                const unsigned p01 = pkbf(sw[0], sw[1]), p23 = pkbf(sw[2], sw[3]); const int t0 = 16 * mt + 4 * lq;
                ((LAS bf16*)(L + MX_SS))[(t0 + 0) * 72 + s] = (bf16)(p01 & 0xffffu); ((LAS bf16*)(L + MX_SS))[(t0 + 1) * 72 + s] = (bf16)(p01 >> 16);
                ((LAS bf16*)(L + MX_SS))[(t0 + 2) * 72 + s] = (bf16)(p23 & 0xffffu); ((LAS bf16*)(L + MX_SS))[(t0 + 3) * 72 + s] = (bf16)(p23 >> 16); }
            __syncthreads();
            f32x4 na[4], da = (f32x4){0.f, 0.f, 0.f, 0.f};
#pragma unroll
            for (int i = 0; i < 4; ++i) na[i] = (f32x4){0.f, 0.f, 0.f, 0.f};
#pragma unroll
            for (int ks = 0; ks < 4; ++ks) {
                const int aoff = (ks < 2 ? MX_SS : MX_QP) + ((16 * mt + l15) * 72 + 32 * (ks & 1) + 8 * lq) * 2, bbase = (ks < 2 ? MX_VST : MX_CST) + (32 * (ks & 1) + 8 * lq) * 2;
                const bf16x8 av = *(const LAS bf16x8*)(L + aoff);
#pragma unroll
                for (int i = 0; i < 4; ++i) { const int nt = 4 * (w & 1) + i; const bf16x8 bv = *(const LAS bf16x8*)(L + bbase + (16 * nt + l15) * 144);
                    na[i] = __builtin_amdgcn_mfma_f32_16x16x32_bf16(av, bv, na[i], 0, 0, 0); }
                if ((w & 1) == 0) { const bf16x8 bv = *(const LAS bf16x8*)(L + bbase + (128 + l15) * 144); da = __builtin_amdgcn_mfma_f32_16x16x32_bf16(av, bv, da, 0, 0, 0); }
            }
#pragma unroll
            for (int i = 0; i < 4; ++i) { const int nt = 4 * (w & 1) + i;
#pragma unroll
                for (int r = 0; r < 4; ++r) ((LAS float*)(L + MX_HS))[(16 * mt + 4 * lq + r) * 132 + 16 * nt + l15] = na[i][r]; }
            if ((w & 1) == 0 && l15 == 0) {
#pragma unroll
                for (int r = 0; r < 4; ++r) ((LAS float*)(L + MX_DEN))[16 * mt + 4 * lq + r] = da[r]; }
        }
        {
            const float dec = fexp(gMP[n] - gMXE[n]);
#pragma unroll
            for (int mt2 = 0; mt2 < 4; ++mt2) cacc[mt2] = cacc[mt2] * dec;
            nacc = nacc * dec;
#pragma unroll
            for (int ks = 0; ks < 2; ++ks) { const bf16x8 bv = *(const LAS bf16x8*)(L + MX_VST + ((16 * w + l15) * 72 + 32 * ks + 8 * lq) * 2);
#pragma unroll
                for (int mt2 = 0; mt2 < 4; ++mt2) { const bf16x8 av = *(const LAS bf16x8*)(L + MX_KWT + ((16 * mt2 + l15) * 72 + 32 * ks + 8 * lq) * 2);
                    cacc[mt2] = __builtin_amdgcn_mfma_f32_16x16x32_bf16(av, bv, cacc[mt2], 0, 0, 0); }
                if (w < 4) { const bf16x8 av = *(const LAS bf16x8*)(L + MX_KWT + ((16 * w + l15) * 72 + 32 * ks + 8 * lq) * 2), bn = *(const LAS bf16x8*)(L + MX_VST + ((128 + l15) * 72 + 32 * ks + 8 * lq) * 2);
                    nacc = __builtin_amdgcn_mfma_f32_16x16x32_bf16(av, bn, nacc, 0, 0, 0); } }
        }
        __syncthreads();
        if (OUT) {
#pragma unroll
            for (int mt2 = 0; mt2 < 4; ++mt2) { unsigned long long v = (unsigned long long)pkbf(cacc[mt2][0], cacc[mt2][1]) | ((unsigned long long)pkbf(cacc[mt2][2], cacc[mt2][3]) << 32);
                *(LAS unsigned long long*)(L + MX_CST + ((16 * w + l15) * 72 + 16 * mt2 + 4 * lq) * 2) = v; }
            if (w < 4) { unsigned long long v = (unsigned long long)pkbf(nacc[0], nacc[1]) | ((unsigned long long)pkbf(nacc[2], nacc[3]) << 32);
                *(LAS unsigned long long*)(L + MX_CST + ((128 + l15) * 72 + 16 * w + 4 * lq) * 2) = v; }
            f32x4 hh[2][2]; float dn[2], flr[2];
#pragma unroll
            for (int k = 0; k < 2; ++k) { const int id = tid + 512 * k, t = id >> 4, c = id & 15;
                hh[k][0] = *(const LAS f32x4*)(L + MX_HS + (t * 132 + 8 * c) * 4); hh[k][1] = *(const LAS f32x4*)(L + MX_HS + (t * 132 + 8 * c + 4) * 4);
                dn[k] = ((const LAS float*)(L + MX_DEN))[t]; flr[k] = gFL[64 * n + t]; }
            MX_LDS_FENCE();
#pragma unroll
            for (int k = 0; k < 2; ++k) { const int id = tid + 512 * k, t = id >> 4, c = id & 15;
                const float inv = __builtin_amdgcn_rcpf(fmaxf(fabsf(dn[k]), flr[k]));
                float hv[8] = {hh[k][0][0] * inv, hh[k][0][1] * inv, hh[k][0][2] * inv, hh[k][0][3] * inv, hh[k][1][0] * inv, hh[k][1][1] * inv, hh[k][1][2] * inv, hh[k][1][3] * inv};
                float sm = 0.f;
#pragma unroll
                for (int e = 0; e < 8; ++e) sm += hv[e];
                sm = row_sum16(sm);
                const float mean = sm * (1.f / 128.f); float q = 0.f;
#pragma unroll
                for (int e = 0; e < 8; ++e) { hv[e] -= mean; q = __builtin_fmaf(hv[e], hv[e], q); }
                q = row_sum16(q);
                const float rstd = rsqrtf(q * (1.f / 128.f) + LN_EPS);
                float yv[8];
#pragma unroll
                for (int e2 = 0; e2 < 4; ++e2) { const unsigned x = ro[k][e2]; const float o0 = __uint_as_float(x << 16), o1 = __uint_as_float(x & 0xffff0000u);
                    yv[2 * e2] = hv[2 * e2] * rstd * gain[2 * e2] * __builtin_amdgcn_rcpf(1.0f + fexp(-o0)); yv[2 * e2 + 1] = hv[2 * e2 + 1] * rstd * gain[2 * e2 + 1] * __builtin_amdgcn_rcpf(1.0f + fexp(-o1)); }
                v4u o; o.x = pkbf(yv[0], yv[1]); o.y = pkbf(yv[2], yv[3]); o.z = pkbf(yv[4], yv[5]); o.w = pkbf(yv[6], yv[7]);
                *(GAS v4u*)(Y + (gr_seg + 64 * n + t) * DM + 512 + 128 * h + 8 * c) = o; }
            if (n + 1 < 8) MX_LOAD_O(n + 1);
            __syncthreads();
        }
    }
    }
    if (!OUT) {
        float* st = ST + (size_t)u * ST_FLOATS;
#pragma unroll
        for (int mt = 0; mt < 4; ++mt)
#pragma unroll
            for (int r = 0; r < 4; ++r) st[(16 * mt + 4 * lq + r) * 144 + 16 * w + l15] = cacc[mt][r];
        if (w < 4) {
#pragma unroll
            for (int r = 0; r < 4; ++r) st[(16 * w + 4 * lq + r) * 144 + 128 + l15] = nacc[r]; }
    }
    __syncthreads();
}

constexpr int SG_VNT = 0, SG_SOUT = 34816, SG_RAW = 34816;
__device__ __forceinline__ void sgu_phase(Frame& F, const Args& args, int l) {
    const int tid = F.tid, lane = F.lane, w = F.wave, l15 = lane & 15, lq = lane >> 4;
    unsigned char* ws = F.ws; const bf16* Z = (const bf16*)(ws + WS_Z); bf16* Y = (bf16*)(ws + WS_Y);
    LAS unsigned char* L = F.lds;
    const int h = F.vcu & 3;
    const float* sw = INP(6) + ((size_t)l * 4 + h) * 128 * 128; const float* sb = INP(7) + (l * 4 + h) * 128;
    const float* lg = INP(8) + (l * 4 + h) * 128; const float* lb = INP(9) + (l * 4 + h) * 128;
    bf16x8 wa[4];
#pragma unroll
    for (int ks = 0; ks < 4; ++ks) { const float* p = sw + (size_t)(16 * w + l15) * 128 + 32 * ks + 8 * lq; const f32x4 a = *(const GAS f32x4*)p, b = *(const GAS f32x4*)(p + 4);
        v4u o; o.x = pkbf(a[0], a[1]); o.y = pkbf(a[2], a[3]); o.z = pkbf(b[0], b[1]); o.w = pkbf(b[2], b[3]);
        if (w < 4 && ks >= 2) o = (v4u){0u, 0u, 0u, 0u};
        wa[ks] = __builtin_bit_cast(bf16x8, o); }
    float bsr[4];
#pragma unroll
    for (int r = 0; r < 4; ++r) bsr[r] = sb[16 * w + 4 * lq + r];
    float lgv[8], lbv[8];
#pragma unroll
    for (int e = 0; e < 8; ++e) { lgv[e] = lg[8 * (tid & 15) + e]; lbv[e] = lb[8 * (tid & 15) + e]; }
    v4u pv_[4], pu_[4];
#pragma unroll
    for (int k = 0; k < 4; ++k) { const int id = tid + 512 * k; pv_[k] = *(const GAS v4u*)(Z + ((size_t)((F.vcu >> 2) * 4) * 128 + (id >> 4)) * ZW + 512 + 128 * h + 8 * (id & 15)); }
#pragma unroll 1
    for (int it = 0; it < 4; ++it) {
        const int blk = (F.vcu >> 2) * 4 + it;
        const size_t r0 = (size_t)blk * 128;
#pragma unroll
        for (int k = 0; k < 4; ++k) { const int id = tid + 512 * k; pu_[k] = *(const GAS v4u*)(Z + (r0 + (id >> 4)) * ZW + 128 * h + 8 * (id & 15)); }
#pragma unroll
        for (int k = 0; k < 4; ++k) { const int id = tid + 512 * k, j = id >> 4, c = id & 15;
            const v4u rw = pv_[k];
            float v[8];
#pragma unroll
            for (int e2 = 0; e2 < 4; ++e2) { v[2 * e2] = __uint_as_float(rw[e2] << 16); v[2 * e2 + 1] = __uint_as_float(rw[e2] & 0xffff0000u); }
            float sm = 0.f;
#pragma unroll
            for (int e = 0; e < 8; ++e) sm += v[e];
            sm = row_sum16(sm);
            const float mean = sm * (1.f / 128.f); float q = 0.f;
#pragma unroll
            for (int e = 0; e < 8; ++e) { v[e] -= mean; q = __builtin_fmaf(v[e], v[e], q); }
            q = row_sum16(q);
            const float rstd = rsqrtf(q * (1.f / 128.f) + LN_EPS);
#pragma unroll
            for (int e = 0; e < 8; ++e) v[e] = v[e] * rstd * lgv[e] + lbv[e];
            v4u o; o.x = pkbf(v[0], v[1]); o.y = pkbf(v[2], v[3]); o.z = pkbf(v[4], v[5]); o.w = pkbf(v[6], v[7]);
            *(LAS v4u*)(L + SG_RAW + j * 272 + c * 16) = o; }
        if (it + 1 < 4) {
#pragma unroll
            for (int k = 0; k < 4; ++k) { const int id = tid + 512 * k; pv_[k] = *(const GAS v4u*)(Z + (r0 + 128 + (id >> 4)) * ZW + 512 + 128 * h + 8 * (id & 15)); } }
        __syncthreads();
#pragma unroll
        for (int k = 0; k < 4; ++k) { const int id = w + 8 * k;
            const int c = id & 15, j = 64 * (id >> 4) + lane; const v4u rw = *(const LAS v4u*)(L + SG_RAW + j * 272 + c * 16);
#pragma unroll
            for (int e2 = 0; e2 < 4; ++e2) { ((LAS bf16*)(L + SG_VNT))[(8 * c + 2 * e2) * 136 + j] = (bf16)(rw[e2] & 0xffffu); ((LAS bf16*)(L + SG_VNT))[(8 * c + 2 * e2 + 1) * 136 + j] = (bf16)(rw[e2] >> 16); } }
        __syncthreads();
        {
            f32x4 sa[8];
#pragma unroll
            for (int nt = 0; nt < 8; ++nt) sa[nt] = (f32x4){0.f, 0.f, 0.f, 0.f};
#pragma unroll
            for (int ks = 0; ks < 4; ++ks) {
                if (ks < 2 || w >= 4) {
#pragma unroll
                    for (int nt = 0; nt < 8; ++nt) { const bf16x8 bv = *(const LAS bf16x8*)(L + SG_VNT + ((16 * nt + l15) * 136 + 32 * ks + 8 * lq) * 2);
                        sa[nt] = __builtin_amdgcn_mfma_f32_16x16x32_bf16(wa[ks], bv, sa[nt], 0, 0, 0); } } }
#pragma unroll
            for (int nt = 0; nt < 8; ++nt)
#pragma unroll
                for (int r = 0; r < 4; ++r) ((LAS float*)(L + SG_SOUT))[(16 * w + 4 * lq + r) * 132 + 16 * nt + l15] = sa[nt][r] + bsr[r];
        }
        __syncthreads();
#pragma unroll
        for (int k = 0; k < 4; ++k) { const int id = tid + 512 * k, i = id >> 4, c = id & 15;
            const v4u rw = pu_[k];
            const f32x4 s0 = *(const LAS f32x4*)(L + SG_SOUT + (i * 132 + 8 * c) * 4), s1 = *(const LAS f32x4*)(L + SG_SOUT + (i * 132 + 8 * c + 4) * 4);
            v4u o; o.x = pkbf(__uint_as_float(rw[0] << 16) * s0[0], __uint_as_float(rw[0] & 0xffff0000u) * s0[1]); o.y = pkbf(__uint_as_float(rw[1] << 16) * s0[2], __uint_as_float(rw[1] & 0xffff0000u) * s0[3]);
            o.z = pkbf(__uint_as_float(rw[2] << 16) * s1[0], __uint_as_float(rw[2] & 0xffff0000u) * s1[1]); o.w = pkbf(__uint_as_float(rw[3] << 16) * s1[2], __uint_as_float(rw[3] & 0xffff0000u) * s1[3]);
            *(GAS v4u*)(Y + (r0 + i) * DM + 128 * h + 8 * c) = o; }
        __syncthreads();
    }
}
#define MIXER_PASS1 mlstm_phase<false>(F, args, l);
#define MIXER_PASS2 { mlstm_phase<true>(F, args, l); sgu_phase(F, args, l); }
__global__ void __launch_bounds__(NWAVES * 64, 2) mk_fwd(Args args) {
    extern __shared__ __attribute__((aligned(16))) unsigned char lds[];
    Frame F;
    F.lds = (LAS unsigned char*)lds;
    F.MISC = (volatile LAS unsigned*)(F.lds + MISC_OFF);
    F.tid = threadIdx.x; F.lane = F.tid & 63; F.wave = __builtin_amdgcn_readfirstlane(F.tid >> 6);
    F.G = gridDim.x; { const int bx = blockIdx.x; F.vcu = (F.G % 8 == 0) ? (bx % 8) * (F.G / 8) + bx / 8 : bx; }
    F.ws = args.ws;
    F.ctl = (gu32*)(F.ws + WS_CTL);
    for (int u = F.tid; u < (LDS_BYTES - LDSCTL_OFF) / 4; u += NWAVES * 64) ((LAS unsigned*)(F.lds + LDSCTL_OFF))[u] = 0u;
    __syncthreads();
    if (F.tid == 0) {
#pragma unroll
        for (int i = 0; i < 20; ++i) ((LAS unsigned long long*)(F.lds + PT_OFF))[i] = (unsigned long long)args.in[i];
        ((LAS unsigned long long*)(F.lds + PT_OFF))[20] = (unsigned long long)args.out; }
    __syncthreads();
    const int lo = args.ph_lo, hi = args.ph_hi;
    XcdBarrier bar; bar.bar = (unsigned*)(F.ctl + CW_BAR) + args.bar_region * XCD_BAR_WORDS; bar.x = 0; bar.st = nullptr;
    if (hi - lo > 1) bar = xcd_barrier_post((unsigned*)(F.ctl + CW_BAR) + args.bar_region * XCD_BAR_WORDS, F.MISC + 8);

#pragma unroll 1
    for (int ph = lo; ph < hi; ++ph) {
        const int l = (ph - 1) / 8, sub = (ph - 1) % 8;
        int nrep = 1;
        if (DUP_MASK && ph < NPHASE - 1) { if (ph == 0) nrep += (DUP_MASK >> 7) & 1; else nrep += (DUP_MASK >> sub) & 1; }
#pragma unroll 1
        for (int rep = 0; rep < nrep; ++rep) {
        if (ph > lo || rep) xcd_barrier(bar, F.wave == 0 && mk_lane() == 0);
        if (PROBE_CLK >= 10 && blockIdx.x == 0 && F.tid == 0) ((unsigned long long*)(F.ws + WS_CTL + 16384))[ph] = __builtin_amdgcn_s_memrealtime();
#define FRESH_LANE() do { F.lane = mk_lane(); asm volatile("" : "+v"(F.lane)); F.tid = F.wave * 64 + F.lane; } while (0)
        asm volatile("" : "+s"(F.vcu), "+s"(F.wave), "+s"(F.G));
        { unsigned long long wsi = (unsigned long long)F.ws; asm volatile("" : "+s"(wsi)); F.ws = (unsigned char*)(GAS unsigned char*)wsi; }
        unsigned char* ws = F.ws;
        bf16* XN = (bf16*)(ws + WS_XN); bf16* Z = (bf16*)(ws + WS_Z); float* GT = (float*)(ws + WS_GT); bf16* Y = (bf16*)(ws + WS_Y); bf16* H = (bf16*)(ws + WS_H);
        float* G0 = (float*)(ws + WS_G0); float* UP0 = (float*)(ws + WS_UP0);
        if (ph == 0) { FRESH_LANE(); p0_prologue(F, args); continue; }
        if (ph == NPHASE - 1) { FRESH_LANE(); final_ln_phase(F, XN, (const float*)(ws + WS_PARTB), INP(18) + (DEPTH - 1) * DM, INP(19) + (DEPTH - 1) * DM, ((float*)INP(20))); continue; }
        const unsigned char* wt = ws + WS_WT + (size_t)l * WT_LAYER;
        const float* cv = (const float*)(ws + WS_CV); float* partA = (float*)(ws + WS_PARTA); float* partB = (float*)(ws + WS_PARTB);
        if (sub == 0) {
#ifndef NO_Z
            FRESH_LANE();
            if (l == 0) cvec_finalize(F, args);
            const float* part = l > 0 ? partB : nullptr;
            pg8::Gemm g{XN, (const bf16*)(wt + WT_IN), M, ZW, DM}; pg8::StaticOrder S; S.init(M, ZW, F.G, (int)blockIdx.x);
            pg8::EpiZ E{Z, ZW, part, cv + CV_IN1, cv + CV_IN1 + 2576, F.lds + MX_TAB};
            pg8::gemm_phase<pg8::EpiZ, pg8::StaticOrder, true, true>(F.lds + RING_OFF, g, S, E, F.tid);
            FRESH_LANE();
            gates_phase(F, XN, (const bf16*)(wt + WT_G), GT, part, cv + CV_IN1 + ZW, cv + CV_IN1 + 2576 + ZW);
            if (l == 0) { FRESH_LANE(); quant_w_step(F); }
#endif
        } else if (sub == 1) {
#ifndef NO_MIX
            FRESH_LANE();
            MIXER_PASS1
#endif
        } else if (sub == 2) {
#ifndef NO_MIX
            FRESH_LANE();
            MIXER_PASS2
#endif
        } else if (sub == 3) {
#ifndef NO_RES
            FRESH_LANE();
            res_gemm_phase(F, Y, (const bf16*)(wt + WT_OUT), DM, XN, (DUP_MASK && rep == 0 && nrep == 2) ? (bf16*)(ws + 295 * MiB) : XN, l > 0 ? partB : (const float*)nullptr, INP(18) + (l > 0 ? l - 1 : 0) * DM, INP(19) + (l > 0 ? l - 1 : 0) * DM, (DUP_MASK && rep == 0 && nrep == 2) ? (float*)(ws + 400 * MiB) : partA);
#endif
        } else if (sub == 4) {
            FRESH_LANE();
            quant_a_phase(F, XN);
        } else if (sub == 5) {
#ifndef NO_GLU
            FRESH_LANE();
            pg8::Gemm g{(const bf16*)(ws + WS_V8), (const bf16*)(ws + WS_W8 + (size_t)l * 2 * DFF * DM), M, 2 * DFF, DM / 2}; pg8::StaticOrder S; S.init(M, 2 * DFF, F.G, (int)blockIdx.x);
            const float* cu = cv + (l == 0 ? CV_UP0 : CV_UP1); const float* swc = (const float*)(ws + WS_SWC) + (size_t)l * 4 * DFF;
            pg8::EpiGlu8 E{H, INP(15) + (size_t)l * 3 * DFF, INP(16) + l * DFF, G0, UP0, DFF, M / 64, partA, swc + 2 * DFF, cu + 5632, F.lds + MX_TAB, swc, (const float*)(ws + WS_SA)};
            pg8::gemm_phase<pg8::EpiGlu8, pg8::StaticOrder, true, true>(F.lds + RING_OFF, g, S, E, F.tid);
#endif
        } else if (sub == 6) {
            FRESH_LANE();
            glu_fixup_phase(F, G0, UP0, INP(15) + (size_t)l * 3 * DFF, INP(16) + l * DFF, H);
        } else {
#ifndef NO_RES
            FRESH_LANE();
            res_gemm_phase(F, H, (const bf16*)(wt + WT_DN), DFF, XN, (DUP_MASK && rep == 0 && nrep == 2) ? (bf16*)(ws + WS_T4) : XN, partA, INP(12) + l * DM, INP(13) + l * DM, (DUP_MASK && rep == 0 && nrep == 2) ? (float*)(ws + WS_T4 + 128 * MiB) : partB);
#endif
        }
        }
    }
    if (PROBE_CLK && hi == NPHASE) { xcd_barrier(bar, F.wave == 0 && mk_lane() == 0); if (blockIdx.x == 0 && F.tid == 0) {
        if (PROBE_CLK >= 10) { unsigned long long* ts = (unsigned long long*)(F.ws + WS_CTL + 16384); ts[NPHASE] = __builtin_amdgcn_s_memrealtime(); const int k = PROBE_CLK - 10;
            ((float*)INP(20))[0] += 0.1f + 1e-5f * (float)(ts[k + 1] - ts[k]); }
        else ((float*)INP(20))[0] += ((float*)(F.ws + WS_CTL))[2048]; } }
}

static void launch_mk(const Args& base, int lo, int hi, int region, hipStream_t stream) {
    Args a = base; a.ph_lo = lo; a.ph_hi = hi; a.bar_region = region; a.pad = 0;
    hipLaunchKernelGGL(mk_fwd, dim3(256), dim3(NWAVES * 64), LDS_BYTES, stream, a);
}

extern "C" void kernel_launch(void* const* d_in, const int* in_sizes, int n_in, void* d_out, int out_size, void* d_ws, size_t ws_size, hipStream_t stream) {
    static int inited = 0;
    if (!inited) {
        if (hipFuncSetAttribute((const void*)mk_fwd, hipFuncAttributeMaxDynamicSharedMemorySize, LDS_BYTES) != hipSuccess) fprintf(stderr, "kernel_launch: hipFuncSetAttribute failed\n");
        int dev = 0, cus = 0, per_cu = 0;
        if (hipGetDevice(&dev) != hipSuccess || hipDeviceGetAttribute(&cus, hipDeviceAttributeMultiprocessorCount, dev) != hipSuccess) cus = 0;
        if (hipOccupancyMaxActiveBlocksPerMultiprocessor(&per_cu, (const void*)mk_fwd, NWAVES * 64, LDS_BYTES) != hipSuccess) per_cu = 0;
        (void)hipGetLastError();
        if (cus * per_cu < 256) fprintf(stderr, "kernel_launch: %d CUs x %d resident workgroups per CU < the 256 workgroups this kernel's grid barriers need\n", cus, per_cu);
        inited = 1;
    }
    unsigned char* ws = (unsigned char*)d_ws;
    (void)hipMemsetAsync(ws + WS_CTL, 0, CTL_ZERO_BYTES, stream);
    Args a{};
    for (int i = 0; i < 20; ++i) a.in[i] = (const float*)d_in[i];
    a.out = (float*)d_out; a.ws = ws;
    launch_mk(a, 0, NPHASE, 0, stream);
}
```

```cpp
constexpr int PROBE_CLK = 0;
constexpr int PROBE_NULL = 0;
constexpr int DUP_MASK = 0;
#include <hip/hip_runtime.h>
#include <cstdint>
#include <cstdio>

constexpr int BATCH = 4, SEQ = 8192, DM = 1024, M = BATCH * SEQ, DEPTH = 2;
constexpr int DA = 512, DQK = 256, DB = 512, NH = 4;
constexpr int DIN = 2568, ZW = 2560, DFF = 2816;
constexpr float LN_EPS = 1e-5f, ALPHA = 1.41421356237f;

typedef unsigned short bf16;
typedef unsigned u32x4 __attribute__((ext_vector_type(4)));

__device__ __forceinline__ float bf2f(bf16 v) { return __uint_as_float(((unsigned)v) << 16); }
__device__ __forceinline__ bf16 f2bf(float f) { unsigned u = __float_as_uint(f); return (bf16)((u + 0x7fffu + ((u >> 16) & 1u)) >> 16); }
__device__ __forceinline__ float gelu_f(float x) { return 0.5f * x * (1.0f + erff(x * 0.70710678118f)); }
__device__ __forceinline__ float silu_f(float x) { return x / (1.0f + expf(-x)); }
__device__ __forceinline__ float sigmoid_f(float x) { return 1.0f / (1.0f + expf(-x)); }
__device__ __forceinline__ float logsigmoid_f(float x) { return fminf(x, 0.f) - log1pf(expf(-fabsf(x))); }

constexpr size_t MiB = 1u << 20;
constexpr size_t WS_XN = 0;
constexpr size_t WS_Z = 64 * MiB;
constexpr size_t WS_GT = 224 * MiB;
constexpr size_t WS_Y = 225 * MiB;
constexpr size_t WS_HM = 289 * MiB;
constexpr size_t WS_QC = 353 * MiB;
constexpr size_t WS_KC = 385 * MiB;
constexpr size_t WS_IG = 417 * MiB;
constexpr size_t WS_LF = 417 * MiB + 512 * 1024;
constexpr size_t WS_T3 = 64 * MiB;
constexpr size_t WS_H = 64 * MiB;
constexpr size_t WS_T4 = 240 * MiB;
constexpr size_t WS_T5 = 240 * MiB;


__device__ __forceinline__ int mk_lane() { return (int)__builtin_amdgcn_mbcnt_hi(~0u, __builtin_amdgcn_mbcnt_lo(~0u, 0u)); }
namespace pg8 {
#define PG8_LAS __attribute__((address_space(3)))
typedef unsigned short bf16_t;
typedef short bf16x8 __attribute__((ext_vector_type(8)));
typedef float f32x4 __attribute__((ext_vector_type(4)));
typedef unsigned u32x4 __attribute__((ext_vector_type(4)));
typedef int i32x4 __attribute__((ext_vector_type(4)));
constexpr int BM = 256, BK = 64, HALF = 128, HTB = HALF * BK * 2  , STAGE_BYTES = 8 * HTB, NXCD = 8, WGM = 8;

__host__ __device__ __forceinline__ int lds_byte(int r, int c) { const int st = (r >> 4) * 2 + (c >> 5), rr = r & 15, cc = c & 31, ob = rr * 64 + cc * 2; return st * 1024 + (ob ^ (((ob >> 9) & 1) << 5)); }
__host__ __device__ __forceinline__ void stage_rc(int b, int& R, int& C) { const int st = b / 1024, sb = b % 1024, swz = sb ^ (((sb >> 9) & 1) << 5); R = (st >> 1) * 16 + swz / 64; C = (st & 1) * 32 + (swz % 64) / 2; }
__host__ __device__ __forceinline__ int perm32(int rho) { const int n = rho >> 4, i = rho & 15; return 8 * (i >> 2) + 4 * n + (i & 3); }

struct Unit { int pm, pn; };
struct Gemm { const bf16_t* A; const bf16_t* Bt; int M, N, K; };

struct StaticOrder {
    int nM, nN, nwg, G, c;
    __host__ __device__ void init(int M, int N, int G_, int c_) { nM = M / BM; nN = N / BM; nwg = nM * nN; G = G_; c = c_; }
    __host__ __device__ bool next(int i, Unit& u) const {
        const long L = (long)i * G + c; if (L >= nwg) return false;
        int wgid = (int)L; { const int q = nwg / NXCD, r = nwg % NXCD, xcd = wgid % NXCD, off = wgid / NXCD; wgid = (xcd < r ? xcd * (q + 1) : r * (q + 1) + (xcd - r) * q) + off; }
        const int nig = WGM * nN, gid = wgid / nig, fm = gid * WGM, gsz = (nM - fm) < WGM ? (nM - fm) : WGM;
        u.pm = fm + ((wgid % nig) % gsz); u.pn = (wgid % nig) / gsz; return true;
    }
    __device__ __forceinline__ void a_ready(const Unit&) const {}
    __device__ __forceinline__ void done(const Unit&) const {}
};

__device__ __forceinline__ unsigned cvt_pk_bf16(float lo, float hi) { unsigned r; asm volatile("v_cvt_pk_bf16_f32 %0, %1, %2" : "=v"(r) : "v"(lo), "v"(hi)); return r; }
typedef float f32x2 __attribute__((ext_vector_type(2)));
__device__ __forceinline__ f32x2 gelu_pk(f32x2 v) {
    const f32x2 av = __builtin_elementwise_abs(v), d = av * 0.2316418882f + 1.0f;
    f32x2 t; t.x = __builtin_amdgcn_rcpf(d.x); t.y = __builtin_amdgcn_rcpf(d.y);
    f32x2 q = t * 0.5307027145f + (-0.7265760135f); q = q * t + 0.7107068705f; q = q * t + (-0.142248368f); q = q * t + 0.127414796f; q = q * t;
    const f32x2 s = (v * v) * (-0.72134752044f);
    f32x2 e; e.x = __builtin_amdgcn_exp2f(s.x); e.y = __builtin_amdgcn_exp2f(s.y);
    const f32x2 m = v * (q * e), r = v - m;
    f32x2 o; o.x = v.x < 0.f ? m.x : r.x; o.y = v.y < 0.f ? m.y : r.y; return o;
}

constexpr float K_EPS = 1e-5f, K_ALPHA = 1.41421356237f;
struct RowStat { float nmr, r; };
constexpr int TAB_STAT = 0, TAB_CONST = 8192, TAB_P = 12288, TAB_P2 = 20480, TAB_SW = 12288, TAB_R4 = 24576, TAB_SA = 28672;
__device__ __forceinline__ void glds16(const void* gsrc, PG8_LAS unsigned char* ldst) { __builtin_amdgcn_global_load_lds((const unsigned*)gsrc, (PG8_LAS unsigned*)ldst, 16, 0, 0); }
__device__ __forceinline__ void prefetch_stats(const float* part, int pm, PG8_LAS unsigned char* tab, int wid, int lane) {
    glds16(part + ((size_t)pm * BM + 32 * wid) * 8 + 4 * lane, tab + TAB_STAT + wid * 1024);
}
__device__ __forceinline__ RowStat row_stat_lds(const PG8_LAS unsigned char* tab, int rloc, float eps) {
    const f32x4 a = *(const PG8_LAS f32x4*)(tab + TAB_STAT + rloc * 32), b = *(const PG8_LAS f32x4*)(tab + TAB_STAT + rloc * 32 + 16);
    const float mean = ((a[0] + a[2]) + (b[0] + b[2])) * 0.25f;
    const float d0 = a[0] - mean, d1 = a[2] - mean, d2 = b[0] - mean, d3 = b[2] - mean;
    const float m2 = ((a[1] + a[3]) + (b[1] + b[3])) + 256.0f * ((d0 * d0 + d1 * d1) + (d2 * d2 + d3 * d3));
    RowStat o; o.r = __builtin_amdgcn_rsqf(m2 * (1.0f / 1024.0f) + eps); o.nmr = -mean * o.r; return o;
}
__device__ __forceinline__ void finalize_stats(PG8_LAS unsigned char* tab, int tid, int slot = TAB_P) {
    typedef float f32x2v __attribute__((ext_vector_type(2)));
    if (tid < 256) { const RowStat rs = row_stat_lds(tab, tid, K_EPS); *(PG8_LAS f32x2v*)(tab + slot + 8 * tid) = (f32x2v){rs.nmr, rs.r}; }
}
__device__ __forceinline__ RowStat stat_tab(const PG8_LAS unsigned char* tab, int rloc, int slot = TAB_P) {
    typedef float f32x2v __attribute__((ext_vector_type(2)));
    const f32x2v v = *(const PG8_LAS f32x2v*)(tab + slot + 8 * rloc); RowStat o; o.nmr = v.x; o.r = v.y; return o;
}
__device__ __forceinline__ float sum_fq4(float x) {
    auto a = __builtin_amdgcn_permlane16_swap(__float_as_uint(x), __float_as_uint(x), false, false); const float y = __uint_as_float(a[0]) + __uint_as_float(a[1]);
    auto b = __builtin_amdgcn_permlane32_swap(__float_as_uint(y), __float_as_uint(y), false, false); return __uint_as_float(b[0]) + __uint_as_float(b[1]);
}
__device__ __forceinline__ RowStat row_stat(const float* part, size_t row, float eps) {
    const f32x4 a = *(const f32x4*)(part + row * 8), b = *(const f32x4*)(part + row * 8 + 4);
    const float mean = ((a[0] + a[2]) + (b[0] + b[2])) * 0.25f;
    const float d0 = a[0] - mean, d1 = a[2] - mean, d2 = b[0] - mean, d3 = b[2] - mean;
    const float m2 = ((a[1] + a[3]) + (b[1] + b[3])) + 256.0f * ((d0 * d0 + d1 * d1) + (d2 * d2 + d3 * d3));
    RowStat o; o.r = 1.0f / sqrtf(m2 * (1.0f / 1024.0f) + eps); o.nmr = -mean * o.r; return o;
}
__device__ __forceinline__ f32x2 gelu_ns_pk(f32x2 v) {
    const f32x2 av = __builtin_elementwise_abs(v), d = av * 0.2316418882f + 1.0f;
    f32x2 t; t.x = __builtin_amdgcn_rcpf(d.x); t.y = __builtin_amdgcn_rcpf(d.y);
    f32x2 q = t * 0.5307027145f + (-0.7265760135f); q = q * t + 0.7107068705f; q = q * t + (-0.142248368f); q = q * t + 0.127414796f; q = q * t;
    const f32x2 s = (v * v) * (-0.72134752044f);
    f32x2 e; e.x = __builtin_amdgcn_exp2f(s.x); e.y = __builtin_amdgcn_exp2f(s.y);
    return __builtin_elementwise_max(v, (f32x2){0.f, 0.f}) - av * (q * e);
}
struct EpiZ {
    static constexpr bool PERM = true, AFTER_DRAIN = false, PERM_A = false, I8 = false;
    bf16_t* O; int ldc; const float* part; const float* c1; const float* c0; PG8_LAS unsigned char* tab;
    __device__ __forceinline__ void prefetch(const Unit& u, int wid, int lane) const {
        if (part) { prefetch_stats(part, u.pm, tab, wid, lane);
            if (wid < 2) glds16((wid ? c0 : c1) + u.pn * BM + 4 * lane, tab + TAB_CONST + wid * 1024); }
    }
    __device__ __forceinline__ void operator()(f32x4 (&acc)[2][2][4][2], const Unit& u, int wr, int wc, int fr, int fq) const {
        const int row0 = u.pm * BM + wr * 64 + fr, col0 = u.pn * BM + wc * 32 + 8 * fq, cl0 = wc * 32 + 8 * fq;
        const bool act = u.pn < 4;
        if (part) { finalize_stats(tab, (wr * 4 + wc) * 64 + fr + 16 * fq); asm volatile("s_waitcnt lgkmcnt(0)" ::: "memory"); __builtin_amdgcn_s_barrier(); asm volatile("" ::: "memory"); }
#pragma unroll
        for (int ai = 0; ai < 2; ++ai)
#pragma unroll
            for (int m = 0; m < 4; ++m) { const int rloc = ai * HALF + wr * 64 + m * 16 + fr; bf16_t* rowp = O + (size_t)(u.pm * BM + rloc) * ldc + col0;
                RowStat rs; rs.r = 1.f; rs.nmr = 0.f; if (part) rs = stat_tab(tab, rloc);
#pragma unroll
                for (int bj = 0; bj < 2; ++bj) { u32x4 w;
#pragma unroll
                    for (int n = 0; n < 2; ++n) { f32x4 v = acc[ai][bj][m][n];
                        if (part) { const f32x4 k1 = *(const PG8_LAS f32x4*)(tab + TAB_CONST + (cl0 + bj * HALF + 4 * n) * 4), k0 = *(const PG8_LAS f32x4*)(tab + TAB_CONST + 1024 + (cl0 + bj * HALF + 4 * n) * 4);
                            v = v * rs.r + (k1 * rs.nmr + k0); }
                        if (act) { const f32x2 a = gelu_ns_pk((f32x2){v[0], v[1]}), b = gelu_ns_pk((f32x2){v[2], v[3]}); v = (f32x4){a.x, a.y, b.x, b.y}; }
                        w[2 * n] = cvt_pk_bf16(v[0], v[1]); w[2 * n + 1] = cvt_pk_bf16(v[2], v[3]); }
                    *(u32x4*)(rowp + bj * HALF) = w; }
                asm volatile("" ::: "memory"); }
    }
};

struct EpiRes {
    static constexpr bool PERM = true, AFTER_DRAIN = false, PERM_A = false, I8 = false;
    bf16_t* V; bf16_t* Vout; int ldc; const float* part_prev; const float* gp; const float* bp; float* part_new; PG8_LAS unsigned char* tab;
    __device__ __forceinline__ void prefetch(const Unit& u, int wid, int lane) const {
        if (part_prev) { prefetch_stats(part_prev, u.pm, tab, wid, lane);
            if (wid < 2) glds16((wid ? bp : gp) + u.pn * BM + 4 * lane, tab + TAB_CONST + wid * 1024); }
    }
    __device__ __forceinline__ void operator()(f32x4 (&acc)[2][2][4][2], const Unit& u, int wr, int wc, int fr, int fq) const {
        typedef float f32x2v __attribute__((ext_vector_type(2)));
        const int col0 = u.pn * BM + wc * 32 + 8 * fq, cl0 = wc * 32 + 8 * fq, lane = fr + 16 * fq, wid = wr * 4 + wc;
        PG8_LAS f32x2v* P = (PG8_LAS f32x2v*)(tab + TAB_P);
        u32x4 bwv[2][4][2];
#pragma unroll
        for (int ai = 0; ai < 2; ++ai)
#pragma unroll
            for (int m = 0; m < 4; ++m)
#pragma unroll
                for (int bj = 0; bj < 2; ++bj) bwv[ai][m][bj] = *(const u32x4*)(V + (size_t)(u.pm * BM + ai * HALF + wr * 64 + m * 16 + fr) * ldc + col0 + bj * HALF);
        asm volatile("" ::: "memory");
        if (part_prev) { finalize_stats(tab, wid * 64 + lane, TAB_P2); asm volatile("s_waitcnt lgkmcnt(0)" ::: "memory"); __builtin_amdgcn_s_barrier(); asm volatile("" ::: "memory"); }
#pragma unroll
        for (int ai = 0; ai < 2; ++ai)
#pragma unroll
            for (int m = 0; m < 4; ++m) { const int rloc = ai * HALF + wr * 64 + m * 16 + fr; bf16_t* rowp = V + (size_t)(u.pm * BM + rloc) * ldc + col0; bf16_t* rowo = Vout + (size_t)(u.pm * BM + rloc) * ldc + col0;
                RowStat rs; rs.r = 1.f; rs.nmr = 0.f; if (part_prev) rs = stat_tab(tab, rloc, TAB_P2);
                float sm = 0.f;
#pragma unroll
                for (int bj = 0; bj < 2; ++bj) { const u32x4 bw = bwv[ai][m][bj];
#pragma unroll
                    for (int n = 0; n < 2; ++n) { const unsigned lo = bw[2 * n], hi = bw[2 * n + 1];
                        f32x4 xs = (f32x4){__uint_as_float(lo << 16), __uint_as_float(lo & 0xffff0000u), __uint_as_float(hi << 16), __uint_as_float(hi & 0xffff0000u)};
                        if (part_prev) { const f32x4 gv = *(const PG8_LAS f32x4*)(tab + TAB_CONST + (cl0 + bj * HALF + 4 * n) * 4), bv = *(const PG8_LAS f32x4*)(tab + TAB_CONST + 1024 + (cl0 + bj * HALF + 4 * n) * 4);
                            xs = (xs * rs.r + rs.nmr) * gv + bv; }
                        const f32x4 v = xs * K_ALPHA + acc[ai][bj][m][n]; acc[ai][bj][m][n] = v; sm += (v[0] + v[1]) + (v[2] + v[3]); } }
                sm = sum_fq4(sm);
                const float mw = sm * (1.0f / 64.0f); float q = 0.f;
#pragma unroll
                for (int bj = 0; bj < 2; ++bj)
#pragma unroll
                    for (int n = 0; n < 2; ++n) { const f32x4 d = acc[ai][bj][m][n] - mw; q += (d[0] * d[0] + d[1] * d[1]) + (d[2] * d[2] + d[3] * d[3]); }
                q = sum_fq4(q);
                if (fq == 0) P[rloc * 4 + wc] = (f32x2v){mw, q};
#pragma unroll
                for (int bj = 0; bj < 2; ++bj) { const f32x4 v0 = acc[ai][bj][m][0], v1 = acc[ai][bj][m][1];
                    u32x4 w; w.x = cvt_pk_bf16(v0[0], v0[1]); w.y = cvt_pk_bf16(v0[2], v0[3]); w.z = cvt_pk_bf16(v1[0], v1[1]); w.w = cvt_pk_bf16(v1[2], v1[3]);
                    *(u32x4*)(rowo + bj * HALF) = w; }
                asm volatile("" ::: "memory"); }
        asm volatile("s_waitcnt lgkmcnt(0)" ::: "memory"); __builtin_amdgcn_s_barrier(); asm volatile("" ::: "memory");
        { const int row = wid * 32 + (lane & 31);
          if (lane < 32) { const f32x2v a = P[row * 4 + 0], b = P[row * 4 + 1], c = P[row * 4 + 2], d = P[row * 4 + 3];
            const float mt = (a.x + b.x + c.x + d.x) * 0.25f; const float da = a.x - mt, db = b.x - mt, dc = c.x - mt, dd = d.x - mt;
            const float m2 = (a.y + b.y) + (c.y + d.y) + 64.0f * ((da * da + db * db) + (dc * dc + dd * dd));
            *(f32x2v*)(part_new + (size_t)(u.pm * BM + row) * 8 + 2 * u.pn) = (f32x2v){mt, m2}; } }
    }
};

#define PG8_DPP0(src, ctrl) __builtin_bit_cast(float, __builtin_amdgcn_update_dpp(0, __builtin_bit_cast(int, (float)(src)), (ctrl), 0xf, 0xf, true))
__device__ __forceinline__ f32x2 gelu_mul_pk(f32x2 v, f32x2 u) {
    const f32x2 av = __builtin_elementwise_abs(v), d = av * 0.2316418882f + 1.0f;
    f32x2 t; t.x = __builtin_amdgcn_rcpf(d.x); t.y = __builtin_amdgcn_rcpf(d.y);
    f32x2 q = t * 0.5307027145f + (-0.7265760135f); q = q * t + 0.7107068705f; q = q * t + (-0.142248368f); q = q * t + 0.127414796f; q = q * t;
    const f32x2 s = (v * v) * (-0.72134752044f);
    f32x2 e; e.x = __builtin_amdgcn_exp2f(s.x); e.y = __builtin_amdgcn_exp2f(s.y);
    const f32x2 r = __builtin_elementwise_max(v, (f32x2){0.f, 0.f}) - av * (q * e);
    return r * u;
}
template <int MODE  , bool I8_ = false> struct EpiGluT {
    static constexpr bool PERM = true, AFTER_DRAIN = false, PERM_A = true, I8 = I8_;
    bf16_t* H; const float* cw; const float* cb; float* G0; float* UP0; int dff; int ngrp; const float* part; const float* c1; const float* c0; PG8_LAS unsigned char* tab; const float* sw; const float* sa;
    __device__ __forceinline__ void prefetch(const Unit& u, int wid, int lane) const {
        prefetch_stats(part, u.pm, tab, wid, lane);
        if (wid < 4) { const int v = 2 * wid + (lane >> 5), c4 = (lane & 31) * 4;
            const float* src = (v < 3) ? cw + v * dff : (v == 3) ? cb : (v & 1) ? c0 + ((v - 4) >> 1) * dff : c1 + ((v - 4) >> 1) * dff;
            glds16(src + u.pn * HALF + c4, tab + TAB_CONST + wid * 1024); }
        if (I8_) {
            if (wid == 4) glds16(sw + (lane >> 5) * dff + u.pn * HALF + (lane & 31) * 4, tab + TAB_SW);
            if (wid == 5) glds16(sa + (size_t)u.pm * BM + 4 * lane, tab + TAB_SA); }
    }
    __device__ __forceinline__ void operator()(f32x4 (&acc)[2][2][4][2], const Unit& u, int wr, int wc, int fr, int fq) const {
        const int hc0 = u.pn * HALF + wc * 32 + 8 * fq;
        const PG8_LAS unsigned char* wt_ = tab + TAB_CONST + (wc * 32 + 8 * fq) * 4;
#define PG8_TABV(v_, n_) (*(const PG8_LAS f32x4*)(wt_ + (v_) * 512 + (4 * (n_)) * 4))
        if (MODE == 0 && !I8_) { finalize_stats(tab, (wr * 4 + wc) * 64 + fr + 16 * fq); asm volatile("s_waitcnt lgkmcnt(0)" ::: "memory"); __builtin_amdgcn_s_barrier(); asm volatile("" ::: "memory"); }
        if (MODE == 0 && I8_) { const int tid_ = (wr * 4 + wc) * 64 + fr + 16 * fq;
            if (tid_ < 256) { const RowStat rs = row_stat_lds(tab, tid_, K_EPS); const float sa_ = *(const PG8_LAS float*)(tab + TAB_SA + 4 * tid_); *(PG8_LAS f32x4*)(tab + TAB_R4 + 16 * tid_) = (f32x4){rs.nmr, rs.r, rs.r * sa_, 0.f}; }
            asm volatile("s_waitcnt lgkmcnt(0)" ::: "memory"); __builtin_amdgcn_s_barrier(); asm volatile("" ::: "memory"); }
#pragma unroll
        for (int ai = 0; ai < 2; ++ai) {
            const int tb = u.pm * BM + ai * HALF + wr * 64, grp = tb >> 6;
            if (MODE == 0 && I8_) {
                f32x4 r4[4];
#pragma unroll
                for (int m = 0; m < 4; ++m) r4[m] = *(const PG8_LAS f32x4*)(tab + TAB_R4 + 16 * (ai * HALF + wr * 64 + 4 * fr + m));
#pragma unroll
                for (int bj = 0; bj < 2; ++bj)
#pragma unroll
                    for (int n = 0; n < 2; ++n) { const f32x4 k1 = PG8_TABV(4 + 2 * bj, n), k0 = PG8_TABV(5 + 2 * bj, n), swv = PG8_TABV(8 + bj, n);
#pragma unroll
                        for (int m = 0; m < 4; ++m) { const f32x4 fv = __builtin_convertvector(__builtin_bit_cast(i32x4, acc[ai][bj][m][n]), f32x4);
                            acc[ai][bj][m][n] = fv * (swv * r4[m][2]) + (k1 * r4[m][0] + k0); } }
                asm volatile("" ::: "memory");
            }
            if (MODE == 0 && !I8_) {
                RowStat rs[4];
#pragma unroll
                for (int m = 0; m < 4; ++m) rs[m] = stat_tab(tab, ai * HALF + wr * 64 + 4 * fr + m);
#pragma unroll
                for (int bj = 0; bj < 2; ++bj)
#pragma unroll
                    for (int n = 0; n < 2; ++n) { const f32x4 k1 = PG8_TABV(4 + 2 * bj, n), k0 = PG8_TABV(5 + 2 * bj, n);
#pragma unroll
                        for (int m = 0; m < 4; ++m) acc[ai][bj][m][n] = acc[ai][bj][m][n] * rs[m].r + (k1 * rs[m].nmr + k0); }
                asm volatile("" ::: "memory");
            }
            unsigned hp[4][2];
#pragma unroll
            for (int n = 0; n < 2; ++n) {
                const f32x4 w0 = PG8_TABV(0, n), w1 = PG8_TABV(1, n), w2 = PG8_TABV(2, n), cbv = PG8_TABV(3, n);
#pragma unroll
                for (int m = 0; m < 4; ++m) {
                    const int t = tb + 4 * fr + m; const f32x4 gg = acc[ai][0][m][n], up = acc[ai][1][m][n]; f32x4 hv;
                    if (MODE == 1) { hv = gg * up; } else {
                    f32x4 g1, g2;
                    if (m == 0) {
#pragma unroll
                        for (int e = 0; e < 4; ++e) { g1[e] = PG8_DPP0(acc[ai][0][3][n][e], 0x111); g2[e] = PG8_DPP0(acc[ai][0][2][n][e], 0x111); } }
                    else if (m == 1) { g1 = acc[ai][0][0][n];
#pragma unroll
                        for (int e = 0; e < 4; ++e) g2[e] = PG8_DPP0(acc[ai][0][3][n][e], 0x111); }
                    else { g1 = acc[ai][0][m - 1][n]; g2 = acc[ai][0][m - 2][n]; }
                    const f32x4 cv = cbv + w0 * g2 + w1 * g1 + w2 * gg;
                    const f32x2 a = gelu_mul_pk((f32x2){cv[0], cv[1]}, (f32x2){up[0], up[1]}), b = gelu_mul_pk((f32x2){cv[2], cv[3]}, (f32x2){up[2], up[3]});
                    hv = (f32x4){a.x, a.y, b.x, b.y}; }
                    if (MODE == 0 && fr == 0 && m < 2) {
                        *(f32x4*)(G0 + ((size_t)grp * 4 + 2 + m) * dff + hc0 + 4 * n) = gg; *(f32x4*)(UP0 + ((size_t)grp * 2 + m) * dff + hc0 + 4 * n) = up; }
                    if (MODE == 0 && fr == 15 && m >= 2 && grp + 1 < ngrp)
                        *(f32x4*)(G0 + ((size_t)(grp + 1) * 4 + (m - 2)) * dff + hc0 + 4 * n) = gg;
                    const unsigned p0 = cvt_pk_bf16(hv[0], hv[1]), p1 = cvt_pk_bf16(hv[2], hv[3]);
                    if (n == 0) { hp[m][0] = p0; hp[m][1] = p1; }
                    else if (MODE == 2) { asm volatile("" :: "v"(p0), "v"(p1), "v"(hp[m][0]), "v"(hp[m][1])); }
                    else if (m >= 2 || fr > 0) { u32x4 w; w.x = hp[m][0]; w.y = hp[m][1]; w.z = p0; w.w = p1; __builtin_nontemporal_store(w, (u32x4*)(H + (size_t)t * dff + hc0)); }
                }
            }
            asm volatile("" ::: "memory");
        }
#undef PG8_TABV
    }
};
typedef EpiGluT<0> EpiGlu;
typedef EpiGluT<0, true> EpiGlu8;
struct EpiNull {
    static constexpr bool PERM = true, AFTER_DRAIN = false, PERM_A = false, I8 = false;
    __device__ __forceinline__ void prefetch(const Unit&, int, int) const {}
    __device__ __forceinline__ void operator()(f32x4 (&acc)[2][2][4][2], const Unit& u, int wr, int wc, int fr, int fq) const {
#pragma unroll
        for (int ai = 0; ai < 2; ++ai)
#pragma unroll
            for (int bj = 0; bj < 2; ++bj)
#pragma unroll
                for (int m = 0; m < 4; ++m) asm volatile("" :: "v"(acc[ai][bj][m][0]), "v"(acc[ai][bj][m][1]));
    }
};
template <class Epi, class Sched, bool ALIGN_EPI = false, bool SP2 = false>
__device__ __forceinline__ void gemm_phase(PG8_LAS unsigned char* lds, const Gemm g, const Sched& S, const Epi& E, int tid_in) {
    int tid_ = tid_in; asm volatile("" : "+v"(tid_));
    const int tid = tid_, wid = __builtin_amdgcn_readfirstlane(tid >> 6), lane = tid & 63, wr = wid >> 2, wc = wid & 3, fr = lane & 15, fq = lane >> 4;
    const int K = g.K, nt = K / BK;
    unsigned voffA[2], voffB[2];
#pragma unroll
    for (int i = 0; i < 2; ++i) { int R, C; stage_rc(tid * 16 + i * 8192, R, C); const int Rb = Epi::PERM ? ((R & ~31) + perm32(R & 31)) : R;
        const int Ra = Epi::PERM_A ? ((R & ~63) + 4 * (R & 15) + ((R >> 4) & 3)) : R;
        voffA[i] = (unsigned)(Ra * K + C) * 2u; voffB[i] = (unsigned)(Rb * K + C) * 2u; }
    const size_t kstep = (size_t)(BK * 2);
    const size_t hstep = (size_t)HALF * K * 2;
    const size_t tstep = 2 * hstep;
    const unsigned ldsw = (unsigned)wid * 1024u;
    const int aoff = lds_byte(wr * 64 + fr, fq * 8), boff = lds_byte(wc * 32 + fr, fq * 8);
#define PG8_SA(b, h) (((b) * 2 + (h)) * HTB)
#define PG8_SB(b, h) ((4 + (b) * 2 + (h)) * HTB)
#define PG8_STAGE(bufoff, gbase, voff) do { _Pragma("unroll") for (int _i = 0; _i < 2; ++_i) \
        __builtin_amdgcn_global_load_lds((const unsigned*)((const char*)(gbase) + (voff)[_i]), (PG8_LAS unsigned*)(lds + (bufoff) + ldsw + _i * 8192), 16, 0, 0); } while (0)
#define PG8_LDA(dst, b, h) do { _Pragma("unroll") for (int m = 0; m < 4; ++m) _Pragma("unroll") for (int k = 0; k < 2; ++k) dst[m][k] = *(const PG8_LAS bf16x8*)(lds + PG8_SA(b, h) + aoff + m * 2048 + k * 1024); } while (0)
#define PG8_LDB(dst, b, h) do { _Pragma("unroll") for (int n = 0; n < 2; ++n) _Pragma("unroll") for (int k = 0; k < 2; ++k) dst[n][k] = *(const PG8_LAS bf16x8*)(lds + PG8_SB(b, h) + boff + n * 2048 + k * 1024); } while (0)
#define PG8_MMA(ai, bj, At, Bt) do { __builtin_amdgcn_s_setprio(1); _Pragma("unroll") for (int m = 0; m < 4; ++m) _Pragma("unroll") for (int n = 0; n < 2; ++n) _Pragma("unroll") for (int k = 0; k < 2; ++k) \
        { if constexpr (Epi::I8) acc[ai][bj][m][n] = __builtin_bit_cast(f32x4, __builtin_amdgcn_mfma_i32_16x16x64_i8(__builtin_bit_cast(i32x4, Bt[n][k]), __builtin_bit_cast(i32x4, At[m][k]), __builtin_bit_cast(i32x4, acc[ai][bj][m][n]), 0, 0, 0)); \
          else acc[ai][bj][m][n] = __builtin_amdgcn_mfma_f32_16x16x32_bf16(Bt[n][k], At[m][k], acc[ai][bj][m][n], 0, 0, 0); } __builtin_amdgcn_s_setprio(0); } while (0)
#define PG8_WAIT_V(n) asm volatile("s_waitcnt vmcnt(" #n ")" ::: "memory")
#define PG8_WAIT_L(n) asm volatile("s_waitcnt lgkmcnt(" #n ")" ::: "memory")
#define PG8_BAR __builtin_amdgcn_s_barrier()
#define PG8_SCHED __builtin_amdgcn_sched_barrier(0)
    Unit cur, nxt; int ui = 0;
    if (!S.next(0, cur)) return;
    f32x4 acc[2][2][4][2];
    bf16x8 At[4][2], B0[2][2], B1[2][2];
    const char* cA = (const char*)g.A + (size_t)cur.pm * tstep; const char* cB = (const char*)g.Bt + (size_t)cur.pn * tstep;
    S.a_ready(cur);
    if constexpr (SP2) {
        PG8_STAGE(PG8_SB(0, 0), cB, voffB); PG8_STAGE(PG8_SB(0, 1), cB + hstep, voffB); PG8_STAGE(PG8_SA(0, 0), cA, voffA); PG8_STAGE(PG8_SA(0, 1), cA + hstep, voffA);
        if (wr == 1) PG8_BAR;
        PG8_WAIT_V(2); PG8_BAR;
        PG8_STAGE(PG8_SB(1, 0), cB + kstep, voffB); PG8_STAGE(PG8_SA(1, 0), cA + kstep, voffA); PG8_STAGE(PG8_SB(1, 1), cB + hstep + kstep, voffB);
        PG8_WAIT_V(6); PG8_BAR;
    } else {
        PG8_STAGE(PG8_SB(0, 0), cB, voffB); PG8_STAGE(PG8_SA(0, 0), cA, voffA); PG8_STAGE(PG8_SB(0, 1), cB + hstep, voffB); PG8_STAGE(PG8_SA(0, 1), cA + hstep, voffA);
        if (wr == 1) PG8_BAR;
        PG8_WAIT_V(4); PG8_BAR;
        PG8_STAGE(PG8_SB(1, 0), cB + kstep, voffB); PG8_STAGE(PG8_SA(1, 0), cA + kstep, voffA); PG8_STAGE(PG8_SB(1, 1), cB + hstep + kstep, voffB);
        PG8_WAIT_V(6); PG8_BAR;
    }
#pragma unroll
    for (int a = 0; a < 2; ++a)
#pragma unroll
        for (int b = 0; b < 2; ++b)
#pragma unroll
            for (int m = 0; m < 4; ++m)
#pragma unroll
                for (int n = 0; n < 2; ++n) acc[a][b][m][n] = (f32x4){0.f, 0.f, 0.f, 0.f};
    for (;;) {
        const bool has_next = S.next(ui + 1, nxt);
        const char* nA = has_next ? (const char*)g.A + (size_t)nxt.pm * tstep : cA; const char* nB = has_next ? (const char*)g.Bt + (size_t)nxt.pn * tstep : cB;
        { PG8_BAR; int ln_ = (int)__builtin_amdgcn_mbcnt_hi(~0u, __builtin_amdgcn_mbcnt_lo(~0u, 0u)); asm volatile("" : "+v"(ln_)); E.prefetch(cur, wid, ln_); }
        for (int t = 0; t < nt; t += 2) {
            const bool last = (t == nt - 2);
            const char* a1 = cA + (size_t)(t + 1) * kstep;
            const char* a2 = last ? nA : cA + (size_t)(t + 2) * kstep; const char* b2 = last ? nB : cB + (size_t)(t + 2) * kstep;
            const char* a3 = a2 + kstep; const char* b3 = b2 + kstep;
            if (last && has_next) S.a_ready(nxt);
            if constexpr (SP2) {
            PG8_LDB(B0, 0, 0); PG8_LDB(B1, 0, 1); PG8_SCHED; PG8_LDA(At, 0, 0); PG8_STAGE(PG8_SA(1, 1), a1 + hstep, voffA);
            PG8_WAIT_V(8); PG8_WAIT_L(0); PG8_BAR; PG8_MMA(0, 0, At, B0); PG8_MMA(0, 1, At, B1); PG8_BAR; PG8_SCHED;
            PG8_LDA(At, 0, 1); PG8_STAGE(PG8_SB(0, 0), b2, voffB); PG8_STAGE(PG8_SB(0, 1), b2 + hstep, voffB); PG8_STAGE(PG8_SA(0, 0), a2, voffA);
            PG8_WAIT_V(8); PG8_WAIT_L(0); PG8_BAR; PG8_MMA(1, 0, At, B0); PG8_MMA(1, 1, At, B1); PG8_BAR; PG8_SCHED;
            PG8_LDB(B0, 1, 0); PG8_LDB(B1, 1, 1); PG8_SCHED; PG8_LDA(At, 1, 0); PG8_STAGE(PG8_SA(0, 1), a2 + hstep, voffA);
            PG8_WAIT_V(8); PG8_WAIT_L(0); PG8_BAR; PG8_MMA(0, 0, At, B0); PG8_MMA(0, 1, At, B1); PG8_BAR; PG8_SCHED;
            PG8_LDA(At, 1, 1); PG8_STAGE(PG8_SB(1, 0), b3, voffB); PG8_STAGE(PG8_SB(1, 1), b3 + hstep, voffB); PG8_STAGE(PG8_SA(1, 0), a3, voffA);
            PG8_WAIT_V(8); PG8_WAIT_L(0); PG8_BAR; PG8_MMA(1, 0, At, B0); PG8_MMA(1, 1, At, B1); PG8_BAR; PG8_SCHED;
            } else {
            PG8_LDB(B0, 0, 0); PG8_SCHED; PG8_LDA(At, 0, 0); PG8_STAGE(PG8_SA(1, 1), a1 + hstep, voffA);
            PG8_WAIT_L(8); PG8_BAR; PG8_WAIT_L(0); PG8_MMA(0, 0, At, B0); PG8_BAR; PG8_SCHED;
            PG8_LDB(B1, 0, 1); PG8_STAGE(PG8_SB(0, 0), b2, voffB);
            PG8_BAR; PG8_WAIT_L(0); PG8_MMA(0, 1, At, B1); PG8_BAR;
            PG8_LDA(At, 0, 1); PG8_STAGE(PG8_SA(0, 0), a2, voffA);
            PG8_BAR; PG8_WAIT_L(0); PG8_MMA(1, 0, At, B0); PG8_BAR; PG8_SCHED;
            PG8_STAGE(PG8_SB(0, 1), b2 + hstep, voffB);
            PG8_WAIT_V(6); PG8_BAR; PG8_MMA(1, 1, At, B1); PG8_BAR;
            PG8_LDB(B0, 1, 0); PG8_SCHED; PG8_LDA(At, 1, 0); PG8_STAGE(PG8_SA(0, 1), a2 + hstep, voffA);
            PG8_WAIT_L(8); PG8_BAR; PG8_WAIT_L(0); PG8_MMA(0, 0, At, B0); PG8_BAR; PG8_SCHED;
            PG8_LDB(B1, 1, 1); PG8_STAGE(PG8_SB(1, 0), b3, voffB);
            PG8_BAR; PG8_WAIT_L(0); PG8_MMA(0, 1, At, B1); PG8_BAR;
            PG8_LDA(At, 1, 1); PG8_STAGE(PG8_SA(1, 0), a3, voffA);
            PG8_BAR; PG8_WAIT_L(0); PG8_MMA(1, 0, At, B0); PG8_BAR; PG8_SCHED;
            PG8_STAGE(PG8_SB(1, 1), b3 + hstep, voffB);
            PG8_WAIT_V(6); PG8_BAR; PG8_MMA(1, 1, At, B1); PG8_BAR;
            }
        }
        if constexpr (ALIGN_EPI) { if (wr == 0) PG8_BAR; }
        if constexpr (!Epi::AFTER_DRAIN) { int ln_ = (int)__builtin_amdgcn_mbcnt_hi(~0u, __builtin_amdgcn_mbcnt_lo(~0u, 0u)); asm volatile("" : "+v"(ln_));
            E(acc, cur, wr, wc, ln_ & 15, ln_ >> 4); S.done(cur); }
        if (!has_next) break;
#pragma unroll
        for (int a = 0; a < 2; ++a)
#pragma unroll
            for (int b = 0; b < 2; ++b)
#pragma unroll
                for (int m = 0; m < 4; ++m)
#pragma unroll
                    for (int n = 0; n < 2; ++n) acc[a][b][m][n] = (f32x4){0.f, 0.f, 0.f, 0.f};
        cur = nxt; cA = nA; cB = nB; ++ui;
        if constexpr (ALIGN_EPI) { if (wr == 1) PG8_BAR; }
    }
    PG8_WAIT_V(0);
    if constexpr (!ALIGN_EPI) { if (wr == 0) PG8_BAR; }
    PG8_BAR;
    if constexpr (Epi::AFTER_DRAIN) { E.fused(acc, cur, wr, wc, fr, fq, lds, wid, lane); S.done(cur); }
#undef PG8_SA
#undef PG8_SB
#undef PG8_STAGE
#undef PG8_LDA
#undef PG8_LDB
#undef PG8_MMA
#undef PG8_WAIT_V
#undef PG8_WAIT_L
#undef PG8_BAR
#undef PG8_SCHED
}
}
#define GAS __attribute__((address_space(1)))
#define LAS __attribute__((address_space(3)))
typedef unsigned short bf16;
typedef unsigned v4u __attribute__((ext_vector_type(4)));
typedef float f32x4 __attribute__((ext_vector_type(4)));
typedef short bf16x8 __attribute__((ext_vector_type(8)));
typedef GAS unsigned gu32;
typedef GAS unsigned long long gu64;
#define RLX_AGENT __ATOMIC_RELAXED, __HIP_MEMORY_SCOPE_AGENT
#define LDS_WAIT() asm volatile("s_waitcnt lgkmcnt(0)" ::: "memory")
#define VM_WAIT() asm volatile("s_waitcnt vmcnt(0)" ::: "memory")
__device__ __forceinline__ unsigned long long rt() { return __builtin_amdgcn_s_memrealtime(); }

#define XB_TMO      128
#define XB_XCNT(j)  (256  + 64 * (j))
#define XB_XSUB(j)  (1280 + 64 * (j))
#define XB_XGEN(j)  (2304 + 64 * (j))
#define XB_TOP      3328
#define XB_TOPGEN   3392
#define XCD_BAR_WORDS 3456
#define XB_SPIN_CAP (1u << 18)

__device__ __forceinline__ unsigned xb_ld(unsigned* p)              { return __hip_atomic_load(p, __ATOMIC_RELAXED, __HIP_MEMORY_SCOPE_AGENT); }
__device__ __forceinline__ unsigned xb_add(unsigned* p, unsigned v) { return __hip_atomic_fetch_add(p, v, __ATOMIC_RELAXED, __HIP_MEMORY_SCOPE_AGENT); }
__device__ __forceinline__ unsigned xb_xcc_id() { return (unsigned)__builtin_amdgcn_s_getreg((3 << 11) | 20) & 0xFu; }
#define XB_SPIN(cond, bar) do { unsigned _sp = 0; while (cond) { __builtin_amdgcn_s_sleep(1); \
    if ((++_sp & 255u) == 0u) { if (xb_ld(&(bar)[XB_TMO])) break; if (_sp > XB_SPIN_CAP) { atomicAdd(&(bar)[XB_TMO], 1u); break; } } } } while (0)

struct XcdBarrier {
    unsigned* bar; unsigned x;
    volatile LAS unsigned* st;
};

__device__ __forceinline__ XcdBarrier xcd_barrier_post(unsigned* bar, volatile LAS unsigned* st) {
    XcdBarrier b; b.bar = bar; b.x = xb_xcc_id(); b.st = st;
    if (threadIdx.x == 0) (void)xb_add(&bar[XB_XCNT(b.x)], 1u);
    return b;
}
__device__ __forceinline__ void xcd_barrier_complete(unsigned* bar, unsigned x, unsigned& nloc, unsigned& nx) {
    const unsigned G = gridDim.x * gridDim.y * gridDim.z;
    unsigned sum, cnt, mine, sp = 0u;
    for (;;) {
        sum = 0u; cnt = 0u; mine = 0u;
#pragma unroll
        for (unsigned j = 0; j < 16; ++j) { const unsigned c = xb_ld(&bar[XB_XCNT(j)]); sum += c; cnt += (c > 0u) ? 1u : 0u; mine = (j == x) ? c : mine; }
        if (sum == G) break;
        __builtin_amdgcn_s_sleep(1);
        if ((++sp & 255u) == 0u) { if (xb_ld(&bar[XB_TMO])) break; if (sp > XB_SPIN_CAP) { atomicAdd(&bar[XB_TMO], 1u); break; } }
    }
    nloc = mine > 0u ? mine : 1u; nx = cnt > 0u ? cnt : 1u;
}

__device__ __forceinline__ void xcd_barrier(const XcdBarrier& b, bool leader_thread) {
    asm volatile("s_waitcnt vmcnt(0)" ::: "memory");
    __syncthreads();
    if (leader_thread) {
        unsigned* bar = b.bar;
        __builtin_amdgcn_s_waitcnt(0);
        unsigned nloc = b.st[0], nx = b.st[1];
        if (nloc == 0u) { xcd_barrier_complete(bar, b.x, nloc, nx); b.st[0] = nloc; b.st[1] = nx; }
        const unsigned old = xb_add(&bar[XB_XSUB(b.x)], 1u);
        const unsigned gen = old / nloc;
        if (old + 1u == (gen + 1u) * nloc) {
            __builtin_amdgcn_fence(__ATOMIC_RELEASE, "agent");
            asm volatile("s_waitcnt vmcnt(0)" ::: "memory");
            const unsigned og = xb_add(&bar[XB_TOP], 1u);
            const unsigned tg = og / nx;
            if (og + 1u == (tg + 1u) * nx) xb_add(&bar[XB_TOPGEN], 1u);
            else XB_SPIN(xb_ld(&bar[XB_TOPGEN]) == tg, bar);
            __builtin_amdgcn_fence(__ATOMIC_ACQUIRE, "agent");
            xb_add(&bar[XB_XGEN(b.x)], 1u);
            asm volatile("s_waitcnt vmcnt(0)" ::: "memory");
        } else {
            XB_SPIN(xb_ld(&bar[XB_XGEN(b.x)]) == gen, bar);
            __builtin_amdgcn_fence(__ATOMIC_ACQUIRE, "agent");
            asm volatile("s_waitcnt vmcnt(0)" ::: "memory");
        }
    }
    __syncthreads();
}

constexpr int NWAVES = 8;
constexpr size_t WS_CTL = 420 * MiB, CTL_ZERO_BYTES = 64 * 1024;
constexpr size_t WS_XCH = 421 * MiB;
constexpr size_t WS_PARTA = WS_XCH, WS_PARTB = WS_XCH + 1 * MiB, WS_CV = WS_XCH + 2 * MiB, WS_CPART = WS_CV + 256 * 1024;
constexpr int CV_IN1 = 0, CV_UP0 = 2 * 2576, CV_UP1 = CV_UP0 + 2 * 5632, CV_END = CV_UP1 + 2 * 5632;
constexpr int CP_IN1 = 0, CP_UP0 = 16 * 2 * 2576, CP_UP1 = CP_UP0 + 16 * 2 * 5632, CP_END = CP_UP1 + 16 * 2 * 5632;
static_assert(CV_END * 4 <= 256 * 1024 && WS_CPART + (size_t)CP_END * 4 <= WS_XCH + 4 * MiB, "deferred-LN map");
constexpr size_t WS_G0 = 425 * MiB;
constexpr size_t WS_UP0 = 447 * MiB;
constexpr size_t WS_WT = 458 * MiB;
constexpr size_t WT_IN = 0, WT_G = (size_t)2560 * 1024 * 2, WT_OUT = WT_G + 16 * 1024 * 2, WT_UP = WT_OUT + (size_t)1024 * 1024 * 2, WT_DN = WT_UP + (size_t)5632 * 1024 * 2, WT_LAYER = WT_DN + (size_t)1024 * 2816 * 2;
constexpr size_t WS_W8 = 302 * MiB, WS_SWC = 314 * MiB, WS_V8 = 320 * MiB, WS_SA = 353 * MiB;
constexpr size_t WS_MST = 289 * MiB;
static_assert(WS_WT + 2 * WT_LAYER <= 512 * MiB, "ws map");
constexpr int CW_TMO = 0, CW_CODE = 1, CW_BAR = 4096, CW_SEAM = 16384, SEAM_BANK = 128 * 64;
constexpr int MX_TAB = 131072 + 512;
constexpr int RING_OFF = 0, RING_BYTES = 131072, LDSCTL_OFF = RING_BYTES, MISC_OFF = LDSCTL_OFF + 320, LDS_BYTES = 163840;
constexpr int NPHASE = 18;

struct Frame {
    LAS unsigned char* lds; volatile LAS unsigned* MISC; gu32* ctl; unsigned char* ws; int tid, lane, wave, vcu, G;
};
constexpr int PT_OFF = LDSCTL_OFF + 64;
#define INP(i) inptr(F, (i))
__device__ __forceinline__ const float* inptr(const Frame& F, int i) {
    const volatile LAS unsigned* p = (const volatile LAS unsigned*)(F.lds + PT_OFF) + 2 * i;
    const unsigned lo = __builtin_amdgcn_readfirstlane(p[0]), hi = __builtin_amdgcn_readfirstlane(p[1]);
    return (const float*)(const GAS float*)(((unsigned long long)hi << 32) | lo);
}
struct Args { const float* in[20]; float* out; unsigned char* ws; int ph_lo, ph_hi, bar_region, pad; };

__device__ __forceinline__ unsigned pk2(float lo, float hi) { return f2bf(lo) | ((unsigned)f2bf(hi) << 16); }

__device__ __forceinline__ void p0_transpose_item(const float* W, int K, int N, bf16* WT, int k0, int n0, int drow0, LAS float* scr, int lane, const float* gs, const float* bs, float* cp1, float* cp0) {
    float tv[32];
#pragma unroll
    for (int i = 0; i < 32; ++i) { const int kk = 2 * i + (lane >> 5); tv[i] = W[(size_t)(k0 + kk) * N + n0 + (lane & 31)]; }
    if (gs) {
        float s1 = 0.f, s0 = 0.f;
#pragma unroll
        for (int i = 0; i < 32; ++i) { const int kk = 2 * i + (lane >> 5); const float gk = gs[k0 + kk], bk = bs[k0 + kk]; s0 = __builtin_fmaf(bk, tv[i], s0); tv[i] *= gk; s1 += tv[i]; }
        s1 += __shfl_xor(s1, 32); s0 += __shfl_xor(s0, 32);
        if (lane < 32) { cp1[n0 + lane] = s1; cp0[n0 + lane] = s0; }
    }
#pragma unroll
    for (int i = 0; i < 32; ++i) { const int kk = 2 * i + (lane >> 5); scr[kk * 33 + (lane & 31)] = tv[i]; }
    LDS_WAIT(); asm volatile("" ::: "memory");
    const int c = lane & 7;
#pragma unroll
    for (int j = 0; j < 4; ++j) { const int n = (lane >> 3) + 8 * j; const LAS float* s = scr + (8 * c) * 33 + n;
        v4u o; o.x = pk2(s[0 * 33], s[1 * 33]); o.y = pk2(s[2 * 33], s[3 * 33]); o.z = pk2(s[4 * 33], s[5 * 33]); o.w = pk2(s[6 * 33], s[7 * 33]);
        *(GAS v4u*)(WT + (size_t)(drow0 + n) * K + k0 + 8 * c) = o; }
    LDS_WAIT(); asm volatile("" ::: "memory");
}

__device__ __forceinline__ void p0_prologue(Frame& F, const Args& a) {
    LAS float* scr = (LAS float*)(F.lds + RING_OFF + F.wave * 16384);
    const int gw = F.vcu * NWAVES + F.wave, NGW = F.G * NWAVES;
    constexpr int I_IN = 16 * 80, I_OUT = 16 * 32, I_UP = 16 * 176, I_DN = 44 * 32, I_LAYER = I_IN + I_OUT + I_UP + I_DN;
    for (int it = gw; it < DEPTH * I_LAYER; it += NGW) {
        const int l = it / I_LAYER; int r = it % I_LAYER; unsigned char* wt = F.ws + WS_WT + (size_t)l * WT_LAYER;
        float* cpart = (float*)(F.ws + WS_CPART);
        if (r < I_IN) { const int kb = r / 80, nb = r % 80; const bool sc = l > 0;
            p0_transpose_item(INP(1) + (size_t)l * DM * DIN, DM, DIN, (bf16*)(wt + WT_IN), 64 * kb, 32 * nb, 32 * nb, scr, F.lane, sc ? INP(18) + (l - 1) * DM : nullptr, sc ? INP(19) + (l - 1) * DM : nullptr,
                              cpart + CP_IN1 + kb * 2 * 2576, cpart + CP_IN1 + kb * 2 * 2576 + 2576); continue; } r -= I_IN;
        if (r < I_OUT) { const int kb = r / 32, nb = r % 32; p0_transpose_item(INP(11) + (size_t)l * DM * DM, DM, DM, (bf16*)(wt + WT_OUT), 64 * kb, 32 * nb, 32 * nb, scr, F.lane, nullptr, nullptr, nullptr, nullptr); continue; } r -= I_OUT;
        if (r < I_UP) { const int kb = r / 176, nb = r % 176, n0 = 32 * nb; const int isup = n0 >= DFF, c = isup ? n0 - DFF : n0; const int drow = (c >> 7) * 256 + isup * 128 + (c & 127);
            float* cp = cpart + (l == 0 ? CP_UP0 : CP_UP1) + kb * 2 * 5632;
            p0_transpose_item(INP(14) + (size_t)l * DM * 2 * DFF, DM, 2 * DFF, (bf16*)(wt + WT_UP), 64 * kb, n0, drow, scr, F.lane, INP(12) + l * DM, INP(13) + l * DM, cp, cp + 5632); continue; } r -= I_UP;
        { const int kb = r / 32, nb = r % 32; p0_transpose_item(INP(17) + (size_t)l * DFF * DM, DFF, DM, (bf16*)(wt + WT_DN), 64 * kb, 32 * nb, 32 * nb, scr, F.lane, nullptr, nullptr, nullptr, nullptr); }
    }
    for (int i = gw * 64 + F.lane; i < DEPTH * 16 * DM; i += NGW * 64) { const int l = i / (16 * DM), j = (i / DM) % 16, k = i % DM;
        float v = j < 8 ? INP(1)[(size_t)l * DM * DIN + (size_t)k * DIN + ZW + j] : 0.f; if (l > 0) v *= INP(18)[(l - 1) * DM + k];
        ((bf16*)(F.ws + WS_WT + (size_t)l * WT_LAYER + WT_G))[j * DM + k] = f2bf(v); }
    for (int j = gw; j < 8; j += NGW) { float s1 = 0.f, s0 = 0.f;
        for (int k = F.lane; k < DM; k += 64) { const float wv = INP(1)[(size_t)1 * DM * DIN + (size_t)k * DIN + ZW + j]; s1 = __builtin_fmaf(INP(18)[k], wv, s1); s0 = __builtin_fmaf(INP(19)[k], wv, s0); }
#pragma unroll
        for (int o = 1; o < 64; o <<= 1) { s1 += __shfl_xor(s1, o); s0 += __shfl_xor(s0, o); }
        if (F.lane == 0) { float* cv = (float*)(F.ws + WS_CV); cv[CV_IN1 + ZW + j] = s1; cv[CV_IN1 + 2576 + ZW + j] = s0; } }
    const float* x = INP(0); bf16* XN = (bf16*)(F.ws + WS_XN);
    for (size_t i0 = (size_t)gw * 64 + F.lane; i0 < (size_t)M * DM / 8; i0 += (size_t)NGW * 64 * 4) {
        f32x4 v0[4], v1[4];
#pragma unroll
        for (int q = 0; q < 4; ++q) { const size_t i = i0 + (size_t)q * NGW * 64; v0[q] = *(const GAS f32x4*)(x + i * 8); v1[q] = *(const GAS f32x4*)(x + i * 8 + 4); }
#pragma unroll
        for (int q = 0; q < 4; ++q) { const size_t i = i0 + (size_t)q * NGW * 64;
            v4u o; o.x = pk2(v0[q][0], v0[q][1]); o.y = pk2(v0[q][2], v0[q][3]); o.z = pk2(v1[q][0], v1[q][1]); o.w = pk2(v1[q][2], v1[q][3]);
            *(GAS v4u*)(XN + i * 8) = o; } }
}

__device__ __forceinline__ void cvec_finalize(Frame& F, const Args& a) {
    const float* cp = (const float*)(F.ws + WS_CPART); float* cv = (float*)(F.ws + WS_CV);
    const int gt = (F.vcu * NWAVES + F.wave) * 64 + F.lane, NT = F.G * NWAVES * 64;
    for (int i = gt; i < 2 * ZW + 4 * 5632; i += NT) {
        int src, dst, stride, idx = i;
        if (idx < 2 * ZW) { const int v = idx / ZW, n = idx % ZW; src = CP_IN1 + v * 2576 + n; dst = CV_IN1 + v * 2576 + n; stride = 2 * 2576; }
        else { idx -= 2 * ZW; const int m = idx / (2 * 5632), e = idx % (2 * 5632); src = (m ? CP_UP1 : CP_UP0) + e; dst = (m ? CV_UP1 : CV_UP0) + e; stride = 2 * 5632; }
        float sacc = 0.f;
#pragma unroll
        for (int kb = 0; kb < 16; ++kb) sacc += cp[src + kb * stride];
        cv[dst] = sacc; }
}
__device__ __forceinline__ float wave_max(float x) {
#pragma unroll
    for (int o = 32; o > 0; o >>= 1) x = fmaxf(x, __shfl_xor(x, o)); return x; }
__device__ __forceinline__ int wave_isum(int x) {
#pragma unroll
    for (int o = 32; o > 0; o >>= 1) x += __shfl_xor(x, o); return x; }
__device__ __forceinline__ void quant_unpack(const v4u a, const v4u b, float (&x)[16]) {
#pragma unroll
    for (int e = 0; e < 4; ++e) { x[2 * e] = __uint_as_float(a[e] << 16); x[2 * e + 1] = __uint_as_float(a[e] & 0xffff0000u); x[8 + 2 * e] = __uint_as_float(b[e] << 16); x[8 + 2 * e + 1] = __uint_as_float(b[e] & 0xffff0000u); }
}
__device__ __forceinline__ float quant_row16(const float (&x)[16], unsigned (&q8)[4], int& isum) {
    float am = 0.f;
#pragma unroll
    for (int e = 0; e < 16; ++e) am = fmaxf(am, fabsf(x[e]));
    am = wave_max(am);
    const float inv = am > 0.f ? 127.0f / am : 0.f;
    isum = 0;
#pragma unroll
    for (int j = 0; j < 4; ++j) { unsigned w = 0u;
#pragma unroll
        for (int e = 0; e < 4; ++e) { const int q = (int)__builtin_rintf(x[4 * j + e] * inv); isum += q; w |= ((unsigned)q & 0xffu) << (8 * e); }
        q8[j] = w; }
    return am * (1.0f / 127.0f);
}
typedef unsigned v2u __attribute__((ext_vector_type(2)));
__device__ __forceinline__ void quant_w_step(Frame& F) {
    const int gw = F.vcu * NWAVES + F.wave, NGW = F.G * NWAVES, lane = F.lane;
    for (int rr = gw; rr < DEPTH * 2 * DFF; rr += NGW) {
        const int l = rr / (2 * DFF), n = rr % (2 * DFF);
        const bf16* src = (const bf16*)(F.ws + WS_WT + (size_t)l * WT_LAYER + WT_UP) + (size_t)n * DM;
        const v4u a = *(const GAS v4u*)(src + 8 * lane), b = *(const GAS v4u*)(src + 512 + 8 * lane);
        float x[16]; quant_unpack(a, b, x);
        unsigned q8[4]; int isum; const float sc = quant_row16(x, q8, isum);
        isum = wave_isum(isum);
        unsigned char* dst = F.ws + WS_W8 + ((size_t)l * 2 * DFF + n) * DM;
        *(GAS v2u*)(dst + 8 * lane) = (v2u){q8[0], q8[1]}; *(GAS v2u*)(dst + 512 + 8 * lane) = (v2u){q8[2], q8[3]};
        if (lane == 0) { float* swc = (float*)(F.ws + WS_SWC) + (size_t)l * 4 * DFF; const int idx = ((n & 255) >= 128 ? DFF : 0) + 128 * (n >> 8) + (n & 127);
            swc[idx] = sc; swc[2 * DFF + idx] = sc * (float)isum; }
    }
}
__device__ __forceinline__ void quant_a_phase(Frame& F, const bf16* V) {
    const int gw = F.vcu * NWAVES + F.wave, NGW = F.G * NWAVES, lane = F.lane;
    unsigned char* V8 = F.ws + WS_V8; float* SA = (float*)(F.ws + WS_SA);
    for (int m0 = gw * 4; m0 < M; m0 += NGW * 4) {
        v4u a[4], b[4];
#pragma unroll
        for (int q = 0; q < 4; ++q) { const bf16* src = V + (size_t)(m0 + q) * DM; a[q] = *(const GAS v4u*)(src + 8 * lane); b[q] = *(const GAS v4u*)(src + 512 + 8 * lane); }
#pragma unroll
        for (int q = 0; q < 4; ++q) { float x[16]; quant_unpack(a[q], b[q], x);
            unsigned q8[4]; int isum; const float sc = quant_row16(x, q8, isum);
            unsigned char* dst = V8 + (size_t)(m0 + q) * DM;
            *(GAS v2u*)(dst + 8 * lane) = (v2u){q8[0], q8[1]}; *(GAS v2u*)(dst + 512 + 8 * lane) = (v2u){q8[2], q8[3]};
            if (lane == 0) SA[m0 + q] = sc; }
    }
}
__device__ __forceinline__ void gates_phase(Frame& F, const bf16* XN, const bf16* WG, float* GT, const float* part, const float* c1, const float* c0) {
    const int gw = F.vcu * NWAVES + F.wave, NGW = F.G * NWAVES, l15 = F.lane & 15, lq = F.lane >> 4;
    for (int blk = gw; blk < M / 16; blk += NGW) {
        const bf16* ap = XN + (size_t)(blk * 16 + l15) * DM + 8 * lq; const bf16* bp = WG + (size_t)l15 * DM + 8 * lq;
        f32x4 acc = (f32x4){0.f, 0.f, 0.f, 0.f};
#pragma unroll 16
        for (int ks = 0; ks < DM / 32; ++ks) { const bf16x8 av = *(const GAS bf16x8*)(ap + ks * 32), bv = *(const GAS bf16x8*)(bp + ks * 32);
            acc = __builtin_amdgcn_mfma_f32_16x16x32_bf16(av, bv, acc, 0, 0, 0); }
        if (l15 < 8) {
            float k1 = 0.f, k0 = 0.f; if (part) { k1 = c1[l15]; k0 = c0[l15]; }
#pragma unroll
            for (int r = 0; r < 4; ++r) { const size_t row = (size_t)(blk * 16 + 4 * lq + r); float v = acc[r];
                if (part) { const pg8::RowStat rs = pg8::row_stat(part, row, LN_EPS); v = v * rs.r + (k1 * rs.nmr + k0); }
                GT[row * 8 + l15] = v; } }
    }
}

__device__ __forceinline__ void glu_fixup_phase(Frame& F, const float* G0, const float* UP0, const float* cw, const float* cb, bf16* H) {
    const int gt = (F.vcu * NWAVES + F.wave) * 64 + F.lane, NT = F.G * NWAVES * 64;
    constexpr int C4 = DFF / 4, NIT = (M / 64) * 2 * C4;
    for (int i0 = gt; i0 < NIT; i0 += 2 * NT) {
        f32x4 s0[2], s1[2], s2[2], up[2], w0[2], w1[2], w2[2], bb[2]; int rr[2], gg[2], cc[2]; bool ok[2];
#pragma unroll
        for (int q = 0; q < 2; ++q) { const int i = i0 + q * NT; ok[q] = i < NIT; const int ii = ok[q] ? i : gt;
            const int c = (ii % C4) * 4, r = (ii / C4) & 1, grp = ii / (2 * C4); rr[q] = r; gg[q] = grp; cc[q] = c;
            const float* gp = G0 + ((size_t)grp * 4 + r) * DFF + c;
            s0[q] = *(const GAS f32x4*)gp; s1[q] = *(const GAS f32x4*)(gp + DFF); s2[q] = *(const GAS f32x4*)(gp + 2 * DFF);
            up[q] = *(const GAS f32x4*)(UP0 + ((size_t)grp * 2 + r) * DFF + c);
            w0[q] = *(const GAS f32x4*)(cw + c); w1[q] = *(const GAS f32x4*)(cw + DFF + c); w2[q] = *(const GAS f32x4*)(cw + 2 * DFF + c); bb[q] = *(const GAS f32x4*)(cb + c); }
#pragma unroll
        for (int q = 0; q < 2; ++q) { if (!ok[q]) continue;
            const bool bs = (gg[q] & (SEQ / 64 - 1)) == 0;
            const f32x4 z = (f32x4){0.f, 0.f, 0.f, 0.f}; const f32x4 a0 = bs ? z : s0[q], a1 = (bs && rr[q] == 0) ? z : s1[q];
            const f32x4 cv = bb[q] + w0[q] * a0 + w1[q] * a1 + w2[q] * s2[q];
            const pg8::f32x2 ha = pg8::gelu_mul_pk((pg8::f32x2){cv[0], cv[1]}, (pg8::f32x2){up[q][0], up[q][1]}), hb = pg8::gelu_mul_pk((pg8::f32x2){cv[2], cv[3]}, (pg8::f32x2){up[q][2], up[q][3]});
            unsigned long long o = (unsigned long long)pg8::cvt_pk_bf16(ha.x, ha.y) | ((unsigned long long)pg8::cvt_pk_bf16(hb.x, hb.y) << 32);
            *(GAS unsigned long long*)(H + (size_t)(gg[q] * 64 + rr[q]) * DFF + cc[q]) = o; }
    }
}

struct SameTileOrder {
    int n, pm0, pn0;
    __device__ bool next(int i, pg8::Unit& u) const { if (i >= n) return false; u.pm = pm0; u.pn = pn0; return true; }
    __device__ __forceinline__ void a_ready(const pg8::Unit&) const {}
    __device__ __forceinline__ void done(const pg8::Unit&) const {}
};
struct OneUnit {
    int pm, pn;
    __device__ bool next(int i, pg8::Unit& u) const { if (i != 0) return false; u.pm = pm; u.pn = pn; return true; }
    __device__ __forceinline__ void a_ready(const pg8::Unit&) const {}
    __device__ __forceinline__ void done(const pg8::Unit&) const {}
};

__device__ __forceinline__ void res_gemm_phase(Frame& F, const bf16* A, const bf16* Bt, int K, bf16* V, bf16* Vout, const float* part_prev, const float* gp, const float* bp, float* part_new) {
    pg8::Gemm gm{A, Bt, M, DM, K}; pg8::StaticOrder S; S.init(M, DM, F.G, (int)blockIdx.x);
    pg8::EpiRes E{V, Vout, DM, part_prev, gp, bp, part_new, F.lds + MX_TAB};
    pg8::gemm_phase<pg8::EpiRes, pg8::StaticOrder, true, true>(F.lds + RING_OFF, gm, S, E, F.tid);
}
__device__ __forceinline__ void final_ln_phase(Frame& F, const bf16* V, const float* part, const float* g, const float* b, float* out) {
    const int gw = F.vcu * NWAVES + F.wave, NGW = F.G * NWAVES;
    f32x4 gv[4], bv[4];
#pragma unroll
    for (int j = 0; j < 4; ++j) { gv[j] = *(const GAS f32x4*)(g + 256 * j + 4 * F.lane); bv[j] = *(const GAS f32x4*)(b + 256 * j + 4 * F.lane); }
    for (int m0 = gw * 4; m0 < M; m0 += NGW * 4) {
        unsigned long long w[4][4]; pg8::RowStat rs[4];
#pragma unroll
        for (int q = 0; q < 4; ++q) { rs[q] = pg8::row_stat(part, (size_t)(m0 + q), LN_EPS);
#pragma unroll
            for (int j = 0; j < 4; ++j) w[q][j] = *(const GAS unsigned long long*)(V + (size_t)(m0 + q) * DM + 256 * j + 4 * F.lane); }
#pragma unroll
        for (int q = 0; q < 4; ++q)
#pragma unroll
            for (int j = 0; j < 4; ++j) { const unsigned lo = (unsigned)w[q][j], hi = (unsigned)(w[q][j] >> 32);
                f32x4 x = (f32x4){__uint_as_float(lo << 16), __uint_as_float(lo & 0xffff0000u), __uint_as_float(hi << 16), __uint_as_float(hi & 0xffff0000u)};
                x = (x * rs[q].r + rs[q].nmr) * gv[j] + bv[j];
                *(GAS f32x4*)(out + (size_t)(m0 + q) * DM + 256 * j + 4 * F.lane) = x; }
    }
}
constexpr int MX_RAWQK = 0, MX_RAWV = 18496, MX_HS = 0, MX_QS = 35904, MX_KS = 45120, MX_QP = 54336, MX_SS = 63552, MX_KWT = 72768, MX_VST = 81984, MX_CST = 102720, MX_CWB = 123456, MX_DEN = 126016;
constexpr int MX_GA = LDSCTL_OFF + 512;
constexpr int ST_FLOATS = 64 * 144 + 64;
typedef short s16x4v __attribute__((ext_vector_type(4)));

__device__ __forceinline__ float fexp(float x) { return __expf(x); }
__device__ __forceinline__ unsigned pkbf(float lo, float hi) { return pg8::cvt_pk_bf16(lo, hi); }
#define MX_DPPF(x, ctrl) __builtin_bit_cast(float, __builtin_amdgcn_update_dpp(0, __builtin_bit_cast(int, (float)(x)), (ctrl), 0xf, 0xf, true))
__device__ __forceinline__ float row_sum16(float x) {
    x += MX_DPPF(x, 0xB1); x += MX_DPPF(x, 0x4E); x += MX_DPPF(x, 0x141); x += MX_DPPF(x, 0x140); return x;
}
#define MX_LDS_FENCE() asm volatile("s_waitcnt lgkmcnt(0)" ::: "memory")

template <bool OUT>
__device__ __forceinline__ void mlstm_phase(Frame& F, const Args& args, int l) {
    const int tid = F.tid, lane = F.lane, w = F.wave, l15 = lane & 15, lq = lane >> 4;
    unsigned char* ws = F.ws;
    const bf16* Z = (const bf16*)(ws + WS_Z); const float* GT = (const float*)(ws + WS_GT); bf16* Y = (bf16*)(ws + WS_Y); float* ST = (float*)(ws + WS_MST);
    const int u = F.vcu, b = u >> 6, h = (u >> 4) & 3, seg = u & 15;
    const size_t gr_seg = (size_t)b * SEQ + (size_t)seg * 512;
    LAS unsigned char* L = F.lds;
    LAS float* gA = (LAS float*)(L + MX_GA); LAS float* gMX = gA + 512; LAS float* gFL = gA + 1024; LAS float* gBend = gA + 1536; LAS float* gAmax = gA + 1544; LAS float* gMP = gA + 1552; LAS float* gMXE = gA + 1560;
    LAS float* cwb = (LAS float*)(L + MX_CWB);
    const float* qcw = INP(4) + (size_t)l * 4 * 512; const float* qcb = INP(5) + l * 512;
    for (int i = tid; i < 640; i += 512) { const int j = i >> 7, c = i & 127; const int ch = (c < 64) ? (64 * h + c) : (256 + 64 * h + c - 64);
        cwb[i] = (j < 4) ? qcw[j * 512 + ch] : qcb[ch]; }
    for (int i = tid; i < 16 * 72; i += 512) { const int r = i / 72, c = i % 72; ((LAS bf16*)(L + MX_VST))[(128 + r) * 72 + c] = (r == 0 && c < 64) ? (bf16)0x3F80 : (bf16)0; }
    for (int i = tid; i < 144 * 72 / 2; i += 512) ((LAS unsigned*)(L + MX_CST))[i] = 0u;
    float bpos, apos, cmax;
    {
        const size_t t = gr_seg + 64 * w + lane; const float bi = INP(2)[l * 4 + h], bfg = INP(3)[l * 4 + h];
        const float ig = GT[t * 8 + h] + bi, lf = logsigmoid_f(GT[t * 8 + 4 + h] + bfg);
        float s = lf;
#pragma unroll
        for (int o = 1; o < 64; o <<= 1) { const float v = __shfl_up(s, o); if (lane >= o) s += v; }
        bpos = s; apos = ig - s; float c = apos;
#pragma unroll
        for (int o = 1; o < 64; o <<= 1) { const float v = __shfl_up(c, o); if (lane >= o) c = fmaxf(c, v); }
        cmax = c;
        gA[64 * w + lane] = apos;
        if (lane == 63) { gBend[w] = bpos; gAmax[w] = cmax; }
    }
    __syncthreads();
    float m_init = -INFINITY; asm volatile("" : "+v"(m_init));
    f32x4 cacc[4], nacc;
#pragma unroll
    for (int i = 0; i < 4; ++i) cacc[i] = (f32x4){0.f, 0.f, 0.f, 0.f};
    nacc = (f32x4){0.f, 0.f, 0.f, 0.f};
    if (OUT) {
        float ml_l = -INFINITY, bs_l = 0.f;
        if (lane < seg) { const float* sp_ = ST + (size_t)(u - seg + lane) * ST_FLOATS + 64 * 144; ml_l = sp_[0]; bs_l = sp_[1]; }
        float m_run = 0.f;
        for (int sp = 0; sp < seg; ++sp) m_run = fmaxf(__shfl(bs_l, sp) + m_run, __shfl(ml_l, sp));
        float pre = bs_l;
#pragma unroll
        for (int o = 1; o < 16; o <<= 1) { const float v = __shfl_up(pre, o); if (lane >= o) pre += v; }
        const float tot = __shfl(pre, 15);
        const float wgt_l = (lane < seg) ? fexp(ml_l + (tot - pre) - m_run) : 0.f;
#pragma unroll 1
        for (int sp0 = 0; sp0 < seg; sp0 += 3) {
            float v[3][16], vn[3][4], wj[3];
#pragma unroll
            for (int j = 0; j < 3; ++j) { const int sp = (sp0 + j < seg) ? sp0 + j : seg - 1; const float* st = ST + (size_t)(u - seg + sp) * ST_FLOATS;
                wj[j] = (sp0 + j < seg) ? __shfl(wgt_l, sp) : 0.f;
#pragma unroll
                for (int mt = 0; mt < 4; ++mt)
#pragma unroll
                    for (int r = 0; r < 4; ++r) v[j][4 * mt + r] = st[(16 * mt + 4 * lq + r) * 144 + 16 * w + l15];
#pragma unroll
                for (int r = 0; r < 4; ++r) vn[j][r] = (w < 4) ? st[(16 * w + 4 * lq + r) * 144 + 128 + l15] : 0.f; }
#pragma unroll
            for (int j = 0; j < 3; ++j) {
#pragma unroll
                for (int mt = 0; mt < 4; ++mt)
#pragma unroll
                    for (int r = 0; r < 4; ++r) cacc[mt][r] += wj[j] * v[j][4 * mt + r];
#pragma unroll
                for (int r = 0; r < 4; ++r) nacc[r] += wj[j] * vn[j][r]; }
        }
        m_init = m_run;
    }
    { float mp = m_init, mpw = m_init;
#pragma unroll
      for (int n = 0; n < 8; ++n) { const float mxe = fmaxf(mp, gAmax[n]); if (tid == 0) { gMP[n] = mp; gMXE[n] = mxe; } mpw = (w == n) ? mp : mpw; mp = gBend[n] + mxe; }
      if (!OUT) { if (tid == 0) { float bsum = 0.f;
#pragma unroll
            for (int n = 0; n < 8; ++n) bsum += gBend[n];
            ST[(size_t)u * ST_FLOATS + 64 * 144] = mp; ST[(size_t)u * ST_FLOATS + 64 * 144 + 1] = bsum; } }
      if (OUT) {
        const float mx = fmaxf(cmax, mpw); gMX[64 * w + lane] = mx; gFL[64 * w + lane] = fexp(-(bpos + mx));
#pragma unroll
        for (int mt = 0; mt < 4; ++mt) { unsigned long long v = (unsigned long long)pkbf(cacc[mt][0], cacc[mt][1]) | ((unsigned long long)pkbf(cacc[mt][2], cacc[mt][3]) << 32);
            *(LAS unsigned long long*)(L + MX_CST + ((16 * w + l15) * 72 + 16 * mt + 4 * lq) * 2) = v; }
        if (w < 4) { unsigned long long v = (unsigned long long)pkbf(nacc[0], nacc[1]) | ((unsigned long long)pkbf(nacc[2], nacc[3]) << 32);
            *(LAS unsigned long long*)(L + MX_CST + ((128 + l15) * 72 + 16 * w + 4 * lq) * 2) = v; }
      } }
    float gain[8];
    if (OUT) {
#pragma unroll
        for (int e = 0; e < 8; ++e) gain[e] = INP(10)[l * 512 + h * 128 + 8 * (tid & 15) + e]; }
    v4u rq[2][3], rv[2][2], ro[2];
#define MX_LOAD_RAW(n_, ps_) do { \
        const size_t gr0 = gr_seg + 64 * (n_); const int tc = seg * 512 + 64 * (n_); \
        _Pragma("unroll") \
        for (int k = 0; k < 3; ++k) { const int p = tid + 512 * k; const int r = p >> 4, c = p & 15; v4u v = (v4u){0u, 0u, 0u, 0u}; \
            if (p < 67 * 16 && tc - 3 + r >= 0) v = *(const GAS v4u*)(Z + (gr0 + r - 3) * ZW + (c < 8 ? 1024 + 64 * h + 8 * c : 1280 + 64 * h + 8 * (c - 8))); \
            rq[ps_][k] = v; } \
        _Pragma("unroll") \
        for (int k = 0; k < 2; ++k) { const int p = tid + 512 * k; const int r = p >> 4, c = p & 15; \
            rv[ps_][k] = *(const GAS v4u*)(Z + (gr0 + r) * ZW + 1536 + 128 * h + 8 * c); \
            } \
    } while (0)
#define MX_LOAD_O(n_) do { _Pragma("unroll") for (int k = 0; k < 2; ++k) { const int p = tid + 512 * k; ro[k] = *(const GAS v4u*)(Z + (gr_seg + 64 * (n_) + (p >> 4)) * ZW + 2048 + 128 * h + 8 * (p & 15)); } } while (0)
    MX_LOAD_RAW(0, 0); MX_LOAD_RAW(1, 1);
    if (OUT) MX_LOAD_O(0);
    __syncthreads();
#pragma unroll 1
    for (int n2 = 0; n2 < 8; n2 += 2) {
#pragma unroll
    for (int par = 0; par < 2; ++par) { const int n = n2 + par;
        int tid_ = F.tid; asm volatile("" : "+v"(tid_));
        const int tid = tid_, lane = tid & 63, l15 = lane & 15, lq = lane >> 4;
#pragma unroll
        for (int k = 0; k < 3; ++k) { const int p = tid + 512 * k; if (p < 67 * 16) *(LAS v4u*)(L + MX_RAWQK + (p >> 4) * 272 + (p & 15) * 16) = rq[par][k]; }
#pragma unroll
        for (int k = 0; k < 2; ++k) { const int p = tid + 512 * k; *(LAS v4u*)(L + MX_RAWV + (p >> 4) * 272 + (p & 15) * 16) = rv[par][k]; }
        __syncthreads();
        if (n + 2 < 8) MX_LOAD_RAW(n + 2, par);
        {
            const int s = lane;
            const float mxe = gMXE[n], mpv = gMP[n], a_s = gA[64 * n + s]; float mxs = 0.f; if (OUT) mxs = gMX[64 * n + s];
            v4u rvv[2];
#pragma unroll
            for (int cc = 0; cc < 2; ++cc) rvv[cc] = *(const LAS v4u*)(L + MX_RAWV + s * 272 + (2 * w + cc) * 16);
#pragma unroll
            for (int qk = (OUT ? 0 : 1); qk < 2; ++qk) {
                const int cb0 = 64 * qk + 8 * w;
                v4u rw[4]; f32x4 cw4[5][2];
#pragma unroll
                for (int j = 0; j < 4; ++j) rw[j] = *(const LAS v4u*)(L + MX_RAWQK + (s + j) * 272 + cb0 * 2);
#pragma unroll
                for (int j = 0; j < 5; ++j) { cw4[j][0] = *(const LAS f32x4*)(cwb + j * 128 + cb0); cw4[j][1] = *(const LAS f32x4*)(cwb + j * 128 + cb0 + 4); }
                MX_LDS_FENCE();
                float acc[8];
#pragma unroll
                for (int e = 0; e < 8; ++e) acc[e] = cw4[4][e >> 2][e & 3];
#pragma unroll
                for (int j = 0; j < 4; ++j)
#pragma unroll
                    for (int e2 = 0; e2 < 4; ++e2) { const unsigned x = rw[j][e2];
                        acc[2 * e2] = __builtin_fmaf(cw4[j][(2 * e2) >> 2][(2 * e2) & 3], __uint_as_float(x << 16), acc[2 * e2]);
                        acc[2 * e2 + 1] = __builtin_fmaf(cw4[j][(2 * e2 + 1) >> 2][(2 * e2 + 1) & 3], __uint_as_float(x & 0xffff0000u), acc[2 * e2 + 1]); }
#pragma unroll
                for (int e = 0; e < 8; ++e) acc[e] = acc[e] * __builtin_amdgcn_rcpf(1.0f + fexp(-acc[e]));
                if (qk == 0) {
                    const float wi = fexp(mpv - mxs);
                    v4u o; o.x = pkbf(acc[0], acc[1]); o.y = pkbf(acc[2], acc[3]); o.z = pkbf(acc[4], acc[5]); o.w = pkbf(acc[6], acc[7]);
                    *(LAS v4u*)(L + MX_QS + (s * 72 + 8 * w) * 2) = o;
                    v4u p; p.x = pkbf(acc[0] * wi, acc[1] * wi); p.y = pkbf(acc[2] * wi, acc[3] * wi); p.z = pkbf(acc[4] * wi, acc[5] * wi); p.w = pkbf(acc[6] * wi, acc[7] * wi);
                    *(LAS v4u*)(L + MX_QP + (s * 72 + 8 * w) * 2) = p;
                } else {
                    const float kwt = 0.125f * fexp(a_s - mxe);
                    if (OUT) { v4u o; o.x = pkbf(acc[0] * 0.125f, acc[1] * 0.125f); o.y = pkbf(acc[2] * 0.125f, acc[3] * 0.125f); o.z = pkbf(acc[4] * 0.125f, acc[5] * 0.125f); o.w = pkbf(acc[6] * 0.125f, acc[7] * 0.125f);
                        *(LAS v4u*)(L + MX_KS + (s * 72 + 8 * w) * 2) = o; }
#pragma unroll
                    for (int e2 = 0; e2 < 4; ++e2) { const unsigned pk = pkbf(acc[2 * e2] * kwt, acc[2 * e2 + 1] * kwt);
                        ((LAS bf16*)(L + MX_KWT))[(8 * w + 2 * e2) * 72 + s] = (bf16)(pk & 0xffffu); ((LAS bf16*)(L + MX_KWT))[(8 * w + 2 * e2 + 1) * 72 + s] = (bf16)(pk >> 16); }
                }
            }
#pragma unroll
            for (int cc = 0; cc < 2; ++cc) { const int c = 2 * w + cc; const v4u rw = rvv[cc];
#pragma unroll
                for (int e2 = 0; e2 < 4; ++e2) { ((LAS bf16*)(L + MX_VST))[(8 * c + 2 * e2) * 72 + s] = (bf16)(rw[e2] & 0xffffu); ((LAS bf16*)(L + MX_VST))[(8 * c + 2 * e2 + 1) * 72 + s] = (bf16)(rw[e2] >> 16); } }
        }
        __syncthreads();
        if (OUT) {
            const int mt = w >> 1;
#pragma unroll
            for (int ni = 0; ni < 2; ++ni) { const int nt = 2 * (w & 1) + ni; f32x4 sa = (f32x4){0.f, 0.f, 0.f, 0.f};
#pragma unroll
                for (int ks = 0; ks < 2; ++ks) { const bf16x8 av = *(const LAS bf16x8*)(L + MX_QS + ((16 * mt + l15) * 72 + 32 * ks + 8 * lq) * 2), bv = *(const LAS bf16x8*)(L + MX_KS + ((16 * nt + l15) * 72 + 32 * ks + 8 * lq) * 2);
                    sa = __builtin_amdgcn_mfma_f32_16x16x32_bf16(av, bv, sa, 0, 0, 0); }
                const int s = 16 * nt + l15; const float a_s = gA[64 * n + s]; const f32x4 mx4 = *(const LAS f32x4*)(gMX + 64 * n + 16 * mt + 4 * lq);
                float sw[4];
#pragma unroll
                for (int r = 0; r < 4; ++r) { const int t = 16 * mt + 4 * lq + r; sw[r] = (s <= t) ? sa[r] * fexp(a_s - mx4[r]) : 0.f; }
                const unsigned p01 = pkbf(sw[0], sw[1]), p23 = pkbf(sw[2], sw[3]); const int t0 = 16 * mt + 4 * lq;
                ((LAS bf16*)(L + MX_SS))[(t0 + 0) * 72 + s] = (bf16)(p01 & 0xffffu); ((LAS bf16*)(L + MX_SS))[(t0 + 1) * 72 + s] = (bf16)(p01 >> 16);
                ((LAS bf16*)(L + MX_SS))[(t0 + 2) * 72 + s] = (bf16)(p23 & 0xffffu); ((LAS bf16*)(L + MX_SS))[(t0 + 3) * 72 + s] = (bf16)(p23 >> 16); }
            __syncthreads();
            f32x4 na[4], da = (f32x4){0.f, 0.f, 0.f, 0.f};
#pragma unroll
            for (int i = 0; i < 4; ++i) na[i] = (f32x4){0.f, 0.f, 0.f, 0.f};
#pragma unroll
            for (int ks = 0; ks < 4; ++ks) {
                const int aoff = (ks < 2 ? MX_SS : MX_QP) + ((16 * mt + l15) * 72 + 32 * (ks & 1) + 8 * lq) * 2, bbase = (ks < 2 ? MX_VST : MX_CST) + (32 * (ks & 1) + 8 * lq) * 2;
                const bf16x8 av = *(const LAS bf16x8*)(L + aoff);
#pragma unroll
                for (int i = 0; i < 4; ++i) { const int nt = 4 * (w & 1) + i; const bf16x8 bv = *(const LAS bf16x8*)(L + bbase + (16 * nt + l15) * 144);
                    na[i] = __builtin_amdgcn_mfma_f32_16x16x32_bf16(av, bv, na[i], 0, 0, 0); }
                if ((w & 1) == 0) { const bf16x8 bv = *(const LAS bf16x8*)(L + bbase + (128 + l15) * 144); da = __builtin_amdgcn_mfma_f32_16x16x32_bf16(av, bv, da, 0, 0, 0); }
            }
#pragma unroll
            for (int i = 0; i < 4; ++i) { const int nt = 4 * (w & 1) + i;
#pragma unroll
                for (int r = 0; r < 4; ++r) ((LAS float*)(L + MX_HS))[(16 * mt + 4 * lq + r) * 132 + 16 * nt + l15] = na[i][r]; }
            if ((w & 1) == 0 && l15 == 0) {
#pragma unroll
                for (int r = 0; r < 4; ++r) ((LAS float*)(L + MX_DEN))[16 * mt + 4 * lq + r] = da[r]; }
        }
        {
            const float dec = fexp(gMP[n] - gMXE[n]);
#pragma unroll
            for (int mt2 = 0; mt2 < 4; ++mt2) cacc[mt2] = cacc[mt2] * dec;
            nacc = nacc * dec;
#pragma unroll
            for (int ks = 0; ks < 2; ++ks) { const bf16x8 bv = *(const LAS bf16x8*)(L + MX_VST + ((16 * w + l15) * 72 + 32 * ks + 8 * lq) * 2);
#pragma unroll
                for (int mt2 = 0; mt2 < 4; ++mt2) { const bf16x8 av = *(const LAS bf16x8*)(L + MX_KWT + ((16 * mt2 + l15) * 72 + 32 * ks + 8 * lq) * 2);
                    cacc[mt2] = __builtin_amdgcn_mfma_f32_16x16x32_bf16(av, bv, cacc[mt2], 0, 0, 0); }
                if (w < 4) { const bf16x8 av = *(const LAS bf16x8*)(L + MX_KWT + ((16 * w + l15) * 72 + 32 * ks + 8 * lq) * 2), bn = *(const LAS bf16x8*)(L + MX_VST + ((128 + l15) * 72 + 32 * ks + 8 * lq) * 2);
                    nacc = __builtin_amdgcn_mfma_f32_16x16x32_bf16(av, bn, nacc, 0, 0, 0); } }
        }
        __syncthreads();
        if (OUT) {
#pragma unroll
            for (int mt2 = 0; mt2 < 4; ++mt2) { unsigned long long v = (unsigned long long)pkbf(cacc[mt2][0], cacc[mt2][1]) | ((unsigned long long)pkbf(cacc[mt2][2], cacc[mt2][3]) << 32);
                *(LAS unsigned long long*)(L + MX_CST + ((16 * w + l15) * 72 + 16 * mt2 + 4 * lq) * 2) = v; }
            if (w < 4) { unsigned long long v = (unsigned long long)pkbf(nacc[0], nacc[1]) | ((unsigned long long)pkbf(nacc[2], nacc[3]) << 32);
                *(LAS unsigned long long*)(L + MX_CST + ((128 + l15) * 72 + 16 * w + 4 * lq) * 2) = v; }
            f32x4 hh[2][2]; float dn[2], flr[2];
#pragma unroll
            for (int k = 0; k < 2; ++k) { const int id = tid + 512 * k, t = id >> 4, c = id & 15;
                hh[k][0] = *(const LAS f32x4*)(L + MX_HS + (t * 132 + 8 * c) * 4); hh[k][1] = *(const LAS f32x4*)(L + MX_HS + (t * 132 + 8 * c + 4) * 4);
                dn[k] = ((const LAS float*)(L + MX_DEN))[t]; flr[k] = gFL[64 * n + t]; }
            MX_LDS_FENCE();
#pragma unroll
            for (int k = 0; k < 2; ++k) { const int id = tid + 512 * k, t = id >> 4, c = id & 15;
                const float inv = __builtin_amdgcn_rcpf(fmaxf(fabsf(dn[k]), flr[k]));
                float hv[8] = {hh[k][0][0] * inv, hh[k][0][1] * inv, hh[k][0][2] * inv, hh[k][0][3] * inv, hh[k][1][0] * inv, hh[k][1][1] * inv, hh[k][1][2] * inv, hh[k][1][3] * inv};
                float sm = 0.f;
#pragma unroll
                for (int e = 0; e < 8; ++e) sm += hv[e];
                sm = row_sum16(sm);
                const float mean = sm * (1.f / 128.f); float q = 0.f;
#pragma unroll
                for (int e = 0; e < 8; ++e) { hv[e] -= mean; q = __builtin_fmaf(hv[e], hv[e], q); }
                q = row_sum16(q);
                const float rstd = rsqrtf(q * (1.f / 128.f) + LN_EPS);
                float yv[8];
#pragma unroll
                for (int e2 = 0; e2 < 4; ++e2) { const unsigned x = ro[k][e2]; const float o0 = __uint_as_float(x << 16), o1 = __uint_as_float(x & 0xffff0000u);
                    yv[2 * e2] = hv[2 * e2] * rstd * gain[2 * e2] * __builtin_amdgcn_rcpf(1.0f + fexp(-o0)); yv[2 * e2 + 1] = hv[2 * e2 + 1] * rstd * gain[2 * e2 + 1] * __builtin_amdgcn_rcpf(1.0f + fexp(-o1)); }
                v4u o; o.x = pkbf(yv[0], yv[1]); o.y = pkbf(yv[2], yv[3]); o.z = pkbf(yv[4], yv[5]); o.w = pkbf(yv[6], yv[7]);
                *(GAS v4u*)(Y + (gr_seg + 64 * n + t) * DM + 512 + 128 * h + 8 * c) = o; }
            if (n + 1 < 8) MX_LOAD_O(n + 1);
            __syncthreads();
        }
    }
    }
    if (!OUT) {
        float* st = ST + (size_t)u * ST_FLOATS;
#pragma unroll
        for (int mt = 0; mt < 4; ++mt)
#pragma unroll
            for (int r = 0; r < 4; ++r) st[(16 * mt + 4 * lq + r) * 144 + 16 * w + l15] = cacc[mt][r];
        if (w < 4) {
#pragma unroll
            for (int r = 0; r < 4; ++r) st[(16 * w + 4 * lq + r) * 144 + 128 + l15] = nacc[r]; }
    }
    __syncthreads();
}

constexpr int SG_VNT = 0, SG_SOUT = 34816, SG_RAW = 34816;
__device__ __forceinline__ void sgu_phase(Frame& F, const Args& args, int l) {
    const int tid = F.tid, lane = F.lane, w = F.wave, l15 = lane & 15, lq = lane >> 4;
    unsigned char* ws = F.ws; const bf16* Z = (const bf16*)(ws + WS_Z); bf16* Y = (bf16*)(ws + WS_Y);
    LAS unsigned char* L = F.lds;
    const int h = F.vcu & 3;
    const float* sw = INP(6) + ((size_t)l * 4 + h) * 128 * 128; const float* sb = INP(7) + (l * 4 + h) * 128;
    const float* lg = INP(8) + (l * 4 + h) * 128; const float* lb = INP(9) + (l * 4 + h) * 128;
    bf16x8 wa[4];
#pragma unroll
    for (int ks = 0; ks < 4; ++ks) { const float* p = sw + (size_t)(16 * w + l15) * 128 + 32 * ks + 8 * lq; const f32x4 a = *(const GAS f32x4*)p, b = *(const GAS f32x4*)(p + 4);
        v4u o; o.x = pkbf(a[0], a[1]); o.y = pkbf(a[2], a[3]); o.z = pkbf(b[0], b[1]); o.w = pkbf(b[2], b[3]);
        if (w < 4 && ks >= 2) o = (v4u){0u, 0u, 0u, 0u};
        wa[ks] = __builtin_bit_cast(bf16x8, o); }
    float bsr[4];
#pragma unroll
    for (int r = 0; r < 4; ++r) bsr[r] = sb[16 * w + 4 * lq + r];
    float lgv[8], lbv[8];
#pragma unroll
    for (int e = 0; e < 8; ++e) { lgv[e] = lg[8 * (tid & 15) + e]; lbv[e] = lb[8 * (tid & 15) + e]; }
    v4u pv_[4], pu_[4];
#pragma unroll
    for (int k = 0; k < 4; ++k) { const int id = tid + 512 * k; pv_[k] = *(const GAS v4u*)(Z + ((size_t)((F.vcu >> 2) * 4) * 128 + (id >> 4)) * ZW + 512 + 128 * h + 8 * (id & 15)); }
#pragma unroll 1
    for (int it = 0; it < 4; ++it) {
        const int blk = (F.vcu >> 2) * 4 + it;
        const size_t r0 = (size_t)blk * 128;
#pragma unroll
        for (int k = 0; k < 4; ++k) { const int id = tid + 512 * k; pu_[k] = *(const GAS v4u*)(Z + (r0 + (id >> 4)) * ZW + 128 * h + 8 * (id & 15)); }
#pragma unroll
        for (int k = 0; k < 4; ++k) { const int id = tid + 512 * k, j = id >> 4, c = id & 15;
            const v4u rw = pv_[k];
            float v[8];
#pragma unroll
            for (int e2 = 0; e2 < 4; ++e2) { v[2 * e2] = __uint_as_float(rw[e2] << 16); v[2 * e2 + 1] = __uint_as_float(rw[e2] & 0xffff0000u); }
            float sm = 0.f;
#pragma unroll
            for (int e = 0; e < 8; ++e) sm += v[e];
            sm = row_sum16(sm);
            const float mean = sm * (1.f / 128.f); float q = 0.f;
#pragma unroll
            for (int e = 0; e < 8; ++e) { v[e] -= mean; q = __builtin_fmaf(v[e], v[e], q); }
            q = row_sum16(q);
            const float rstd = rsqrtf(q * (1.f / 128.f) + LN_EPS);
#pragma unroll
            for (int e = 0; e < 8; ++e) v[e] = v[e] * rstd * lgv[e] + lbv[e];
            v4u o; o.x = pkbf(v[0], v[1]); o.y = pkbf(v[2], v[3]); o.z = pkbf(v[4], v[5]); o.w = pkbf(v[6], v[7]);
            *(LAS v4u*)(L + SG_RAW + j * 272 + c * 16) = o; }
        if (it + 1 < 4) {
#pragma unroll
            for (int k = 0; k < 4; ++k) { const int id = tid + 512 * k; pv_[k] = *(const GAS v4u*)(Z + (r0 + 128 + (id >> 4)) * ZW + 512 + 128 * h + 8 * (id & 15)); } }
        __syncthreads();
#pragma unroll
        for (int k = 0; k < 4; ++k) { const int id = w + 8 * k;
            const int c = id & 15, j = 64 * (id >> 4) + lane; const v4u rw = *(const LAS v4u*)(L + SG_RAW + j * 272 + c * 16);
#pragma unroll
            for (int e2 = 0; e2 < 4; ++e2) { ((LAS bf16*)(L + SG_VNT))[(8 * c + 2 * e2) * 136 + j] = (bf16)(rw[e2] & 0xffffu); ((LAS bf16*)(L + SG_VNT))[(8 * c + 2 * e2 + 1) * 136 + j] = (bf16)(rw[e2] >> 16); } }
        __syncthreads();
        {
            f32x4 sa[8];
#pragma unroll
            for (int nt = 0; nt < 8; ++nt) sa[nt] = (f32x4){0.f, 0.f, 0.f, 0.f};
#pragma unroll
            for (int ks = 0; ks < 4; ++ks) {
                if (ks < 2 || w >= 4) {
#pragma unroll
                    for (int nt = 0; nt < 8; ++nt) { const bf16x8 bv = *(const LAS bf16x8*)(L + SG_VNT + ((16 * nt + l15) * 136 + 32 * ks + 8 * lq) * 2);
                        sa[nt] = __builtin_amdgcn_mfma_f32_16x16x32_bf16(wa[ks], bv, sa[nt], 0, 0, 0); } } }
#pragma unroll
            for (int nt = 0; nt < 8; ++nt)
#pragma unroll
                for (int r = 0; r < 4; ++r) ((LAS float*)(L + SG_SOUT))[(16 * w + 4 * lq + r) * 132 + 16 * nt + l15] = sa[nt][r] + bsr[r];
        }
        __syncthreads();
#pragma unroll
        for (int k = 0; k < 4; ++k) { const int id = tid + 512 * k, i = id >> 4, c = id & 15;
            const v4u rw = pu_[k];
            const f32x4 s0 = *(const LAS f32x4*)(L + SG_SOUT + (i * 132 + 8 * c) * 4), s1 = *(const LAS f32x4*)(L + SG_SOUT + (i * 132 + 8 * c + 4) * 4);
            v4u o; o.x = pkbf(__uint_as_float(rw[0] << 16) * s0[0], __uint_as_float(rw[0] & 0xffff0000u) * s0[1]); o.y = pkbf(__uint_as_float(rw[1] << 16) * s0[2], __uint_as_float(rw[1] & 0xffff0000u) * s0[3]);
            o.z = pkbf(__uint_as_float(rw[2] << 16) * s1[0], __uint_as_float(rw[2] & 0xffff0000u) * s1[1]); o.w = pkbf(__uint_as_float(rw[3] << 16) * s1[2], __uint_as_float(rw[3] & 0xffff0000u) * s1[3]);
            *(GAS v4u*)(Y + (r0 + i) * DM + 128 * h + 8 * c) = o; }
        __syncthreads();
    }
}
#define MIXER_PASS1 mlstm_phase<false>(F, args, l);
#define MIXER_PASS2 { mlstm_phase<true>(F, args, l); sgu_phase(F, args, l); }
__global__ void __launch_bounds__(NWAVES * 64, 2) mk_fwd(Args args) {
    extern __shared__ __attribute__((aligned(16))) unsigned char lds[];
    Frame F;
    F.lds = (LAS unsigned char*)lds;
    F.MISC = (volatile LAS unsigned*)(F.lds + MISC_OFF);
    F.tid = threadIdx.x; F.lane = F.tid & 63; F.wave = __builtin_amdgcn_readfirstlane(F.tid >> 6);
    F.G = gridDim.x; { const int bx = blockIdx.x; F.vcu = (F.G % 8 == 0) ? (bx % 8) * (F.G / 8) + bx / 8 : bx; }
    F.ws = args.ws;
    F.ctl = (gu32*)(F.ws + WS_CTL);
    for (int u = F.tid; u < (LDS_BYTES - LDSCTL_OFF) / 4; u += NWAVES * 64) ((LAS unsigned*)(F.lds + LDSCTL_OFF))[u] = 0u;
    __syncthreads();
    if (F.tid == 0) {
#pragma unroll
        for (int i = 0; i < 20; ++i) ((LAS unsigned long long*)(F.lds + PT_OFF))[i] = (unsigned long long)args.in[i];
        ((LAS unsigned long long*)(F.lds + PT_OFF))[20] = (unsigned long long)args.out; }
    __syncthreads();
    const int lo = args.ph_lo, hi = args.ph_hi;
    XcdBarrier bar; bar.bar = (unsigned*)(F.ctl + CW_BAR) + args.bar_region * XCD_BAR_WORDS; bar.x = 0; bar.st = nullptr;
    if (hi - lo > 1) bar = xcd_barrier_post((unsigned*)(F.ctl + CW_BAR) + args.bar_region * XCD_BAR_WORDS, F.MISC + 8);

#pragma unroll 1
    for (int ph = lo; ph < hi; ++ph) {
        const int l = (ph - 1) / 8, sub = (ph - 1) % 8;
        int nrep = 1;
        if (DUP_MASK && ph < NPHASE - 1) { if (ph == 0) nrep += (DUP_MASK >> 7) & 1; else nrep += (DUP_MASK >> sub) & 1; }
#pragma unroll 1
        for (int rep = 0; rep < nrep; ++rep) {
        if (ph > lo || rep) xcd_barrier(bar, F.wave == 0 && mk_lane() == 0);
        if (PROBE_CLK >= 10 && blockIdx.x == 0 && F.tid == 0) ((unsigned long long*)(F.ws + WS_CTL + 16384))[ph] = __builtin_amdgcn_s_memrealtime();
#define FRESH_LANE() do { F.lane = mk_lane(); asm volatile("" : "+v"(F.lane)); F.tid = F.wave * 64 + F.lane; } while (0)
        asm volatile("" : "+s"(F.vcu), "+s"(F.wave), "+s"(F.G));
        { unsigned long long wsi = (unsigned long long)F.ws; asm volatile("" : "+s"(wsi)); F.ws = (unsigned char*)(GAS unsigned char*)wsi; }
        unsigned char* ws = F.ws;
        bf16* XN = (bf16*)(ws + WS_XN); bf16* Z = (bf16*)(ws + WS_Z); float* GT = (float*)(ws + WS_GT); bf16* Y = (bf16*)(ws + WS_Y); bf16* H = (bf16*)(ws + WS_H);
        float* G0 = (float*)(ws + WS_G0); float* UP0 = (float*)(ws + WS_UP0);
        if (ph == 0) { FRESH_LANE(); p0_prologue(F, args); continue; }
        if (ph == NPHASE - 1) { FRESH_LANE(); final_ln_phase(F, XN, (const float*)(ws + WS_PARTB), INP(18) + (DEPTH - 1) * DM, INP(19) + (DEPTH - 1) * DM, ((float*)INP(20))); continue; }
        const unsigned char* wt = ws + WS_WT + (size_t)l * WT_LAYER;
        const float* cv = (const float*)(ws + WS_CV); float* partA = (float*)(ws + WS_PARTA); float* partB = (float*)(ws + WS_PARTB);
        if (sub == 0) {
#ifndef NO_Z
            FRESH_LANE();
            if (l == 0) cvec_finalize(F, args);
            const float* part = l > 0 ? partB : nullptr;
            pg8::Gemm g{XN, (const bf16*)(wt + WT_IN), M, ZW, DM}; pg8::StaticOrder S; S.init(M, ZW, F.G, (int)blockIdx.x);
            pg8::EpiZ E{Z, ZW, part, cv + CV_IN1, cv + CV_IN1 + 2576, F.lds + MX_TAB};
            pg8::gemm_phase<pg8::EpiZ, pg8::StaticOrder, true, true>(F.lds + RING_OFF, g, S, E, F.tid);
            FRESH_LANE();
            gates_phase(F, XN, (const bf16*)(wt + WT_G), GT, part, cv + CV_IN1 + ZW, cv + CV_IN1 + 2576 + ZW);
            if (l == 0) { FRESH_LANE(); quant_w_step(F); }
#endif
        } else if (sub == 1) {
#ifndef NO_MIX
            FRESH_LANE();
            MIXER_PASS1
#endif
        } else if (sub == 2) {
#ifndef NO_MIX
            FRESH_LANE();
            MIXER_PASS2
#endif
        } else if (sub == 3) {
#ifndef NO_RES
            FRESH_LANE();
            res_gemm_phase(F, Y, (const bf16*)(wt + WT_OUT), DM, XN, (DUP_MASK && rep == 0 && nrep == 2) ? (bf16*)(ws + 295 * MiB) : XN, l > 0 ? partB : (const float*)nullptr, INP(18) + (l > 0 ? l - 1 : 0) * DM, INP(19) + (l > 0 ? l - 1 : 0) * DM, (DUP_MASK && rep == 0 && nrep == 2) ? (float*)(ws + 400 * MiB) : partA);
#endif
        } else if (sub == 4) {
            FRESH_LANE();
            quant_a_phase(F, XN);
        } else if (sub == 5) {
#ifndef NO_GLU
            FRESH_LANE();
            pg8::Gemm g{(const bf16*)(ws + WS_V8), (const bf16*)(ws + WS_W8 + (size_t)l * 2 * DFF * DM), M, 2 * DFF, DM / 2}; pg8::StaticOrder S; S.init(M, 2 * DFF, F.G, (int)blockIdx.x);
            const float* cu = cv + (l == 0 ? CV_UP0 : CV_UP1); const float* swc = (const float*)(ws + WS_SWC) + (size_t)l * 4 * DFF;
            pg8::EpiGlu8 E{H, INP(15) + (size_t)l * 3 * DFF, INP(16) + l * DFF, G0, UP0, DFF, M / 64, partA, swc + 2 * DFF, cu + 5632, F.lds + MX_TAB, swc, (const float*)(ws + WS_SA)};
            pg8::gemm_phase<pg8::EpiGlu8, pg8::StaticOrder, true, true>(F.lds + RING_OFF, g, S, E, F.tid);
#endif
        } else if (sub == 6) {
            FRESH_LANE();
            glu_fixup_phase(F, G0, UP0, INP(15) + (size_t)l * 3 * DFF, INP(16) + l * DFF, H);
        } else {
#ifndef NO_RES
            FRESH_LANE();
            res_gemm_phase(F, H, (const bf16*)(wt + WT_DN), DFF, XN, (DUP_MASK && rep == 0 && nrep == 2) ? (bf16*)(ws + WS_T4) : XN, partA, INP(12) + l * DM, INP(13) + l * DM, (DUP_MASK && rep == 0 && nrep == 2) ? (float*)(ws + WS_T4 + 128 * MiB) : partB);
#endif
        }
        }
    }
    if (PROBE_CLK && hi == NPHASE) { xcd_barrier(bar, F.wave == 0 && mk_lane() == 0); if (blockIdx.x == 0 && F.tid == 0) {
        if (PROBE_CLK >= 10) { unsigned long long* ts = (unsigned long long*)(F.ws + WS_CTL + 16384); ts[NPHASE] = __builtin_amdgcn_s_memrealtime(); const int k = PROBE_CLK - 10;
            ((float*)INP(20))[0] += 0.1f + 1e-5f * (float)(ts[k + 1] - ts[k]); }
        else ((float*)INP(20))[0] += ((float*)(F.ws + WS_CTL))[2048]; } }
}

static void launch_mk(const Args& base, int lo, int hi, int region, hipStream_t stream) {
    Args a = base; a.ph_lo = lo; a.ph_hi = hi; a.bar_region = region; a.pad = 0;
    hipLaunchKernelGGL(mk_fwd, dim3(256), dim3(NWAVES * 64), LDS_BYTES, stream, a);
}

extern "C" void kernel_launch(void* const* d_in, const int* in_sizes, int n_in, void* d_out, int out_size, void* d_ws, size_t ws_size, hipStream_t stream) {
    static int inited = 0;
    if (!inited) {
        if (hipFuncSetAttribute((const void*)mk_fwd, hipFuncAttributeMaxDynamicSharedMemorySize, LDS_BYTES) != hipSuccess) fprintf(stderr, "kernel_launch: hipFuncSetAttribute failed\n");
        int dev = 0, cus = 0, per_cu = 0;
        if (hipGetDevice(&dev) != hipSuccess || hipDeviceGetAttribute(&cus, hipDeviceAttributeMultiprocessorCount, dev) != hipSuccess) cus = 0;
        if (hipOccupancyMaxActiveBlocksPerMultiprocessor(&per_cu, (const void*)mk_fwd, NWAVES * 64, LDS_BYTES) != hipSuccess) per_cu = 0;
        (void)hipGetLastError();
        if (cus * per_cu < 256) fprintf(stderr, "kernel_launch: %d CUs x %d resident workgroups per CU < the 256 workgroups this kernel's grid barriers need\n", cus, per_cu);
        inited = 1;
    }
    unsigned char* ws = (unsigned char*)d_ws;
    (void)hipMemsetAsync(ws + WS_CTL, 0, CTL_ZERO_BYTES, stream);
    Args a{};
    for (int i = 0; i < 20; ++i) a.in[i] = (const float*)d_in[i];
    a.out = (float*)d_out; a.ws = ws;
    launch_mk(a, 0, NPHASE, 0, stream);
}
```

```cpp
constexpr int PROBE_CLK = 0;
constexpr int PROBE_NULL = 0;
constexpr int DUP_MASK = 0;
#include <hip/hip_runtime.h>
#include <cstdint>
#include <cstdio>

constexpr int BATCH = 4, SEQ = 8192, DM = 1024, M = BATCH * SEQ, DEPTH = 2;
constexpr int DA = 512, DQK = 256, DB = 512, NH = 4;
constexpr int DIN = 2568, ZW = 2560, DFF = 2816;
constexpr float LN_EPS = 1e-5f, ALPHA = 1.41421356237f;

typedef unsigned short bf16;
typedef unsigned u32x4 __attribute__((ext_vector_type(4)));

__device__ __forceinline__ float bf2f(bf16 v) { return __uint_as_float(((unsigned)v) << 16); }
__device__ __forceinline__ bf16 f2bf(float f) { unsigned u = __float_as_uint(f); return (bf16)((u + 0x7fffu + ((u >> 16) & 1u)) >> 16); }
__device__ __forceinline__ float gelu_f(float x) { return 0.5f * x * (1.0f + erff(x * 0.70710678118f)); }
__device__ __forceinline__ float silu_f(float x) { return x / (1.0f + expf(-x)); }
__device__ __forceinline__ float sigmoid_f(float x) { return 1.0f / (1.0f + expf(-x)); }
__device__ __forceinline__ float logsigmoid_f(float x) { return fminf(x, 0.f) - log1pf(expf(-fabsf(x))); }

constexpr size_t MiB = 1u << 20;
constexpr size_t WS_XN = 0;
constexpr size_t WS_Z = 64 * MiB;
constexpr size_t WS_GT = 224 * MiB;
constexpr size_t WS_Y = 225 * MiB;
constexpr size_t WS_HM = 289 * MiB;
constexpr size_t WS_QC = 353 * MiB;
constexpr size_t WS_KC = 385 * MiB;
constexpr size_t WS_IG = 417 * MiB;
constexpr size_t WS_LF = 417 * MiB + 512 * 1024;
constexpr size_t WS_T3 = 64 * MiB;
constexpr size_t WS_H = 64 * MiB;
constexpr size_t WS_T4 = 240 * MiB;
constexpr size_t WS_T5 = 240 * MiB;


__device__ __forceinline__ int mk_lane() { return (int)__builtin_amdgcn_mbcnt_hi(~0u, __builtin_amdgcn_mbcnt_lo(~0u, 0u)); }
namespace pg8 {
#define PG8_LAS __attribute__((address_space(3)))
typedef unsigned short bf16_t;
typedef short bf16x8 __attribute__((ext_vector_type(8)));
typedef float f32x4 __attribute__((ext_vector_type(4)));
typedef unsigned u32x4 __attribute__((ext_vector_type(4)));
typedef int i32x4 __attribute__((ext_vector_type(4)));
constexpr int BM = 256, BK = 64, HALF = 128, HTB = HALF * BK * 2  , STAGE_BYTES = 8 * HTB, NXCD = 8, WGM = 8;

__host__ __device__ __forceinline__ int lds_byte(int r, int c) { const int st = (r >> 4) * 2 + (c >> 5), rr = r & 15, cc = c & 31, ob = rr * 64 + cc * 2; return st * 1024 + (ob ^ (((ob >> 9) & 1) << 5)); }
__host__ __device__ __forceinline__ void stage_rc(int b, int& R, int& C) { const int st = b / 1024, sb = b % 1024, swz = sb ^ (((sb >> 9) & 1) << 5); R = (st >> 1) * 16 + swz / 64; C = (st & 1) * 32 + (swz % 64) / 2; }
__host__ __device__ __forceinline__ int perm32(int rho) { const int n = rho >> 4, i = rho & 15; return 8 * (i >> 2) + 4 * n + (i & 3); }

struct Unit { int pm, pn; };
struct Gemm { const bf16_t* A; const bf16_t* Bt; int M, N, K; };

struct StaticOrder {
    int nM, nN, nwg, G, c;
    __host__ __device__ void init(int M, int N, int G_, int c_) { nM = M / BM; nN = N / BM; nwg = nM * nN; G = G_; c = c_; }
    __host__ __device__ bool next(int i, Unit& u) const {
        const long L = (long)i * G + c; if (L >= nwg) return false;
        int wgid = (int)L; { const int q = nwg / NXCD, r = nwg % NXCD, xcd = wgid % NXCD, off = wgid / NXCD; wgid = (xcd < r ? xcd * (q + 1) : r * (q + 1) + (xcd - r) * q) + off; }
        const int nig = WGM * nN, gid = wgid / nig, fm = gid * WGM, gsz = (nM - fm) < WGM ? (nM - fm) : WGM;
        u.pm = fm + ((wgid % nig) % gsz); u.pn = (wgid % nig) / gsz; return true;
    }
    __device__ __forceinline__ void a_ready(const Unit&) const {}
    __device__ __forceinline__ void done(const Unit&) const {}
};

__device__ __forceinline__ unsigned cvt_pk_bf16(float lo, float hi) { unsigned r; asm volatile("v_cvt_pk_bf16_f32 %0, %1, %2" : "=v"(r) : "v"(lo), "v"(hi)); return r; }
typedef float f32x2 __attribute__((ext_vector_type(2)));
__device__ __forceinline__ f32x2 gelu_pk(f32x2 v) {
    const f32x2 av = __builtin_elementwise_abs(v), d = av * 0.2316418882f + 1.0f;
    f32x2 t; t.x = __builtin_amdgcn_rcpf(d.x); t.y = __builtin_amdgcn_rcpf(d.y);
    f32x2 q = t * 0.5307027145f + (-0.7265760135f); q = q * t + 0.7107068705f; q = q * t + (-0.142248368f); q = q * t + 0.127414796f; q = q * t;
    const f32x2 s = (v * v) * (-0.72134752044f);
    f32x2 e; e.x = __builtin_amdgcn_exp2f(s.x); e.y = __builtin_amdgcn_exp2f(s.y);
    const f32x2 m = v * (q * e), r = v - m;
    f32x2 o; o.x = v.x < 0.f ? m.x : r.x; o.y = v.y < 0.f ? m.y : r.y; return o;
}

constexpr float K_EPS = 1e-5f, K_ALPHA = 1.41421356237f;
struct RowStat { float nmr, r; };
constexpr int TAB_STAT = 0, TAB_CONST = 8192, TAB_P = 12288, TAB_P2 = 20480, TAB_SW = 12288, TAB_R4 = 24576, TAB_SA = 28672;
__device__ __forceinline__ void glds16(const void* gsrc, PG8_LAS unsigned char* ldst) { __builtin_amdgcn_global_load_lds((const unsigned*)gsrc, (PG8_LAS unsigned*)ldst, 16, 0, 0); }
__device__ __forceinline__ void prefetch_stats(const float* part, int pm, PG8_LAS unsigned char* tab, int wid, int lane) {
    glds16(part + ((size_t)pm * BM + 32 * wid) * 8 + 4 * lane, tab + TAB_STAT + wid * 1024);
}
__device__ __forceinline__ RowStat row_stat_lds(const PG8_LAS unsigned char* tab, int rloc, float eps) {
    const f32x4 a = *(const PG8_LAS f32x4*)(tab + TAB_STAT + rloc * 32), b = *(const PG8_LAS f32x4*)(tab + TAB_STAT + rloc * 32 + 16);
    const float mean = ((a[0] + a[2]) + (b[0] + b[2])) * 0.25f;
    const float d0 = a[0] - mean, d1 = a[2] - mean, d2 = b[0] - mean, d3 = b[2] - mean;
    const float m2 = ((a[1] + a[3]) + (b[1] + b[3])) + 256.0f * ((d0 * d0 + d1 * d1) + (d2 * d2 + d3 * d3));
    RowStat o; o.r = __builtin_amdgcn_rsqf(m2 * (1.0f / 1024.0f) + eps); o.nmr = -mean * o.r; return o;
}
__device__ __forceinline__ void finalize_stats(PG8_LAS unsigned char* tab, int tid, int slot = TAB_P) {
    typedef float f32x2v __attribute__((ext_vector_type(2)));
    if (tid < 256) { const RowStat rs = row_stat_lds(tab, tid, K_EPS); *(PG8_LAS f32x2v*)(tab + slot + 8 * tid) = (f32x2v){rs.nmr, rs.r}; }
}
__device__ __forceinline__ RowStat stat_tab(const PG8_LAS unsigned char* tab, int rloc, int slot = TAB_P) {
    typedef float f32x2v __attribute__((ext_vector_type(2)));
    const f32x2v v = *(const PG8_LAS f32x2v*)(tab + slot + 8 * rloc); RowStat o; o.nmr = v.x; o.r = v.y; return o;
}
__device__ __forceinline__ float sum_fq4(float x) {
    auto a = __builtin_amdgcn_permlane16_swap(__float_as_uint(x), __float_as_uint(x), false, false); const float y = __uint_as_float(a[0]) + __uint_as_float(a[1]);
    auto b = __builtin_amdgcn_permlane32_swap(__float_as_uint(y), __float_as_uint(y), false, false); return __uint_as_float(b[0]) + __uint_as_float(b[1]);
}
__device__ __forceinline__ RowStat row_stat(const float* part, size_t row, float eps) {
    const f32x4 a = *(const f32x4*)(part + row * 8), b = *(const f32x4*)(part + row * 8 + 4);
    const float mean = ((a[0] + a[2]) + (b[0] + b[2])) * 0.25f;
    const float d0 = a[0] - mean, d1 = a[2] - mean, d2 = b[0] - mean, d3 = b[2] - mean;
    const float m2 = ((a[1] + a[3]) + (b[1] + b[3])) + 256.0f * ((d0 * d0 + d1 * d1) + (d2 * d2 + d3 * d3));
    RowStat o; o.r = 1.0f / sqrtf(m2 * (1.0f / 1024.0f) + eps); o.nmr = -mean * o.r; return o;
}
__device__ __forceinline__ f32x2 gelu_ns_pk(f32x2 v) {
    const f32x2 av = __builtin_elementwise_abs(v), d = av * 0.2316418882f + 1.0f;
    f32x2 t; t.x = __builtin_amdgcn_rcpf(d.x); t.y = __builtin_amdgcn_rcpf(d.y);
    f32x2 q = t * 0.5307027145f + (-0.7265760135f); q = q * t + 0.7107068705f; q = q * t + (-0.142248368f); q = q * t + 0.127414796f; q = q * t;
    const f32x2 s = (v * v) * (-0.72134752044f);
    f32x2 e; e.x = __builtin_amdgcn_exp2f(s.x); e.y = __builtin_amdgcn_exp2f(s.y);
    return __builtin_elementwise_max(v, (f32x2){0.f, 0.f}) - av * (q * e);
}
struct EpiZ {
    static constexpr bool PERM = true, AFTER_DRAIN = false, PERM_A = false, I8 = false;
    bf16_t* O; int ldc; const float* part; const float* c1; const float* c0; PG8_LAS unsigned char* tab;
    __device__ __forceinline__ void prefetch(const Unit& u, int wid, int lane) const {
        if (part) { prefetch_stats(part, u.pm, tab, wid, lane);
            if (wid < 2) glds16((wid ? c0 : c1) + u.pn * BM + 4 * lane, tab + TAB_CONST + wid * 1024); }
    }
    __device__ __forceinline__ void operator()(f32x4 (&acc)[2][2][4][2], const Unit& u, int wr, int wc, int fr, int fq) const {
        const int row0 = u.pm * BM + wr * 64 + fr, col0 = u.pn * BM + wc * 32 + 8 * fq, cl0 = wc * 32 + 8 * fq;
        const bool act = u.pn < 4;
        if (part) { finalize_stats(tab, (wr * 4 + wc) * 64 + fr + 16 * fq); asm volatile("s_waitcnt lgkmcnt(0)" ::: "memory"); __builtin_amdgcn_s_barrier(); asm volatile("" ::: "memory"); }
#pragma unroll
        for (int ai = 0; ai < 2; ++ai)
#pragma unroll
            for (int m = 0; m < 4; ++m) { const int rloc = ai * HALF + wr * 64 + m * 16 + fr; bf16_t* rowp = O + (size_t)(u.pm * BM + rloc) * ldc + col0;
                RowStat rs; rs.r = 1.f; rs.nmr = 0.f; if (part) rs = stat_tab(tab, rloc);
#pragma unroll
                for (int bj = 0; bj < 2; ++bj) { u32x4 w;
#pragma unroll
                    for (int n = 0; n < 2; ++n) { f32x4 v = acc[ai][bj][m][n];
                        if (part) { const f32x4 k1 = *(const PG8_LAS f32x4*)(tab + TAB_CONST + (cl0 + bj * HALF + 4 * n) * 4), k0 = *(const PG8_LAS f32x4*)(tab + TAB_CONST + 1024 + (cl0 + bj * HALF + 4 * n) * 4);
                            v = v * rs.r + (k1 * rs.nmr + k0); }
                        if (act) { const f32x2 a = gelu_ns_pk((f32x2){v[0], v[1]}), b = gelu_ns_pk((f32x2){v[2], v[3]}); v = (f32x4){a.x, a.y, b.x, b.y}; }
                        w[2 * n] = cvt_pk_bf16(v[0], v[1]); w[2 * n + 1] = cvt_pk_bf16(v[2], v[3]); }
                    *(u32x4*)(rowp + bj * HALF) = w; }
                asm volatile("" ::: "memory"); }
    }
};

struct EpiRes {
    static constexpr bool PERM = true, AFTER_DRAIN = false, PERM_A = false, I8 = false;
    bf16_t* V; bf16_t* Vout; int ldc; const float* part_prev; const float* gp; const float* bp; float* part_new; PG8_LAS unsigned char* tab;
    __device__ __forceinline__ void prefetch(const Unit& u, int wid, int lane) const {
        if (part_prev) { prefetch_stats(part_prev, u.pm, tab, wid, lane);
            if (wid < 2) glds16((wid ? bp : gp) + u.pn * BM + 4 * lane, tab + TAB_CONST + wid * 1024); }
    }
    __device__ __forceinline__ void operator()(f32x4 (&acc)[2][2][4][2], const Unit& u, int wr, int wc, int fr, int fq) const {
        typedef float f32x2v __attribute__((ext_vector_type(2)));
        const int col0 = u.pn * BM + wc * 32 + 8 * fq, cl0 = wc * 32 + 8 * fq, lane = fr + 16 * fq, wid = wr * 4 + wc;
        PG8_LAS f32x2v* P = (PG8_LAS f32x2v*)(tab + TAB_P);
        u32x4 bwv[2][4][2];
#pragma unroll
        for (int ai = 0; ai < 2; ++ai)
#pragma unroll
            for (int m = 0; m < 4; ++m)
#pragma unroll
                for (int bj = 0; bj < 2; ++bj) bwv[ai][m][bj] = *(const u32x4*)(V + (size_t)(u.pm * BM + ai * HALF + wr * 64 + m * 16 + fr) * ldc + col0 + bj * HALF);
        asm volatile("" ::: "memory");
        if (part_prev) { finalize_stats(tab, wid * 64 + lane, TAB_P2); asm volatile("s_waitcnt lgkmcnt(0)" ::: "memory"); __builtin_amdgcn_s_barrier(); asm volatile("" ::: "memory"); }
#pragma unroll
        for (int ai = 0; ai < 2; ++ai)
#pragma unroll
            for (int m = 0; m < 4; ++m) { const int rloc = ai * HALF + wr * 64 + m * 16 + fr; bf16_t* rowp = V + (size_t)(u.pm * BM + rloc) * ldc + col0; bf16_t* rowo = Vout + (size_t)(u.pm * BM + rloc) * ldc + col0;
                RowStat rs; rs.r = 1.f; rs.nmr = 0.f; if (part_prev) rs = stat_tab(tab, rloc, TAB_P2);
                float sm = 0.f;
#pragma unroll
                for (int bj = 0; bj < 2; ++bj) { const u32x4 bw = bwv[ai][m][bj];
#pragma unroll
                    for (int n = 0; n < 2; ++n) { const unsigned lo = bw[2 * n], hi = bw[2 * n + 1];
                        f32x4 xs = (f32x4){__uint_as_float(lo << 16), __uint_as_float(lo & 0xffff0000u), __uint_as_float(hi << 16), __uint_as_float(hi & 0xffff0000u)};
                        if (part_prev) { const f32x4 gv = *(const PG8_LAS f32x4*)(tab + TAB_CONST + (cl0 + bj * HALF + 4 * n) * 4), bv = *(const PG8_LAS f32x4*)(tab + TAB_CONST + 1024 + (cl0 + bj * HALF + 4 * n) * 4);
                            xs = (xs * rs.r + rs.nmr) * gv + bv; }
                        const f32x4 v = xs * K_ALPHA + acc[ai][bj][m][n]; acc[ai][bj][m][n] = v; sm += (v[0] + v[1]) + (v[2] + v[3]); } }
                sm = sum_fq4(sm);
                const float mw = sm * (1.0f / 64.0f); float q = 0.f;
#pragma unroll
                for (int bj = 0; bj < 2; ++bj)
#pragma unroll
                    for (int n = 0; n < 2; ++n) { const f32x4 d = acc[ai][bj][m][n] - mw; q += (d[0] * d[0] + d[1] * d[1]) + (d[2] * d[2] + d[3] * d[3]); }
                q = sum_fq4(q);
                if (fq == 0) P[rloc * 4 + wc] = (f32x2v){mw, q};
#pragma unroll
                for (int bj = 0; bj < 2; ++bj) { const f32x4 v0 = acc[ai][bj][m][0], v1 = acc[ai][bj][m][1];
                    u32x4 w; w.x = cvt_pk_bf16(v0[0], v0[1]); w.y = cvt_pk_bf16(v0[2], v0[3]); w.z = cvt_pk_bf16(v1[0], v1[1]); w.w = cvt_pk_bf16(v1[2], v1[3]);
                    *(u32x4*)(rowo + bj * HALF) = w; }
                asm volatile("" ::: "memory"); }
        asm volatile("s_waitcnt lgkmcnt(0)" ::: "memory"); __builtin_amdgcn_s_barrier(); asm volatile("" ::: "memory");
        { const int row = wid * 32 + (lane & 31);
          if (lane < 32) { const f32x2v a = P[row * 4 + 0], b = P[row * 4 + 1], c = P[row * 4 + 2], d = P[row * 4 + 3];
            const float mt = (a.x + b.x + c.x + d.x) * 0.25f; const float da = a.x - mt, db = b.x - mt, dc = c.x - mt, dd = d.x - mt;
            const float m2 = (a.y + b.y) + (c.y + d.y) + 64.0f * ((da * da + db * db) + (dc * dc + dd * dd));
            *(f32x2v*)(part_new + (size_t)(u.pm * BM + row) * 8 + 2 * u.pn) = (f32x2v){mt, m2}; } }
    }
};

#define PG8_DPP0(src, ctrl) __builtin_bit_cast(float, __builtin_amdgcn_update_dpp(0, __builtin_bit_cast(int, (float)(src)), (ctrl), 0xf, 0xf, true))
__device__ __forceinline__ f32x2 gelu_mul_pk(f32x2 v, f32x2 u) {
    const f32x2 av = __builtin_elementwise_abs(v), d = av * 0.2316418882f + 1.0f;
    f32x2 t; t.x = __builtin_amdgcn_rcpf(d.x); t.y = __builtin_amdgcn_rcpf(d.y);
    f32x2 q = t * 0.5307027145f + (-0.7265760135f); q = q * t + 0.7107068705f; q = q * t + (-0.142248368f); q = q * t + 0.127414796f; q = q * t;
    const f32x2 s = (v * v) * (-0.72134752044f);
    f32x2 e; e.x = __builtin_amdgcn_exp2f(s.x); e.y = __builtin_amdgcn_exp2f(s.y);
    const f32x2 r = __builtin_elementwise_max(v, (f32x2){0.f, 0.f}) - av * (q * e);
    return r * u;
}
template <int MODE  , bool I8_ = false> struct EpiGluT {
    static constexpr bool PERM = true, AFTER_DRAIN = false, PERM_A = true, I8 = I8_;
    bf16_t* H; const float* cw; const float* cb; float* G0; float* UP0; int dff; int ngrp; const float* part; const float* c1; const float* c0; PG8_LAS unsigned char* tab; const float* sw; const float* sa;
    __device__ __forceinline__ void prefetch(const Unit& u, int wid, int lane) const {
        prefetch_stats(part, u.pm, tab, wid, lane);
        if (wid < 4) { const int v = 2 * wid + (lane >> 5), c4 = (lane & 31) * 4;
            const float* src = (v < 3) ? cw + v * dff : (v == 3) ? cb : (v & 1) ? c0 + ((v - 4) >> 1) * dff : c1 + ((v - 4) >> 1) * dff;
            glds16(src + u.pn * HALF + c4, tab + TAB_CONST + wid * 1024); }
        if (I8_) {
            if (wid == 4) glds16(sw + (lane >> 5) * dff + u.pn * HALF + (lane & 31) * 4, tab + TAB_SW);
            if (wid == 5) glds16(sa + (size_t)u.pm * BM + 4 * lane, tab + TAB_SA); }
    }
    __device__ __forceinline__ void operator()(f32x4 (&acc)[2][2][4][2], const Unit& u, int wr, int wc, int fr, int fq) const {
        const int hc0 = u.pn * HALF + wc * 32 + 8 * fq;
        const PG8_LAS unsigned char* wt_ = tab + TAB_CONST + (wc * 32 + 8 * fq) * 4;
#define PG8_TABV(v_, n_) (*(const PG8_LAS f32x4*)(wt_ + (v_) * 512 + (4 * (n_)) * 4))
        if (MODE == 0 && !I8_) { finalize_stats(tab, (wr * 4 + wc) * 64 + fr + 16 * fq); asm volatile("s_waitcnt lgkmcnt(0)" ::: "memory"); __builtin_amdgcn_s_barrier(); asm volatile("" ::: "memory"); }
        if (MODE == 0 && I8_) { const int tid_ = (wr * 4 + wc) * 64 + fr + 16 * fq;
            if (tid_ < 256) { const RowStat rs = row_stat_lds(tab, tid_, K_EPS); const float sa_ = *(const PG8_LAS float*)(tab + TAB_SA + 4 * tid_); *(PG8_LAS f32x4*)(tab + TAB_R4 + 16 * tid_) = (f32x4){rs.nmr, rs.r, rs.r * sa_, 0.f}; }
            asm volatile("s_waitcnt lgkmcnt(0)" ::: "memory"); __builtin_amdgcn_s_barrier(); asm volatile("" ::: "memory"); }
#pragma unroll
        for (int ai = 0; ai < 2; ++ai) {
            const int tb = u.pm * BM + ai * HALF + wr * 64, grp = tb >> 6;
            if (MODE == 0 && I8_) {
                f32x4 r4[4];
#pragma unroll
                for (int m = 0; m < 4; ++m) r4[m] = *(const PG8_LAS f32x4*)(tab + TAB_R4 + 16 * (ai * HALF + wr * 64 + 4 * fr + m));
#pragma unroll
                for (int bj = 0; bj < 2; ++bj)
#pragma unroll
                    for (int n = 0; n < 2; ++n) { const f32x4 k1 = PG8_TABV(4 + 2 * bj, n), k0 = PG8_TABV(5 + 2 * bj, n), swv = PG8_TABV(8 + bj, n);
#pragma unroll
                        for (int m = 0; m < 4; ++m) { const f32x4 fv = __builtin_convertvector(__builtin_bit_cast(i32x4, acc[ai][bj][m][n]), f32x4);
                            acc[ai][bj][m][n] = fv * (swv * r4[m][2]) + (k1 * r4[m][0] + k0); } }
                asm volatile("" ::: "memory");
            }
            if (MODE == 0 && !I8_) {
                RowStat rs[4];
#pragma unroll
                for (int m = 0; m < 4; ++m) rs[m] = stat_tab(tab, ai * HALF + wr * 64 + 4 * fr + m);
#pragma unroll
                for (int bj = 0; bj < 2; ++bj)
#pragma unroll
                    for (int n = 0; n < 2; ++n) { const f32x4 k1 = PG8_TABV(4 + 2 * bj, n), k0 = PG8_TABV(5 + 2 * bj, n);
#pragma unroll
                        for (int m = 0; m < 4; ++m) acc[ai][bj][m][n] = acc[ai][bj][m][n] * rs[m].r + (k1 * rs[m].nmr + k0); }
                asm volatile("" ::: "memory");
            }
            unsigned hp[4][2];
#pragma unroll
            for (int n = 0; n < 2; ++n) {
                const f32x4 w0 = PG8_TABV(0, n), w1 = PG8_TABV(1, n), w2 = PG8_TABV(2, n), cbv = PG8_TABV(3, n);
#pragma unroll
                for (int m = 0; m < 4; ++m) {
                    const int t = tb + 4 * fr + m; const f32x4 gg = acc[ai][0][m][n], up = acc[ai][1][m][n]; f32x4 hv;
                    if (MODE == 1) { hv = gg * up; } else {
                    f32x4 g1, g2;
                    if (m == 0) {
#pragma unroll
                        for (int e = 0; e < 4; ++e) { g1[e] = PG8_DPP0(acc[ai][0][3][n][e], 0x111); g2[e] = PG8_DPP0(acc[ai][0][2][n][e], 0x111); } }
                    else if (m == 1) { g1 = acc[ai][0][0][n];
#pragma unroll
                        for (int e = 0; e < 4; ++e) g2[e] = PG8_DPP0(acc[ai][0][3][n][e], 0x111); }
                    else { g1 = acc[ai][0][m - 1][n]; g2 = acc[ai][0][m - 2][n]; }
                    const f32x4 cv = cbv + w0 * g2 + w1 * g1 + w2 * gg;
                    const f32x2 a = gelu_mul_pk((f32x2){cv[0], cv[1]}, (f32x2){up[0], up[1]}), b = gelu_mul_pk((f32x2){cv[2], cv[3]}, (f32x2){up[2], up[3]});
                    hv = (f32x4){a.x, a.y, b.x, b.y}; }
                    if (MODE == 0 && fr == 0 && m < 2) {
                        *(f32x4*)(G0 + ((size_t)grp * 4 + 2 + m) * dff + hc0 + 4 * n) = gg; *(f32x4*)(UP0 + ((size_t)grp * 2 + m) * dff + hc0 + 4 * n) = up; }
                    if (MODE == 0 && fr == 15 && m >= 2 && grp + 1 < ngrp)
                        *(f32x4*)(G0 + ((size_t)(grp + 1) * 4 + (m - 2)) * dff + hc0 + 4 * n) = gg;
                    const unsigned p0 = cvt_pk_bf16(hv[0], hv[1]), p1 = cvt_pk_bf16(hv[2], hv[3]);
                    if (n == 0) { hp[m][0] = p0; hp[m][1] = p1; }
                    else if (MODE == 2) { asm volatile("" :: "v"(p0), "v"(p1), "v"(hp[m][0]), "v"(hp[m][1])); }
                    else if (m >= 2 || fr > 0) { u32x4 w; w.x = hp[m][0]; w.y = hp[m][1]; w.z = p0; w.w = p1; __builtin_nontemporal_store(w, (u32x4*)(H + (size_t)t * dff + hc0)); }
                }
            }
            asm volatile("" ::: "memory");
        }
#undef PG8_TABV
    }
};
typedef EpiGluT<0> EpiGlu;
typedef EpiGluT<0, true> EpiGlu8;
struct EpiNull {
    static constexpr bool PERM = true, AFTER_DRAIN = false, PERM_A = false, I8 = false;
    __device__ __forceinline__ void prefetch(const Unit&, int, int) const {}
    __device__ __forceinline__ void operator()(f32x4 (&acc)[2][2][4][2], const Unit& u, int wr, int wc, int fr, int fq) const {
#pragma unroll
        for (int ai = 0; ai < 2; ++ai)
#pragma unroll
            for (int bj = 0; bj < 2; ++bj)
#pragma unroll
                for (int m = 0; m < 4; ++m) asm volatile("" :: "v"(acc[ai][bj][m][0]), "v"(acc[ai][bj][m][1]));
    }
};
template <class Epi, class Sched, bool ALIGN_EPI = false, bool SP2 = false>
__device__ __forceinline__ void gemm_phase(PG8_LAS unsigned char* lds, const Gemm g, const Sched& S, const Epi& E, int tid_in) {
    int tid_ = tid_in; asm volatile("" : "+v"(tid_));
    const int tid = tid_, wid = __builtin_amdgcn_readfirstlane(tid >> 6), lane = tid & 63, wr = wid >> 2, wc = wid & 3, fr = lane & 15, fq = lane >> 4;
    const int K = g.K, nt = K / BK;
    unsigned voffA[2], voffB[2];
#pragma unroll
    for (int i = 0; i < 2; ++i) { int R, C; stage_rc(tid * 16 + i * 8192, R, C); const int Rb = Epi::PERM ? ((R & ~31) + perm32(R & 31)) : R;
        const int Ra = Epi::PERM_A ? ((R & ~63) + 4 * (R & 15) + ((R >> 4) & 3)) : R;
        voffA[i] = (unsigned)(Ra * K + C) * 2u; voffB[i] = (unsigned)(Rb * K + C) * 2u; }
    const size_t kstep = (size_t)(BK * 2);
    const size_t hstep = (size_t)HALF * K * 2;
    const size_t tstep = 2 * hstep;
    const unsigned ldsw = (unsigned)wid * 1024u;
    const int aoff = lds_byte(wr * 64 + fr, fq * 8), boff = lds_byte(wc * 32 + fr, fq * 8);
#define PG8_SA(b, h) (((b) * 2 + (h)) * HTB)
#define PG8_SB(b, h) ((4 + (b) * 2 + (h)) * HTB)
#define PG8_STAGE(bufoff, gbase, voff) do { _Pragma("unroll") for (int _i = 0; _i < 2; ++_i) \
        __builtin_amdgcn_global_load_lds((const unsigned*)((const char*)(gbase) + (voff)[_i]), (PG8_LAS unsigned*)(lds + (bufoff) + ldsw + _i * 8192), 16, 0, 0); } while (0)
#define PG8_LDA(dst, b, h) do { _Pragma("unroll") for (int m = 0; m < 4; ++m) _Pragma("unroll") for (int k = 0; k < 2; ++k) dst[m][k] = *(const PG8_LAS bf16x8*)(lds + PG8_SA(b, h) + aoff + m * 2048 + k * 1024); } while (0)
#define PG8_LDB(dst, b, h) do { _Pragma("unroll") for (int n = 0; n < 2; ++n) _Pragma("unroll") for (int k = 0; k < 2; ++k) dst[n][k] = *(const PG8_LAS bf16x8*)(lds + PG8_SB(b, h) + boff + n * 2048 + k * 1024); } while (0)
#define PG8_MMA(ai, bj, At, Bt) do { __builtin_amdgcn_s_setprio(1); _Pragma("unroll") for (int m = 0; m < 4; ++m) _Pragma("unroll") for (int n = 0; n < 2; ++n) _Pragma("unroll") for (int k = 0; k < 2; ++k) \
        { if constexpr (Epi::I8) acc[ai][bj][m][n] = __builtin_bit_cast(f32x4, __builtin_amdgcn_mfma_i32_16x16x64_i8(__builtin_bit_cast(i32x4, Bt[n][k]), __builtin_bit_cast(i32x4, At[m][k]), __builtin_bit_cast(i32x4, acc[ai][bj][m][n]), 0, 0, 0)); \
          else acc[ai][bj][m][n] = __builtin_amdgcn_mfma_f32_16x16x32_bf16(Bt[n][k], At[m][k], acc[ai][bj][m][n], 0, 0, 0); } __builtin_amdgcn_s_setprio(0); } while (0)
#define PG8_WAIT_V(n) asm volatile("s_waitcnt vmcnt(" #n ")" ::: "memory")
#define PG8_WAIT_L(n) asm volatile("s_waitcnt lgkmcnt(" #n ")" ::: "memory")
#define PG8_BAR __builtin_amdgcn_s_barrier()
#define PG8_SCHED __builtin_amdgcn_sched_barrier(0)
    Unit cur, nxt; int ui = 0;
    if (!S.next(0, cur)) return;
    f32x4 acc[2][2][4][2];
    bf16x8 At[4][2], B0[2][2], B1[2][2];
    const char* cA = (const char*)g.A + (size_t)cur.pm * tstep; const char* cB = (const char*)g.Bt + (size_t)cur.pn * tstep;
    S.a_ready(cur);
    if constexpr (SP2) {
        PG8_STAGE(PG8_SB(0, 0), cB, voffB); PG8_STAGE(PG8_SB(0, 1), cB + hstep, voffB); PG8_STAGE(PG8_SA(0, 0), cA, voffA); PG8_STAGE(PG8_SA(0, 1), cA + hstep, voffA);
        if (wr == 1) PG8_BAR;
        PG8_WAIT_V(2); PG8_BAR;
        PG8_STAGE(PG8_SB(1, 0), cB + kstep, voffB); PG8_STAGE(PG8_SA(1, 0), cA + kstep, voffA); PG8_STAGE(PG8_SB(1, 1), cB + hstep + kstep, voffB);
        PG8_WAIT_V(6); PG8_BAR;
    } else {
        PG8_STAGE(PG8_SB(0, 0), cB, voffB); PG8_STAGE(PG8_SA(0, 0), cA, voffA); PG8_STAGE(PG8_SB(0, 1), cB + hstep, voffB); PG8_STAGE(PG8_SA(0, 1), cA + hstep, voffA);
        if (wr == 1) PG8_BAR;
        PG8_WAIT_V(4); PG8_BAR;
        PG8_STAGE(PG8_SB(1, 0), cB + kstep, voffB); PG8_STAGE(PG8_SA(1, 0), cA + kstep, voffA); PG8_STAGE(PG8_SB(1, 1), cB + hstep + kstep, voffB);
        PG8_WAIT_V(6); PG8_BAR;
    }
#pragma unroll
    for (int a = 0; a < 2; ++a)
#pragma unroll
        for (int b = 0; b < 2; ++b)
#pragma unroll
            for (int m = 0; m < 4; ++m)
#pragma unroll
                for (int n = 0; n < 2; ++n) acc[a][b][m][n] = (f32x4){0.f, 0.f, 0.f, 0.f};
    for (;;) {
        const bool has_next = S.next(ui + 1, nxt);
        const char* nA = has_next ? (const char*)g.A + (size_t)nxt.pm * tstep : cA; const char* nB = has_next ? (const char*)g.Bt + (size_t)nxt.pn * tstep : cB;
        { PG8_BAR; int ln_ = (int)__builtin_amdgcn_mbcnt_hi(~0u, __builtin_amdgcn_mbcnt_lo(~0u, 0u)); asm volatile("" : "+v"(ln_)); E.prefetch(cur, wid, ln_); }
        for (int t = 0; t < nt; t += 2) {
            const bool last = (t == nt - 2);
            const char* a1 = cA + (size_t)(t + 1) * kstep;
            const char* a2 = last ? nA : cA + (size_t)(t + 2) * kstep; const char* b2 = last ? nB : cB + (size_t)(t + 2) * kstep;
            const char* a3 = a2 + kstep; const char* b3 = b2 + kstep;
            if (last && has_next) S.a_ready(nxt);
            if constexpr (SP2) {
            PG8_LDB(B0, 0, 0); PG8_LDB(B1, 0, 1); PG8_SCHED; PG8_LDA(At, 0, 0); PG8_STAGE(PG8_SA(1, 1), a1 + hstep, voffA);
            PG8_WAIT_V(8); PG8_WAIT_L(0); PG8_BAR; PG8_MMA(0, 0, At, B0); PG8_MMA(0, 1, At, B1); PG8_BAR; PG8_SCHED;
            PG8_LDA(At, 0, 1); PG8_STAGE(PG8_SB(0, 0), b2, voffB); PG8_STAGE(PG8_SB(0, 1), b2 + hstep, voffB); PG8_STAGE(PG8_SA(0, 0), a2, voffA);
            PG8_WAIT_V(8); PG8_WAIT_L(0); PG8_BAR; PG8_MMA(1, 0, At, B0); PG8_MMA(1, 1, At, B1); PG8_BAR; PG8_SCHED;
            PG8_LDB(B0, 1, 0); PG8_LDB(B1, 1, 1); PG8_SCHED; PG8_LDA(At, 1, 0); PG8_STAGE(PG8_SA(0, 1), a2 + hstep, voffA);
            PG8_WAIT_V(8); PG8_WAIT_L(0); PG8_BAR; PG8_MMA(0, 0, At, B0); PG8_MMA(0, 1, At, B1); PG8_BAR; PG8_SCHED;
            PG8_LDA(At, 1, 1); PG8_STAGE(PG8_SB(1, 0), b3, voffB); PG8_STAGE(PG8_SB(1, 1), b3 + hstep, voffB); PG8_STAGE(PG8_SA(1, 0), a3, voffA);
            PG8_WAIT_V(8); PG8_WAIT_L(0); PG8_BAR; PG8_MMA(1, 0, At, B0); PG8_MMA(1, 1, At, B1); PG8_BAR; PG8_SCHED;
            } else {
            PG8_LDB(B0, 0, 0); PG8_SCHED; PG8_LDA(At, 0, 0); PG8_STAGE(PG8_SA(1, 1), a1 + hstep, voffA);
            PG8_WAIT_L(8); PG8_BAR; PG8_WAIT_L(0); PG8_MMA(0, 0, At, B0); PG8_BAR; PG8_SCHED;
            PG8_LDB(B1, 0, 1); PG8_STAGE(PG8_SB(0, 0), b2, voffB);
            PG8_BAR; PG8_WAIT_L(0); PG8_MMA(0, 1, At, B1); PG8_BAR;
            PG8_LDA(At, 0, 1); PG8_STAGE(PG8_SA(0, 0), a2, voffA);
            PG8_BAR; PG8_WAIT_L(0); PG8_MMA(1, 0, At, B0); PG8_BAR; PG8_SCHED;
            PG8_STAGE(PG8_SB(0, 1), b2 + hstep, voffB);
            PG8_WAIT_V(6); PG8_BAR; PG8_MMA(1, 1, At, B1); PG8_BAR;
            PG8_LDB(B0, 1, 0); PG8_SCHED; PG8_LDA(At, 1, 0); PG8_STAGE(PG8_SA(0, 1), a2 + hstep, voffA);
            PG8_WAIT_L(8); PG8_BAR; PG8_WAIT_L(0); PG8_MMA(0, 0, At, B0); PG8_BAR; PG8_SCHED;
            PG8_LDB(B1, 1, 1); PG8_STAGE(PG8_SB(1, 0), b3, voffB);
            PG8_BAR; PG8_WAIT_L(0); PG8_MMA(0, 1, At, B1); PG8_BAR;
            PG8_LDA(At, 1, 1); PG8_STAGE(PG8_SA(1, 0), a3, voffA);
            PG8_BAR; PG8_WAIT_L(0); PG8_MMA(1, 0, At, B0); PG8_BAR; PG8_SCHED;
            PG8_STAGE(PG8_SB(1, 1), b3 + hstep, voffB);
            PG8_WAIT_V(6); PG8_BAR; PG8_MMA(1, 1, At, B1); PG8_BAR;
            }
        }
        if constexpr (ALIGN_EPI) { if (wr == 0) PG8_BAR; }
        if constexpr (!Epi::AFTER_DRAIN) { int ln_ = (int)__builtin_amdgcn_mbcnt_hi(~0u, __builtin_amdgcn_mbcnt_lo(~0u, 0u)); asm volatile("" : "+v"(ln_));
            E(acc, cur, wr, wc, ln_ & 15, ln_ >> 4); S.done(cur); }
        if (!has_next) break;
#pragma unroll
        for (int a = 0; a < 2; ++a)
#pragma unroll
            for (int b = 0; b < 2; ++b)
#pragma unroll
                for (int m = 0; m < 4; ++m)
#pragma unroll
                    for (int n = 0; n < 2; ++n) acc[a][b][m][n] = (f32x4){0.f, 0.f, 0.f, 0.f};
        cur = nxt; cA = nA; cB = nB; ++ui;
        if constexpr (ALIGN_EPI) { if (wr == 1) PG8_BAR; }
    }
    PG8_WAIT_V(0);
    if constexpr (!ALIGN_EPI) { if (wr == 0) PG8_BAR; }
    PG8_BAR;
    if constexpr (Epi::AFTER_DRAIN) { E.fused(acc, cur, wr, wc, fr, fq, lds, wid, lane); S.done(cur); }
#undef PG8_SA
#undef PG8_SB
#undef PG8_STAGE
#undef PG8_LDA
#undef PG8_LDB
#undef PG8_MMA
#undef PG8_WAIT_V
#undef PG8_WAIT_L
#undef PG8_BAR
#undef PG8_SCHED
}
}
#define GAS __attribute__((address_space(1)))
#define LAS __attribute__((address_space(3)))
typedef unsigned short bf16;
typedef unsigned v4u __attribute__((ext_vector_type(4)));
typedef float f32x4 __attribute__((ext_vector_type(4)));
typedef short bf16x8 __attribute__((ext_vector_type(8)));
typedef GAS unsigned gu32;
typedef GAS unsigned long long gu64;
#define RLX_AGENT __ATOMIC_RELAXED, __HIP_MEMORY_SCOPE_AGENT
#define LDS_WAIT() asm volatile("s_waitcnt lgkmcnt(0)" ::: "memory")
#define VM_WAIT() asm volatile("s_waitcnt vmcnt(0)" ::: "memory")
__device__ __forceinline__ unsigned long long rt() { return __builtin_amdgcn_s_memrealtime(); }

#define XB_TMO      128
#define XB_XCNT(j)  (256  + 64 * (j))
#define XB_XSUB(j)  (1280 + 64 * (j))
#define XB_XGEN(j)  (2304 + 64 * (j))
#define XB_TOP      3328
#define XB_TOPGEN   3392
#define XCD_BAR_WORDS 3456
#define XB_SPIN_CAP (1u << 18)

__device__ __forceinline__ unsigned xb_ld(unsigned* p)              { return __hip_atomic_load(p, __ATOMIC_RELAXED, __HIP_MEMORY_SCOPE_AGENT); }
__device__ __forceinline__ unsigned xb_add(unsigned* p, unsigned v) { return __hip_atomic_fetch_add(p, v, __ATOMIC_RELAXED, __HIP_MEMORY_SCOPE_AGENT); }
__device__ __forceinline__ unsigned xb_xcc_id() { return (unsigned)__builtin_amdgcn_s_getreg((3 << 11) | 20) & 0xFu; }
#define XB_SPIN(cond, bar) do { unsigned _sp = 0; while (cond) { __builtin_amdgcn_s_sleep(1); \
    if ((++_sp & 255u) == 0u) { if (xb_ld(&(bar)[XB_TMO])) break; if (_sp > XB_SPIN_CAP) { atomicAdd(&(bar)[XB_TMO], 1u); break; } } } } while (0)

struct XcdBarrier {
    unsigned* bar; unsigned x;
    volatile LAS unsigned* st;
};

__device__ __forceinline__ XcdBarrier xcd_barrier_post(unsigned* bar, volatile LAS unsigned* st) {
    XcdBarrier b; b.bar = bar; b.x = xb_xcc_id(); b.st = st;
    if (threadIdx.x == 0) (void)xb_add(&bar[XB_XCNT(b.x)], 1u);
    return b;
}
__device__ __forceinline__ void xcd_barrier_complete(unsigned* bar, unsigned x, unsigned& nloc, unsigned& nx) {
    const unsigned G = gridDim.x * gridDim.y * gridDim.z;
    unsigned sum, cnt, mine, sp = 0u;
    for (;;) {
        sum = 0u; cnt = 0u; mine = 0u;
#pragma unroll
        for (unsigned j = 0; j < 16; ++j) { const unsigned c = xb_ld(&bar[XB_XCNT(j)]); sum += c; cnt += (c > 0u) ? 1u : 0u; mine = (j == x) ? c : mine; }
        if (sum == G) break;
        __builtin_amdgcn_s_sleep(1);
        if ((++sp & 255u) == 0u) { if (xb_ld(&bar[XB_TMO])) break; if (sp > XB_SPIN_CAP) { atomicAdd(&bar[XB_TMO], 1u); break; } }
    }
    nloc = mine > 0u ? mine : 1u; nx = cnt > 0u ? cnt : 1u;
}

__device__ __forceinline__ void xcd_barrier(const XcdBarrier& b, bool leader_thread) {
    asm volatile("s_waitcnt vmcnt(0)" ::: "memory");
    __syncthreads();
    if (leader_thread) {
        unsigned* bar = b.bar;
        __builtin_amdgcn_s_waitcnt(0);
        unsigned nloc = b.st[0], nx = b.st[1];
        if (nloc == 0u) { xcd_barrier_complete(bar, b.x, nloc, nx); b.st[0] = nloc; b.st[1] = nx; }
        const unsigned old = xb_add(&bar[XB_XSUB(b.x)], 1u);
        const unsigned gen = old / nloc;
        if (old + 1u == (gen + 1u) * nloc) {
            __builtin_amdgcn_fence(__ATOMIC_RELEASE, "agent");
            asm volatile("s_waitcnt vmcnt(0)" ::: "memory");
            const unsigned og = xb_add(&bar[XB_TOP], 1u);
            const unsigned tg = og / nx;
            if (og + 1u == (tg + 1u) * nx) xb_add(&bar[XB_TOPGEN], 1u);
            else XB_SPIN(xb_ld(&bar[XB_TOPGEN]) == tg, bar);
            __builtin_amdgcn_fence(__ATOMIC_ACQUIRE, "agent");
            xb_add(&bar[XB_XGEN(b.x)], 1u);
            asm volatile("s_waitcnt vmcnt(0)" ::: "memory");
        } else {
            XB_SPIN(xb_ld(&bar[XB_XGEN(b.x)]) == gen, bar);
            __builtin_amdgcn_fence(__ATOMIC_ACQUIRE, "agent");
            asm volatile("s_waitcnt vmcnt(0)" ::: "memory");
        }
    }
    __syncthreads();
}

constexpr int NWAVES = 8;
constexpr size_t WS_CTL = 420 * MiB, CTL_ZERO_BYTES = 64 * 1024;
constexpr size_t WS_XCH = 421 * MiB;
constexpr size_t WS_PARTA = WS_XCH, WS_PARTB = WS_XCH + 1 * MiB, WS_CV = WS_XCH + 2 * MiB, WS_CPART = WS_CV + 256 * 1024;
constexpr int CV_IN1 = 0, CV_UP0 = 2 * 2576, CV_UP1 = CV_UP0 + 2 * 5632, CV_END = CV_UP1 + 2 * 5632;
constexpr int CP_IN1 = 0, CP_UP0 = 16 * 2 * 2576, CP_UP1 = CP_UP0 + 16 * 2 * 5632, CP_END = CP_UP1 + 16 * 2 * 5632;
static_assert(CV_END * 4 <= 256 * 1024 && WS_CPART + (size_t)CP_END * 4 <= WS_XCH + 4 * MiB, "deferred-LN map");
constexpr size_t WS_G0 = 425 * MiB;
constexpr size_t WS_UP0 = 447 * MiB;
constexpr size_t WS_WT = 458 * MiB;
constexpr size_t WT_IN = 0, WT_G = (size_t)2560 * 1024 * 2, WT_OUT = WT_G + 16 * 1024 * 2, WT_UP = WT_OUT + (size_t)1024 * 1024 * 2, WT_DN = WT_UP + (size_t)5632 * 1024 * 2, WT_LAYER = WT_DN + (size_t)1024 * 2816 * 2;
constexpr size_t WS_W8 = 302 * MiB, WS_SWC = 314 * MiB, WS_V8 = 320 * MiB, WS_SA = 353 * MiB;
constexpr size_t WS_MST = 289 * MiB;
static_assert(WS_WT + 2 * WT_LAYER <= 512 * MiB, "ws map");
constexpr int CW_TMO = 0, CW_CODE = 1, CW_BAR = 4096, CW_SEAM = 16384, SEAM_BANK = 128 * 64;
constexpr int MX_TAB = 131072 + 512;
constexpr int RING_OFF = 0, RING_BYTES = 131072, LDSCTL_OFF = RING_BYTES, MISC_OFF = LDSCTL_OFF + 320, LDS_BYTES = 163840;
constexpr int NPHASE = 18;

struct Frame {
    LAS unsigned char* lds; volatile LAS unsigned* MISC; gu32* ctl; unsigned char* ws; int tid, lane, wave, vcu, G;
};
constexpr int PT_OFF = LDSCTL_OFF + 64;
#define INP(i) inptr(F, (i))
__device__ __forceinline__ const float* inptr(const Frame& F, int i) {
    const volatile LAS unsigned* p = (const volatile LAS unsigned*)(F.lds + PT_OFF) + 2 * i;
    const unsigned lo = __builtin_amdgcn_readfirstlane(p[0]), hi = __builtin_amdgcn_readfirstlane(p[1]);
    return (const float*)(const GAS float*)(((unsigned long long)hi << 32) | lo);
}
struct Args { const float* in[20]; float* out; unsigned char* ws; int ph_lo, ph_hi, bar_region, pad; };

__device__ __forceinline__ unsigned pk2(float lo, float hi) { return f2bf(lo) | ((unsigned)f2bf(hi) << 16); }

__device__ __forceinline__ void p0_transpose_item(const float* W, int K, int N, bf16* WT, int k0, int n0, int drow0, LAS float* scr, int lane, const float* gs, const float* bs, float* cp1, float* cp0) {
    float tv[32];
#pragma unroll
    for (int i = 0; i < 32; ++i) { const int kk = 2 * i + (lane >> 5); tv[i] = W[(size_t)(k0 + kk) * N + n0 + (lane & 31)]; }
    if (gs) {
        float s1 = 0.f, s0 = 0.f;
#pragma unroll
        for (int i = 0; i < 32; ++i) { const int kk = 2 * i + (lane >> 5); const float gk = gs[k0 + kk], bk = bs[k0 + kk]; s0 = __builtin_fmaf(bk, tv[i], s0); tv[i] *= gk; s1 += tv[i]; }
        s1 += __shfl_xor(s1, 32); s0 += __shfl_xor(s0, 32);
        if (lane < 32) { cp1[n0 + lane] = s1; cp0[n0 + lane] = s0; }
    }
#pragma unroll
    for (int i = 0; i < 32; ++i) { const int kk = 2 * i + (lane >> 5); scr[kk * 33 + (lane & 31)] = tv[i]; }
    LDS_WAIT(); asm volatile("" ::: "memory");
    const int c = lane & 7;
#pragma unroll
    for (int j = 0; j < 4; ++j) { const int n = (lane >> 3) + 8 * j; const LAS float* s = scr + (8 * c) * 33 + n;
        v4u o; o.x = pk2(s[0 * 33], s[1 * 33]); o.y = pk2(s[2 * 33], s[3 * 33]); o.z = pk2(s[4 * 33], s[5 * 33]); o.w = pk2(s[6 * 33], s[7 * 33]);
        *(GAS v4u*)(WT + (size_t)(drow0 + n) * K + k0 + 8 * c) = o; }
    LDS_WAIT(); asm volatile("" ::: "memory");
}

__device__ __forceinline__ void p0_prologue(Frame& F, const Args& a) {
    LAS float* scr = (LAS float*)(F.lds + RING_OFF + F.wave * 16384);
    const int gw = F.vcu * NWAVES + F.wave, NGW = F.G * NWAVES;
    constexpr int I_IN = 16 * 80, I_OUT = 16 * 32, I_UP = 16 * 176, I_DN = 44 * 32, I_LAYER = I_IN + I_OUT + I_UP + I_DN;
    for (int it = gw; it < DEPTH * I_LAYER; it += NGW) {
        const int l = it / I_LAYER; int r = it % I_LAYER; unsigned char* wt = F.ws + WS_WT + (size_t)l * WT_LAYER;
        float* cpart = (float*)(F.ws + WS_CPART);
        if (r < I_IN) { const int kb = r / 80, nb = r % 80; const bool sc = l > 0;
            p0_transpose_item(INP(1) + (size_t)l * DM * DIN, DM, DIN, (bf16*)(wt + WT_IN), 64 * kb, 32 * nb, 32 * nb, scr, F.lane, sc ? INP(18) + (l - 1) * DM : nullptr, sc ? INP(19) + (l - 1) * DM : nullptr,
                              cpart + CP_IN1 + kb * 2 * 2576, cpart + CP_IN1 + kb * 2 * 2576 + 2576); continue; } r -= I_IN;
        if (r < I_OUT) { const int kb = r / 32, nb = r % 32; p0_transpose_item(INP(11) + (size_t)l * DM * DM, DM, DM, (bf16*)(wt + WT_OUT), 64 * kb, 32 * nb, 32 * nb, scr, F.lane, nullptr, nullptr, nullptr, nullptr); continue; } r -= I_OUT;
        if (r < I_UP) { const int kb = r / 176, nb = r % 176, n0 = 32 * nb; const int isup = n0 >= DFF, c = isup ? n0 - DFF : n0; const int drow = (c >> 7) * 256 + isup * 128 + (c & 127);
            float* cp = cpart + (l == 0 ? CP_UP0 : CP_UP1) + kb * 2 * 5632;
            p0_transpose_item(INP(14) + (size_t)l * DM * 2 * DFF, DM, 2 * DFF, (bf16*)(wt + WT_UP), 64 * kb, n0, drow, scr, F.lane, INP(12) + l * DM, INP(13) + l * DM, cp, cp + 5632); continue; } r -= I_UP;
        { const int kb = r / 32, nb = r % 32; p0_transpose_item(INP(17) + (size_t)l * DFF * DM, DFF, DM, (bf16*)(wt + WT_DN), 64 * kb, 32 * nb, 32 * nb, scr, F.lane, nullptr, nullptr, nullptr, nullptr); }
    }
    for (int i = gw * 64 + F.lane; i < DEPTH * 16 * DM; i += NGW * 64) { const int l = i / (16 * DM), j = (i / DM) % 16, k = i % DM;
        float v = j < 8 ? INP(1)[(size_t)l * DM * DIN + (size_t)k * DIN + ZW + j] : 0.f; if (l > 0) v *= INP(18)[(l - 1) * DM + k];
        ((bf16*)(F.ws + WS_WT + (size_t)l * WT_LAYER + WT_G))[j * DM + k] = f2bf(v); }
    for (int j = gw; j < 8; j += NGW) { float s1 = 0.f, s0 = 0.f;
        for (int k = F.lane; k < DM; k += 64) { const float wv = INP(1)[(size_t)1 * DM * DIN + (size_t)k * DIN + ZW + j]; s1 = __builtin_fmaf(INP(18)[k], wv, s1); s0 = __builtin_fmaf(INP(19)[k], wv, s0); }
#pragma unroll
        for (int o = 1; o < 64; o <<= 1) { s1 += __shfl_xor(s1, o); s0 += __shfl_xor(s0, o); }
        if (F.lane == 0) { float* cv = (float*)(F.ws + WS_CV); cv[CV_IN1 + ZW + j] = s1; cv[CV_IN1 + 2576 + ZW + j] = s0; } }
    const float* x = INP(0); bf16* XN = (bf16*)(F.ws + WS_XN);
    for (size_t i0 = (size_t)gw * 64 + F.lane; i0 < (size_t)M * DM / 8; i0 += (size_t)NGW * 64 * 4) {
        f32x4 v0[4], v1[4];
#pragma unroll
        for (int q = 0; q < 4; ++q) { const size_t i = i0 + (size_t)q * NGW * 64; v0[q] = *(const GAS f32x4*)(x + i * 8); v1[q] = *(const GAS f32x4*)(x + i * 8 + 4); }
#pragma unroll
        for (int q = 0; q < 4; ++q) { const size_t i = i0 + (size_t)q * NGW * 64;
            v4u o; o.x = pk2(v0[q][0], v0[q][1]); o.y = pk2(v0[q][2], v0[q][3]); o.z = pk2(v1[q][0], v1[q][1]); o.w = pk2(v1[q][2], v1[q][3]);
            *(GAS v4u*)(XN + i * 8) = o; } }
}

__device__ __forceinline__ void cvec_finalize(Frame& F, const Args& a) {
    const float* cp = (const float*)(F.ws + WS_CPART); float* cv = (float*)(F.ws + WS_CV);
    const int gt = (F.vcu * NWAVES + F.wave) * 64 + F.lane, NT = F.G * NWAVES * 64;
    for (int i = gt; i < 2 * ZW + 4 * 5632; i += NT) {
        int src, dst, stride, idx = i;
        if (idx < 2 * ZW) { const int v = idx / ZW, n = idx % ZW; src = CP_IN1 + v * 2576 + n; dst = CV_IN1 + v * 2576 + n; stride = 2 * 2576; }
        else { idx -= 2 * ZW; const int m = idx / (2 * 5632), e = idx % (2 * 5632); src = (m ? CP_UP1 : CP_UP0) + e; dst = (m ? CV_UP1 : CV_UP0) + e; stride = 2 * 5632; }
        float sacc = 0.f;
#pragma unroll
        for (int kb = 0; kb < 16; ++kb) sacc += cp[src + kb * stride];
        cv[dst] = sacc; }
}
__device__ __forceinline__ float wave_max(float x) {
#pragma unroll
    for (int o = 32; o > 0; o >>= 1) x = fmaxf(x, __shfl_xor(x, o)); return x; }
__device__ __forceinline__ int wave_isum(int x) {
#pragma unroll
    for (int o = 32; o > 0; o >>= 1) x += __shfl_xor(x, o); return x; }
__device__ __forceinline__ void quant_unpack(const v4u a, const v4u b, float (&x)[16]) {
#pragma unroll
    for (int e = 0; e < 4; ++e) { x[2 * e] = __uint_as_float(a[e] << 16); x[2 * e + 1] = __uint_as_float(a[e] & 0xffff0000u); x[8 + 2 * e] = __uint_as_float(b[e] << 16); x[8 + 2 * e + 1] = __uint_as_float(b[e] & 0xffff0000u); }
}
__device__ __forceinline__ float quant_row16(const float (&x)[16], unsigned (&q8)[4], int& isum) {
    float am = 0.f;
#pragma unroll
    for (int e = 0; e < 16; ++e) am = fmaxf(am, fabsf(x[e]));
    am = wave_max(am);
    const float inv = am > 0.f ? 127.0f / am : 0.f;
    isum = 0;
#pragma unroll
    for (int j = 0; j < 4; ++j) { unsigned w = 0u;
#pragma unroll
        for (int e = 0; e < 4; ++e) { const int q = (int)__builtin_rintf(x[4 * j + e] * inv); isum += q; w |= ((unsigned)q & 0xffu) << (8 * e); }
        q8[j] = w; }
    return am * (1.0f / 127.0f);
}
typedef unsigned v2u __attribute__((ext_vector_type(2)));
__device__ __forceinline__ void quant_w_step(Frame& F) {
    const int gw = F.vcu * NWAVES + F.wave, NGW = F.G * NWAVES, lane = F.lane;
    for (int rr = gw; rr < DEPTH * 2 * DFF; rr += NGW) {
        const int l = rr / (2 * DFF), n = rr % (2 * DFF);
        const bf16* src = (const bf16*)(F.ws + WS_WT + (size_t)l * WT_LAYER + WT_UP) + (size_t)n * DM;
        const v4u a = *(const GAS v4u*)(src + 8 * lane), b = *(const GAS v4u*)(src + 512 + 8 * lane);
        float x[16]; quant_unpack(a, b, x);
        unsigned q8[4]; int isum; const float sc = quant_row16(x, q8, isum);
        isum = wave_isum(isum);
        unsigned char* dst = F.ws + WS_W8 + ((size_t)l * 2 * DFF + n) * DM;
        *(GAS v2u*)(dst + 8 * lane) = (v2u){q8[0], q8[1]}; *(GAS v2u*)(dst + 512 + 8 * lane) = (v2u){q8[2], q8[3]};
        if (lane == 0) { float* swc = (float*)(F.ws + WS_SWC) + (size_t)l * 4 * DFF; const int idx = ((n & 255) >= 128 ? DFF : 0) + 128 * (n >> 8) + (n & 127);
            swc[idx] = sc; swc[2 * DFF + idx] = sc * (float)isum; }
    }
}
__device__ __forceinline__ void quant_a_phase(Frame& F, const bf16* V) {
    const int gw = F.vcu * NWAVES + F.wave, NGW = F.G * NWAVES, lane = F.lane;
    unsigned char* V8 = F.ws + WS_V8; float* SA = (float*)(F.ws + WS_SA);
    for (int m0 = gw * 4; m0 < M; m0 += NGW * 4) {
        v4u a[4], b[4];
#pragma unroll
        for (int q = 0; q < 4; ++q) { const bf16* src = V + (size_t)(m0 + q) * DM; a[q] = *(const GAS v4u*)(src + 8 * lane); b[q] = *(const GAS v4u*)(src + 512 + 8 * lane); }
#pragma unroll
        for (int q = 0; q < 4; ++q) { float x[16]; quant_unpack(a[q], b[q], x);
            unsigned q8[4]; int isum; const float sc = quant_row16(x, q8, isum);
            unsigned char* dst = V8 + (size_t)(m0 + q) * DM;
            *(GAS v2u*)(dst + 8 * lane) = (v2u){q8[0], q8[1]}; *(GAS v2u*)(dst + 512 + 8 * lane) = (v2u){q8[2], q8[3]};
            if (lane == 0) SA[m0 + q] = sc; }
    }
}
__device__ __forceinline__ void gates_phase(Frame& F, const bf16* XN, const bf16* WG, float* GT, const float* part, const float* c1, const float* c0) {
    const int gw = F.vcu * NWAVES + F.wave, NGW = F.G * NWAVES, l15 = F.lane & 15, lq = F.lane >> 4;
    for (int blk = gw; blk < M / 16; blk += NGW) {
        const bf16* ap = XN + (size_t)(blk * 16 + l15) * DM + 8 * lq; const bf16* bp = WG + (size_t)l15 * DM + 8 * lq;
        f32x4 acc = (f32x4){0.f, 0.f, 0.f, 0.f};
#pragma unroll 16
        for (int ks = 0; ks < DM / 32; ++ks) { const bf16x8 av = *(const GAS bf16x8*)(ap + ks * 32), bv = *(const GAS bf16x8*)(bp + ks * 32);
            acc = __builtin_amdgcn_mfma_f32_16x16x32_bf16(av, bv, acc, 0, 0, 0); }
        if (l15 < 8) {
            float k1 = 0.f, k0 = 0.f; if (part) { k1 = c1[l15]; k0 = c0[l15]; }
#pragma unroll
            for (int r = 0; r < 4; ++r) { const size_t row = (size_t)(blk * 16 + 4 * lq + r); float v = acc[r];
                if (part) { const pg8::RowStat rs = pg8::row_stat(part, row, LN_EPS); v = v * rs.r + (k1 * rs.nmr + k0); }
                GT[row * 8 + l15] = v; } }
    }
}

__device__ __forceinline__ void glu_fixup_phase(Frame& F, const float* G0, const float* UP0, const float* cw, const float* cb, bf16* H) {
    const int gt = (F.vcu * NWAVES + F.wave) * 64 + F.lane, NT = F.G * NWAVES * 64;
    constexpr int C4 = DFF / 4, NIT = (M / 64) * 2 * C4;
    for (int i0 = gt; i0 < NIT; i0 += 2 * NT) {
        f32x4 s0[2], s1[2], s2[2], up[2], w0[2], w1[2], w2[2], bb[2]; int rr[2], gg[2], cc[2]; bool ok[2];
#pragma unroll
        for (int q = 0; q < 2; ++q) { const int i = i0 + q * NT; ok[q] = i < NIT; const int ii = ok[q] ? i : gt;
            const int c = (ii % C4) * 4, r = (ii / C4) & 1, grp = ii / (2 * C4); rr[q] = r; gg[q] = grp; cc[q] = c;
            const float* gp = G0 + ((size_t)grp * 4 + r) * DFF + c;
            s0[q] = *(const GAS f32x4*)gp; s1[q] = *(const GAS f32x4*)(gp + DFF); s2[q] = *(const GAS f32x4*)(gp + 2 * DFF);
            up[q] = *(const GAS f32x4*)(UP0 + ((size_t)grp * 2 + r) * DFF + c);
            w0[q] = *(const GAS f32x4*)(cw + c); w1[q] = *(const GAS f32x4*)(cw + DFF + c); w2[q] = *(const GAS f32x4*)(cw + 2 * DFF + c); bb[q] = *(const GAS f32x4*)(cb + c); }
#pragma unroll
        for (int q = 0; q < 2; ++q) { if (!ok[q]) continue;
            const bool bs = (gg[q] & (SEQ / 64 - 1)) == 0;
            const f32x4 z = (f32x4){0.f, 0.f, 0.f, 0.f}; const f32x4 a0 = bs ? z : s0[q], a1 = (bs && rr[q] == 0) ? z : s1[q];
            const f32x4 cv = bb[q] + w0[q] * a0 + w1[q] * a1 + w2[q] * s2[q];
            const pg8::f32x2 ha = pg8::gelu_mul_pk((pg8::f32x2){cv[0], cv[1]}, (pg8::f32x2){up[q][0], up[q][1]}), hb = pg8::gelu_mul_pk((pg8::f32x2){cv[2], cv[3]}, (pg8::f32x2){up[q][2], up[q][3]});
            unsigned long long o = (unsigned long long)pg8::cvt_pk_bf16(ha.x, ha.y) | ((unsigned long long)pg8::cvt_pk_bf16(hb.x, hb.y) << 32);
            *(GAS unsigned long long*)(H + (size_t)(gg[q] * 64 + rr[q]) * DFF + cc[q]) = o; }
    }
}

struct SameTileOrder {
    int n, pm0, pn0;
    __device__ bool next(int i, pg8::Unit& u) const { if (i >= n) return false; u.pm = pm0; u.pn = pn0; return true; }
    __device__ __forceinline__ void a_ready(const pg8::Unit&) const {}
    __device__ __forceinline__ void done(const pg8::Unit&) const {}
};
struct OneUnit {
    int pm, pn;
    __device__ bool next(int i, pg8::Unit& u) const { if (i != 0) return false; u.pm = pm; u.pn = pn; return true; }
    __device__ __forceinline__ void a_ready(const pg8::Unit&) const {}
    __device__ __forceinline__ void done(const pg8::Unit&) const {}
};

__device__ __forceinline__ void res_gemm_phase(Frame& F, const bf16* A, const bf16* Bt, int K, bf16* V, bf16* Vout, const float* part_prev, const float* gp, const float* bp, float* part_new) {
    pg8::Gemm gm{A, Bt, M, DM, K}; pg8::StaticOrder S; S.init(M, DM, F.G, (int)blockIdx.x);
    pg8::EpiRes E{V, Vout, DM, part_prev, gp, bp, part_new, F.lds + MX_TAB};
    pg8::gemm_phase<pg8::EpiRes, pg8::StaticOrder, true, true>(F.lds + RING_OFF, gm, S, E, F.tid);
}
__device__ __forceinline__ void final_ln_phase(Frame& F, const bf16* V, const float* part, const float* g, const float* b, float* out) {
    const int gw = F.vcu * NWAVES + F.wave, NGW = F.G * NWAVES;
    f32x4 gv[4], bv[4];
#pragma unroll
    for (int j = 0; j < 4; ++j) { gv[j] = *(const GAS f32x4*)(g + 256 * j + 4 * F.lane); bv[j] = *(const GAS f32x4*)(b + 256 * j + 4 * F.lane); }
    for (int m0 = gw * 4; m0 < M; m0 += NGW * 4) {
        unsigned long long w[4][4]; pg8::RowStat rs[4];
#pragma unroll
        for (int q = 0; q < 4; ++q) { rs[q] = pg8::row_stat(part, (size_t)(m0 + q), LN_EPS);
#pragma unroll
            for (int j = 0; j < 4; ++j) w[q][j] = *(const GAS unsigned long long*)(V + (size_t)(m0 + q) * DM + 256 * j + 4 * F.lane); }
#pragma unroll
        for (int q = 0; q < 4; ++q)
#pragma unroll
            for (int j = 0; j < 4; ++j) { const unsigned lo = (unsigned)w[q][j], hi = (unsigned)(w[q][j] >> 32);
                f32x4 x = (f32x4){__uint_as_float(lo << 16), __uint_as_float(lo & 0xffff0000u), __uint_as_float(hi << 16), __uint_as_float(hi & 0xffff0000u)};
                x = (x * rs[q].r + rs[q].nmr) * gv[j] + bv[j];
                __builtin_nontemporal_store(x, (GAS f32x4*)(out + (size_t)(m0 + q) * DM + 256 * j + 4 * F.lane)); }
    }
}
constexpr int MX_RAWQK = 0, MX_RAWV = 18496, MX_HS = 0, MX_QS = 35904, MX_KS = 45120, MX_QP = 54336, MX_SS = 63552, MX_KWT = 72768, MX_VST = 81984, MX_CST = 102720, MX_CWB = 123456, MX_DEN = 126016;
constexpr int MX_GA = LDSCTL_OFF + 512;
constexpr int ST_FLOATS = 64 * 144 + 64;
typedef short s16x4v __attribute__((ext_vector_type(4)));

__device__ __forceinline__ float fexp(float x) { return __expf(x); }
__device__ __forceinline__ unsigned pkbf(float lo, float hi) { return pg8::cvt_pk_bf16(lo, hi); }
#define MX_DPPF(x, ctrl) __builtin_bit_cast(float, __builtin_amdgcn_update_dpp(0, __builtin_bit_cast(int, (float)(x)), (ctrl), 0xf, 0xf, true))
__device__ __forceinline__ float row_sum16(float x) {
    x += MX_DPPF(x, 0xB1); x += MX_DPPF(x, 0x4E); x += MX_DPPF(x, 0x141); x += MX_DPPF(x, 0x140); return x;
}
#define MX_LDS_FENCE() asm volatile("s_waitcnt lgkmcnt(0)" ::: "memory")

template <bool OUT>
__device__ __forceinline__ void mlstm_phase(Frame& F, const Args& args, int l) {
    const int tid = F.tid, lane = F.lane, w = F.wave, l15 = lane & 15, lq = lane >> 4;
    unsigned char* ws = F.ws;
    const bf16* Z = (const bf16*)(ws + WS_Z); const float* GT = (const float*)(ws + WS_GT); bf16* Y = (bf16*)(ws + WS_Y); float* ST = (float*)(ws + WS_MST);
    const int u = F.vcu, b = u >> 6, h = (u >> 4) & 3, seg = u & 15;
    const size_t gr_seg = (size_t)b * SEQ + (size_t)seg * 512;
    LAS unsigned char* L = F.lds;
    LAS float* gA = (LAS float*)(L + MX_GA); LAS float* gMX = gA + 512; LAS float* gFL = gA + 1024; LAS float* gBend = gA + 1536; LAS float* gAmax = gA + 1544; LAS float* gMP = gA + 1552; LAS float* gMXE = gA + 1560;
    LAS float* cwb = (LAS float*)(L + MX_CWB);
    const float* qcw = INP(4) + (size_t)l * 4 * 512; const float* qcb = INP(5) + l * 512;
    for (int i = tid; i < 640; i += 512) { const int j = i >> 7, c = i & 127; const int ch = (c < 64) ? (64 * h + c) : (256 + 64 * h + c - 64);
        cwb[i] = (j < 4) ? qcw[j * 512 + ch] : qcb[ch]; }
    for (int i = tid; i < 16 * 72; i += 512) { const int r = i / 72, c = i % 72; ((LAS bf16*)(L + MX_VST))[(128 + r) * 72 + c] = (r == 0 && c < 64) ? (bf16)0x3F80 : (bf16)0; }
    for (int i = tid; i < 144 * 72 / 2; i += 512) ((LAS unsigned*)(L + MX_CST))[i] = 0u;
    float bpos, apos, cmax;
    {
        const size_t t = gr_seg + 64 * w + lane; const float bi = INP(2)[l * 4 + h], bfg = INP(3)[l * 4 + h];
        const float ig = GT[t * 8 + h] + bi, lf = logsigmoid_f(GT[t * 8 + 4 + h] + bfg);
        float s = lf;
#pragma unroll
        for (int o = 1; o < 64; o <<= 1) { const float v = __shfl_up(s, o); if (lane >= o) s += v; }
        bpos = s; apos = ig - s; float c = apos;
#pragma unroll
        for (int o = 1; o < 64; o <<= 1) { const float v = __shfl_up(c, o); if (lane >= o) c = fmaxf(c, v); }
        cmax = c;
        gA[64 * w + lane] = apos;
        if (lane == 63) { gBend[w] = bpos; gAmax[w] = cmax; }
    }
    __syncthreads();
    float m_init = -INFINITY; asm volatile("" : "+v"(m_init));
    f32x4 cacc[4], nacc;
#pragma unroll
    for (int i = 0; i < 4; ++i) cacc[i] = (f32x4){0.f, 0.f, 0.f, 0.f};
    nacc = (f32x4){0.f, 0.f, 0.f, 0.f};
    if (OUT) {
        float ml_l = -INFINITY, bs_l = 0.f;
        if (lane < seg) { const float* sp_ = ST + (size_t)(u - seg + lane) * ST_FLOATS + 64 * 144; ml_l = sp_[0]; bs_l = sp_[1]; }
        float m_run = 0.f;
        for (int sp = 0; sp < seg; ++sp) m_run = fmaxf(__shfl(bs_l, sp) + m_run, __shfl(ml_l, sp));
        float pre = bs_l;
#pragma unroll
        for (int o = 1; o < 16; o <<= 1) { const float v = __shfl_up(pre, o); if (lane >= o) pre += v; }
        const float tot = __shfl(pre, 15);
        const float wgt_l = (lane < seg) ? fexp(ml_l + (tot - pre) - m_run) : 0.f;
#pragma unroll 1
        for (int sp0 = 0; sp0 < seg; sp0 += 3) {
            float v[3][16], vn[3][4], wj[3];
#pragma unroll
            for (int j = 0; j < 3; ++j) { const int sp = (sp0 + j < seg) ? sp0 + j : seg - 1; const float* st = ST + (size_t)(u - seg + sp) * ST_FLOATS;
                wj[j] = (sp0 + j < seg) ? __shfl(wgt_l, sp) : 0.f;
#pragma unroll
                for (int mt = 0; mt < 4; ++mt)
#pragma unroll
                    for (int r = 0; r < 4; ++r) v[j][4 * mt + r] = st[(16 * mt + 4 * lq + r) * 144 + 16 * w + l15];
#pragma unroll
                for (int r = 0; r < 4; ++r) vn[j][r] = (w < 4) ? st[(16 * w + 4 * lq + r) * 144 + 128 + l15] : 0.f; }
#pragma unroll
            for (int j = 0; j < 3; ++j) {
#pragma unroll
                for (int mt = 0; mt < 4; ++mt)
#pragma unroll
                    for (int r = 0; r < 4; ++r) cacc[mt][r] += wj[j] * v[j][4 * mt + r];
#pragma unroll
                for (int r = 0; r < 4; ++r) nacc[r] += wj[j] * vn[j][r]; }
        }
        m_init = m_run;
    }
    { float mp = m_init, mpw = m_init;
#pragma unroll
      for (int n = 0; n < 8; ++n) { const float mxe = fmaxf(mp, gAmax[n]); if (tid == 0) { gMP[n] = mp; gMXE[n] = mxe; } mpw = (w == n) ? mp : mpw; mp = gBend[n] + mxe; }
      if (!OUT) { if (tid == 0) { float bsum = 0.f;
#pragma unroll
            for (int n = 0; n < 8; ++n) bsum += gBend[n];
            ST[(size_t)u * ST_FLOATS + 64 * 144] = mp; ST[(size_t)u * ST_FLOATS + 64 * 144 + 1] = bsum; } }
      if (OUT) {
        const float mx = fmaxf(cmax, mpw); gMX[64 * w + lane] = mx; gFL[64 * w + lane] = fexp(-(bpos + mx));
#pragma unroll
        for (int mt = 0; mt < 4; ++mt) { unsigned long long v = (unsigned long long)pkbf(cacc[mt][0], cacc[mt][1]) | ((unsigned long long)pkbf(cacc[mt][2], cacc[mt][3]) << 32);
            *(LAS unsigned long long*)(L + MX_CST + ((16 * w + l15) * 72 + 16 * mt + 4 * lq) * 2) = v; }
        if (w < 4) { unsigned long long v = (unsigned long long)pkbf(nacc[0], nacc[1]) | ((unsigned long long)pkbf(nacc[2], nacc[3]) << 32);
            *(LAS unsigned long long*)(L + MX_CST + ((128 + l15) * 72 + 16 * w + 4 * lq) * 2) = v; }
      } }
    float gain[8];
    if (OUT) {
#pragma unroll
        for (int e = 0; e < 8; ++e) gain[e] = INP(10)[l * 512 + h * 128 + 8 * (tid & 15) + e]; }
    v4u rq[2][3], rv[2][2], ro[2];
#define MX_LOAD_RAW(n_, ps_) do { \
        const size_t gr0 = gr_seg + 64 * (n_); const int tc = seg * 512 + 64 * (n_); \
        _Pragma("unroll") \
        for (int k = 0; k < 3; ++k) { const int p = tid + 512 * k; const int r = p >> 4, c = p & 15; v4u v = (v4u){0u, 0u, 0u, 0u}; \
            if (p < 67 * 16 && tc - 3 + r >= 0) v = *(const GAS v4u*)(Z + (gr0 + r - 3) * ZW + (c < 8 ? 1024 + 64 * h + 8 * c : 1280 + 64 * h + 8 * (c - 8))); \
            rq[ps_][k] = v; } \
        _Pragma("unroll") \
        for (int k = 0; k < 2; ++k) { const int p = tid + 512 * k; const int r = p >> 4, c = p & 15; \
            rv[ps_][k] = *(const GAS v4u*)(Z + (gr0 + r) * ZW + 1536 + 128 * h + 8 * c); \
            } \
    } while (0)
#define MX_LOAD_O(n_) do { _Pragma("unroll") for (int k = 0; k < 2; ++k) { const int p = tid + 512 * k; ro[k] = *(const GAS v4u*)(Z + (gr_seg + 64 * (n_) + (p >> 4)) * ZW + 2048 + 128 * h + 8 * (p & 15)); } } while (0)
    MX_LOAD_RAW(0, 0); MX_LOAD_RAW(1, 1);
    if (OUT) MX_LOAD_O(0);
    __syncthreads();
#pragma unroll 1
    for (int n2 = 0; n2 < 8; n2 += 2) {
#pragma unroll
    for (int par = 0; par < 2; ++par) { const int n = n2 + par;
        int tid_ = F.tid; asm volatile("" : "+v"(tid_));
        const int tid = tid_, lane = tid & 63, l15 = lane & 15, lq = lane >> 4;
#pragma unroll
        for (int k = 0; k < 3; ++k) { const int p = tid + 512 * k; if (p < 67 * 16) *(LAS v4u*)(L + MX_RAWQK + (p >> 4) * 272 + (p & 15) * 16) = rq[par][k]; }
#pragma unroll
        for (int k = 0; k < 2; ++k) { const int p = tid + 512 * k; *(LAS v4u*)(L + MX_RAWV + (p >> 4) * 272 + (p & 15) * 16) = rv[par][k]; }
        __syncthreads();
        if (n + 2 < 8) MX_LOAD_RAW(n + 2, par);
        {
            const int s = lane;
            const float mxe = gMXE[n], mpv = gMP[n], a_s = gA[64 * n + s]; float mxs = 0.f; if (OUT) mxs = gMX[64 * n + s];
            v4u rvv[2];
#pragma unroll
            for (int cc = 0; cc < 2; ++cc) rvv[cc] = *(const LAS v4u*)(L + MX_RAWV + s * 272 + (2 * w + cc) * 16);
#pragma unroll
            for (int qk = (OUT ? 0 : 1); qk < 2; ++qk) {
                const int cb0 = 64 * qk + 8 * w;
                v4u rw[4]; f32x4 cw4[5][2];
#pragma unroll
                for (int j = 0; j < 4; ++j) rw[j] = *(const LAS v4u*)(L + MX_RAWQK + (s + j) * 272 + cb0 * 2);
#pragma unroll
                for (int j = 0; j < 5; ++j) { cw4[j][0] = *(const LAS f32x4*)(cwb + j * 128 + cb0); cw4[j][1] = *(const LAS f32x4*)(cwb + j * 128 + cb0 + 4); }
                MX_LDS_FENCE();
                float acc[8];
#pragma unroll
                for (int e = 0; e < 8; ++e) acc[e] = cw4[4][e >> 2][e & 3];
#pragma unroll
                for (int j = 0; j < 4; ++j)
#pragma unroll
                    for (int e2 = 0; e2 < 4; ++e2) { const unsigned x = rw[j][e2];
                        acc[2 * e2] = __builtin_fmaf(cw4[j][(2 * e2) >> 2][(2 * e2) & 3], __uint_as_float(x << 16), acc[2 * e2]);
                        acc[2 * e2 + 1] = __builtin_fmaf(cw4[j][(2 * e2 + 1) >> 2][(2 * e2 + 1) & 3], __uint_as_float(x & 0xffff0000u), acc[2 * e2 + 1]); }
#pragma unroll
                for (int e = 0; e < 8; ++e) acc[e] = acc[e] * __builtin_amdgcn_rcpf(1.0f + fexp(-acc[e]));
                if (qk == 0) {
                    const float wi = fexp(mpv - mxs);
                    v4u o; o.x = pkbf(acc[0], acc[1]); o.y = pkbf(acc[2], acc[3]); o.z = pkbf(acc[4], acc[5]); o.w = pkbf(acc[6], acc[7]);
                    *(LAS v4u*)(L + MX_QS + (s * 72 + 8 * w) * 2) = o;
                    v4u p; p.x = pkbf(acc[0] * wi, acc[1] * wi); p.y = pkbf(acc[2] * wi, acc[3] * wi); p.z = pkbf(acc[4] * wi, acc[5] * wi); p.w = pkbf(acc[6] * wi, acc[7] * wi);
                    *(LAS v4u*)(L + MX_QP + (s * 72 + 8 * w) * 2) = p;
                } else {
                    const float kwt = 0.125f * fexp(a_s - mxe);
                    if (OUT) { v4u o; o.x = pkbf(acc[0] * 0.125f, acc[1] * 0.125f); o.y = pkbf(acc[2] * 0.125f, acc[3] * 0.125f); o.z = pkbf(acc[4] * 0.125f, acc[5] * 0.125f); o.w = pkbf(acc[6] * 0.125f, acc[7] * 0.125f);
                        *(LAS v4u*)(L + MX_KS + (s * 72 + 8 * w) * 2) = o; }
#pragma unroll
                    for (int e2 = 0; e2 < 4; ++e2) { const unsigned pk = pkbf(acc[2 * e2] * kwt, acc[2 * e2 + 1] * kwt);
                        ((LAS bf16*)(L + MX_KWT))[(8 * w + 2 * e2) * 72 + s] = (bf16)(pk & 0xffffu); ((LAS bf16*)(L + MX_KWT))[(8 * w + 2 * e2 + 1) * 72 + s] = (bf16)(pk >> 16); }
                }
            }
#pragma unroll
            for (int cc = 0; cc < 2; ++cc) { const int c = 2 * w + cc; const v4u rw = rvv[cc];
#pragma unroll
                for (int e2 = 0; e2 < 4; ++e2) { ((LAS bf16*)(L + MX_VST))[(8 * c + 2 * e2) * 72 + s] = (bf16)(rw[e2] & 0xffffu); ((LAS bf16*)(L + MX_VST))[(8 * c + 2 * e2 + 1) * 72 + s] = (bf16)(rw[e2] >> 16); } }
        }
        __syncthreads();
        if (OUT) {
            const int mt = w >> 1;
#pragma unroll
            for (int ni = 0; ni < 2; ++ni) { const int nt = 2 * (w & 1) + ni; f32x4 sa = (f32x4){0.f, 0.f, 0.f, 0.f};
#pragma unroll
                for (int ks = 0; ks < 2; ++ks) { const bf16x8 av = *(const LAS bf16x8*)(L + MX_QS + ((16 * mt + l15) * 72 + 32 * ks + 8 * lq) * 2), bv = *(const LAS bf16x8*)(L + MX_KS + ((16 * nt + l15) * 72 + 32 * ks + 8 * lq) * 2);
                    sa = __builtin_amdgcn_mfma_f32_16x16x32_bf16(av, bv, sa, 0, 0, 0); }
                const int s = 16 * nt + l15; const float a_s = gA[64 * n + s]; const f32x4 mx4 = *(const LAS f32x4*)(gMX + 64 * n + 16 * mt + 4 * lq);
                float sw[4];
#pragma unroll
                for (int r = 0; r < 4; ++r) { const int t = 16 * mt + 4 * lq + r; sw[r] = (s <= t) ? sa[r] * fexp(a_s - mx4[r]) : 0.f; }
                const unsigned p01 = pkbf(sw[0], sw[1]), p23 = pkbf(sw[2], sw[3]); const int t0 = 16 * mt + 4 * lq;
                ((LAS bf16*)(L + MX_SS))[(t0 + 0) * 72 + s] = (bf16)(p01 & 0xffffu); ((LAS bf16*)(L + MX_SS))[(t0 + 1) * 72 + s] = (bf16)(p01 >> 16);
                ((LAS bf16*)(L + MX_SS))[(t0 + 2) * 72 + s] = (bf16)(p23 & 0xffffu); ((LAS bf16*)(L + MX_SS))[(t0 + 3) * 72 + s] = (bf16)(p23 >> 16); }
            __syncthreads();
            f32x4 na[4], da = (f32x4){0.f, 0.f, 0.f, 0.f};
#pragma unroll
            for (int i = 0; i < 4; ++i) na[i] = (f32x4){0.f, 0.f, 0.f, 0.f};
#pragma unroll
            for (int ks = 0; ks < 4; ++ks) {
                const int aoff = (ks < 2 ? MX_SS : MX_QP) + ((16 * mt + l15) * 72 + 32 * (ks & 1) + 8 * lq) * 2, bbase = (ks < 2 ? MX_VST : MX_CST) + (32 * (ks & 1) + 8 * lq) * 2;
                const bf16x8 av = *(const LAS bf16x8*)(L + aoff);
#pragma unroll
                for (int i = 0; i < 4; ++i) { const int nt = 4 * (w & 1) + i; const bf16x8 bv = *(const LAS bf16x8*)(L + bbase + (16 * nt + l15) * 144);
                    na[i] = __builtin_amdgcn_mfma_f32_16x16x32_bf16(av, bv, na[i], 0, 0, 0); }
                if ((w & 1) == 0) { const bf16x8 bv = *(const LAS bf16x8*)(L + bbase + (128 + l15) * 144); da = __builtin_amdgcn_mfma_f32_16x16x32_bf16(av, bv, da, 0, 0, 0); }
            }
#pragma unroll
            for (int i = 0; i < 4; ++i) { const int nt = 4 * (w & 1) + i;
#pragma unroll
                for (int r = 0; r < 4; ++r) ((LAS float*)(L + MX_HS))[(16 * mt + 4 * lq + r) * 132 + 16 * nt + l15] = na[i][r]; }
            if ((w & 1) == 0 && l15 == 0) {
#pragma unroll
                for (int r = 0; r < 4; ++r) ((LAS float*)(L + MX_DEN))[16 * mt + 4 * lq + r] = da[r]; }
        }
        {
            const float dec = fexp(gMP[n] - gMXE[n]);
#pragma unroll
            for (int mt2 = 0; mt2 < 4; ++mt2) cacc[mt2] = cacc[mt2] * dec;
            nacc = nacc * dec;
#pragma unroll
            for (int ks = 0; ks < 2; ++ks) { const bf16x8 bv = *(const LAS bf16x8*)(L + MX_VST + ((16 * w + l15) * 72 + 32 * ks + 8 * lq) * 2);
#pragma unroll
                for (int mt2 = 0; mt2 < 4; ++mt2) { const bf16x8 av = *(const LAS bf16x8*)(L + MX_KWT + ((16 * mt2 + l15) * 72 + 32 * ks + 8 * lq) * 2);
                    cacc[mt2] = __builtin_amdgcn_mfma_f32_16x16x32_bf16(av, bv, cacc[mt2], 0, 0, 0); }
                if (w < 4) { const bf16x8 av = *(const LAS bf16x8*)(L + MX_KWT + ((16 * w + l15) * 72 + 32 * ks + 8 * lq) * 2), bn = *(const LAS bf16x8*)(L + MX_VST + ((128 + l15) * 72 + 32 * ks + 8 * lq) * 2);
                    nacc = __builtin_amdgcn_mfma_f32_16x16x32_bf16(av, bn, nacc, 0, 0, 0); } }
        }
        __syncthreads();
        if (OUT) {
#pragma unroll
            for (int mt2 = 0; mt2 < 4; ++mt2) { unsigned long long v = (unsigned long long)pkbf(cacc[mt2][0], cacc[mt2][1]) | ((unsigned long long)pkbf(cacc[mt2][2], cacc[mt2][3]) << 32);
                *(LAS unsigned long long*)(L + MX_CST + ((16 * w + l15) * 72 + 16 * mt2 + 4 * lq) * 2) = v; }
            if (w < 4) { unsigned long long v = (unsigned long long)pkbf(nacc[0], nacc[1]) | ((unsigned long long)pkbf(nacc[2], nacc[3]) << 32);
                *(LAS unsigned long long*)(L + MX_CST + ((128 + l15) * 72 + 16 * w + 4 * lq) * 2) = v; }
            f32x4 hh[2][2]; float dn[2], flr[2];
#pragma unroll
            for (int k = 0; k < 2; ++k) { const int id = tid + 512 * k, t = id >> 4, c = id & 15;
                hh[k][0] = *(const LAS f32x4*)(L + MX_HS + (t * 132 + 8 * c) * 4); hh[k][1] = *(const LAS f32x4*)(L + MX_HS + (t * 132 + 8 * c + 4) * 4);
                dn[k] = ((const LAS float*)(L + MX_DEN))[t]; flr[k] = gFL[64 * n + t]; }
            MX_LDS_FENCE();
#pragma unroll
            for (int k = 0; k < 2; ++k) { const int id = tid + 512 * k, t = id >> 4, c = id & 15;
                const float inv = __builtin_amdgcn_rcpf(fmaxf(fabsf(dn[k]), flr[k]));
                float hv[8] = {hh[k][0][0] * inv, hh[k][0][1] * inv, hh[k][0][2] * inv, hh[k][0][3] * inv, hh[k][1][0] * inv, hh[k][1][1] * inv, hh[k][1][2] * inv, hh[k][1][3] * inv};
                float sm = 0.f;
#pragma unroll
                for (int e = 0; e < 8; ++e) sm += hv[e];
                sm = row_sum16(sm);
                const float mean = sm * (1.f / 128.f); float q = 0.f;
#pragma unroll
                for (int e = 0; e < 8; ++e) { hv[e] -= mean; q = __builtin_fmaf(hv[e], hv[e], q); }
                q = row_sum16(q);
                const float rstd = rsqrtf(q * (1.f / 128.f) + LN_EPS);
                float yv[8];
#pragma unroll
                for (int e2 = 0; e2 < 4; ++e2) { const unsigned x = ro[k][e2]; const float o0 = __uint_as_float(x << 16), o1 = __uint_as_float(x & 0xffff0000u);
                    yv[2 * e2] = hv[2 * e2] * rstd * gain[2 * e2] * __builtin_amdgcn_rcpf(1.0f + fexp(-o0)); yv[2 * e2 + 1] = hv[2 * e2 + 1] * rstd * gain[2 * e2 + 1] * __builtin_amdgcn_rcpf(1.0f + fexp(-o1)); }
                v4u o; o.x = pkbf(yv[0], yv[1]); o.y = pkbf(yv[2], yv[3]); o.z = pkbf(yv[4], yv[5]); o.w = pkbf(yv[6], yv[7]);
                *(GAS v4u*)(Y + (gr_seg + 64 * n + t) * DM + 512 + 128 * h + 8 * c) = o; }
            if (n + 1 < 8) MX_LOAD_O(n + 1);
            __syncthreads();
        }
    }
    }
    if (!OUT) {
        float* st = ST + (size_t)u * ST_FLOATS;
#pragma unroll
        for (int mt = 0; mt < 4; ++mt)
#pragma unroll
            for (int r = 0; r < 4; ++r) st[(16 * mt + 4 * lq + r) * 144 + 16 * w + l15] = cacc[mt][r];
        if (w < 4) {
#pragma unroll
            for (int r = 0; r < 4; ++r) st[(16 * w + 4 * lq + r) * 144 + 128 + l15] = nacc[r]; }
    }
    __syncthreads();
}

constexpr int SG_VNT = 0, SG_SOUT = 34816, SG_RAW = 34816;
__device__ __forceinline__ void sgu_phase(Frame& F, const Args& args, int l) {
    const int tid = F.tid, lane = F.lane, w = F.wave, l15 = lane & 15, lq = lane >> 4;
    unsigned char* ws = F.ws; const bf16* Z = (const bf16*)(ws + WS_Z); bf16* Y = (bf16*)(ws + WS_Y);
    LAS unsigned char* L = F.lds;
    const int h = F.vcu & 3;
    const float* sw = INP(6) + ((size_t)l * 4 + h) * 128 * 128; const float* sb = INP(7) + (l * 4 + h) * 128;
    const float* lg = INP(8) + (l * 4 + h) * 128; const float* lb = INP(9) + (l * 4 + h) * 128;
    bf16x8 wa[4];
#pragma unroll
    for (int ks = 0; ks < 4; ++ks) { const float* p = sw + (size_t)(16 * w + l15) * 128 + 32 * ks + 8 * lq; const f32x4 a = *(const GAS f32x4*)p, b = *(const GAS f32x4*)(p + 4);
        v4u o; o.x = pkbf(a[0], a[1]); o.y = pkbf(a[2], a[3]); o.z = pkbf(b[0], b[1]); o.w = pkbf(b[2], b[3]);
        if (w < 4 && ks >= 2) o = (v4u){0u, 0u, 0u, 0u};
        wa[ks] = __builtin_bit_cast(bf16x8, o); }
    float bsr[4];
#pragma unroll
    for (int r = 0; r < 4; ++r) bsr[r] = sb[16 * w + 4 * lq + r];
    float lgv[8], lbv[8];
#pragma unroll
    for (int e = 0; e < 8; ++e) { lgv[e] = lg[8 * (tid & 15) + e]; lbv[e] = lb[8 * (tid & 15) + e]; }
    v4u pv_[4], pu_[4];
#pragma unroll
    for (int k = 0; k < 4; ++k) { const int id = tid + 512 * k; pv_[k] = *(const GAS v4u*)(Z + ((size_t)((F.vcu >> 2) * 4) * 128 + (id >> 4)) * ZW + 512 + 128 * h + 8 * (id & 15)); }
#pragma unroll 1
    for (int it = 0; it < 4; ++it) {
        const int blk = (F.vcu >> 2) * 4 + it;
        const size_t r0 = (size_t)blk * 128;
#pragma unroll
        for (int k = 0; k < 4; ++k) { const int id = tid + 512 * k; pu_[k] = *(const GAS v4u*)(Z + (r0 + (id >> 4)) * ZW + 128 * h + 8 * (id & 15)); }
#pragma unroll
        for (int k = 0; k < 4; ++k) { const int id = tid + 512 * k, j = id >> 4, c = id & 15;
            const v4u rw = pv_[k];
            float v[8];
#pragma unroll
            for (int e2 = 0; e2 < 4; ++e2) { v[2 * e2] = __uint_as_float(rw[e2] << 16); v[2 * e2 + 1] = __uint_as_float(rw[e2] & 0xffff0000u); }
            float sm = 0.f;
#pragma unroll
            for (int e = 0; e < 8; ++e) sm += v[e];
            sm = row_sum16(sm);
            const float mean = sm * (1.f / 128.f); float q = 0.f;
#pragma unroll
            for (int e = 0; e < 8; ++e) { v[e] -= mean; q = __builtin_fmaf(v[e], v[e], q); }
            q = row_sum16(q);
            const float rstd = rsqrtf(q * (1.f / 128.f) + LN_EPS);
#pragma unroll
            for (int e = 0; e < 8; ++e) v[e] = v[e] * rstd * lgv[e] + lbv[e];
            v4u o; o.x = pkbf(v[0], v[1]); o.y = pkbf(v[2], v[3]); o.z = pkbf(v[4], v[5]); o.w = pkbf(v[6], v[7]);
            *(LAS v4u*)(L + SG_RAW + j * 272 + c * 16) = o; }
        if (it + 1 < 4) {
#pragma unroll
            for (int k = 0; k < 4; ++k) { const int id = tid + 512 * k; pv_[k] = *(const GAS v4u*)(Z + (r0 + 128 + (id >> 4)) * ZW + 512 + 128 * h + 8 * (id & 15)); } }
        __syncthreads();
#pragma unroll
        for (int k = 0; k < 4; ++k) { const int id = w + 8 * k;
            const int c = id & 15, j = 64 * (id >> 4) + lane; const v4u rw = *(const LAS v4u*)(L + SG_RAW + j * 272 + c * 16);
#pragma unroll
            for (int e2 = 0; e2 < 4; ++e2) { ((LAS bf16*)(L + SG_VNT))[(8 * c + 2 * e2) * 136 + j] = (bf16)(rw[e2] & 0xffffu); ((LAS bf16*)(L + SG_VNT))[(8 * c + 2 * e2 + 1) * 136 + j] = (bf16)(rw[e2] >> 16); } }
        __syncthreads();
        {
            f32x4 sa[8];
#pragma unroll
            for (int nt = 0; nt < 8; ++nt) sa[nt] = (f32x4){0.f, 0.f, 0.f, 0.f};
#pragma unroll
            for (int ks = 0; ks < 4; ++ks) {
                if (ks < 2 || w >= 4) {
#pragma unroll
                    for (int nt = 0; nt < 8; ++nt) { const bf16x8 bv = *(const LAS bf16x8*)(L + SG_VNT + ((16 * nt + l15) * 136 + 32 * ks + 8 * lq) * 2);
                        sa[nt] = __builtin_amdgcn_mfma_f32_16x16x32_bf16(wa[ks], bv, sa[nt], 0, 0, 0); } } }
#pragma unroll
            for (int nt = 0; nt < 8; ++nt)
#pragma unroll
                for (int r = 0; r < 4; ++r) ((LAS float*)(L + SG_SOUT))[(16 * w + 4 * lq + r) * 132 + 16 * nt + l15] = sa[nt][r] + bsr[r];
        }
        __syncthreads();
#pragma unroll
        for (int k = 0; k < 4; ++k) { const int id = tid + 512 * k, i = id >> 4, c = id & 15;
            const v4u rw = pu_[k];
            const f32x4 s0 = *(const LAS f32x4*)(L + SG_SOUT + (i * 132 + 8 * c) * 4), s1 = *(const LAS f32x4*)(L + SG_SOUT + (i * 132 + 8 * c + 4) * 4);
            v4u o; o.x = pkbf(__uint_as_float(rw[0] << 16) * s0[0], __uint_as_float(rw[0] & 0xffff0000u) * s0[1]); o.y = pkbf(__uint_as_float(rw[1] << 16) * s0[2], __uint_as_float(rw[1] & 0xffff0000u) * s0[3]);
            o.z = pkbf(__uint_as_float(rw[2] << 16) * s1[0], __uint_as_float(rw[2] & 0xffff0000u) * s1[1]); o.w = pkbf(__uint_as_float(rw[3] << 16) * s1[2], __uint_as_float(rw[3] & 0xffff0000u) * s1[3]);
            *(GAS v4u*)(Y + (r0 + i) * DM + 128 * h + 8 * c) = o; }
        __syncthreads();
    }
}
#define MIXER_PASS1 mlstm_phase<false>(F, args, l);
#define MIXER_PASS2 { mlstm_phase<true>(F, args, l); sgu_phase(F, args, l); }
__global__ void __launch_bounds__(NWAVES * 64, 2) mk_fwd(Args args) {
    extern __shared__ __attribute__((aligned(16))) unsigned char lds[];
    Frame F;
    F.lds = (LAS unsigned char*)lds;
    F.MISC = (volatile LAS unsigned*)(F.lds + MISC_OFF);
    F.tid = threadIdx.x; F.lane = F.tid & 63; F.wave = __builtin_amdgcn_readfirstlane(F.tid >> 6);
    F.G = gridDim.x; { const int bx = blockIdx.x; F.vcu = (F.G % 8 == 0) ? (bx % 8) * (F.G / 8) + bx / 8 : bx; }
    F.ws = args.ws;
    F.ctl = (gu32*)(F.ws + WS_CTL);
    for (int u = F.tid; u < (LDS_BYTES - LDSCTL_OFF) / 4; u += NWAVES * 64) ((LAS unsigned*)(F.lds + LDSCTL_OFF))[u] = 0u;
    __syncthreads();
    if (F.tid == 0) {
#pragma unroll
        for (int i = 0; i < 20; ++i) ((LAS unsigned long long*)(F.lds + PT_OFF))[i] = (unsigned long long)args.in[i];
        ((LAS unsigned long long*)(F.lds + PT_OFF))[20] = (unsigned long long)args.out; }
    __syncthreads();
    const int lo = args.ph_lo, hi = args.ph_hi;
    XcdBarrier bar; bar.bar = (unsigned*)(F.ctl + CW_BAR) + args.bar_region * XCD_BAR_WORDS; bar.x = 0; bar.st = nullptr;
    if (hi - lo > 1) bar = xcd_barrier_post((unsigned*)(F.ctl + CW_BAR) + args.bar_region * XCD_BAR_WORDS, F.MISC + 8);

#pragma unroll 1
    for (int ph = lo; ph < hi; ++ph) {
        const int l = (ph - 1) / 8, sub = (ph - 1) % 8;
        int nrep = 1;
        if (DUP_MASK && ph < NPHASE - 1) { if (ph == 0) nrep += (DUP_MASK >> 7) & 1; else nrep += (DUP_MASK >> sub) & 1; }
#pragma unroll 1
        for (int rep = 0; rep < nrep; ++rep) {
        if (ph > lo || rep) xcd_barrier(bar, F.wave == 0 && mk_lane() == 0);
        if (PROBE_CLK >= 10 && blockIdx.x == 0 && F.tid == 0) ((unsigned long long*)(F.ws + WS_CTL + 16384))[ph] = __builtin_amdgcn_s_memrealtime();
#define FRESH_LANE() do { F.lane = mk_lane(); asm volatile("" : "+v"(F.lane)); F.tid = F.wave * 64 + F.lane; } while (0)
        asm volatile("" : "+s"(F.vcu), "+s"(F.wave), "+s"(F.G));
        { unsigned long long wsi = (unsigned long long)F.ws; asm volatile("" : "+s"(wsi)); F.ws = (unsigned char*)(GAS unsigned char*)wsi; }
        unsigned char* ws = F.ws;
        bf16* XN = (bf16*)(ws + WS_XN); bf16* Z = (bf16*)(ws + WS_Z); float* GT = (float*)(ws + WS_GT); bf16* Y = (bf16*)(ws + WS_Y); bf16* H = (bf16*)(ws + WS_H);
        float* G0 = (float*)(ws + WS_G0); float* UP0 = (float*)(ws + WS_UP0);
        if (ph == 0) { FRESH_LANE(); p0_prologue(F, args); continue; }
        if (ph == NPHASE - 1) { FRESH_LANE(); final_ln_phase(F, XN, (const float*)(ws + WS_PARTB), INP(18) + (DEPTH - 1) * DM, INP(19) + (DEPTH - 1) * DM, ((float*)INP(20))); continue; }
        const unsigned char* wt = ws + WS_WT + (size_t)l * WT_LAYER;
        const float* cv = (const float*)(ws + WS_CV); float* partA = (float*)(ws + WS_PARTA); float* partB = (float*)(ws + WS_PARTB);
        if (sub == 0) {
#ifndef NO_Z
            FRESH_LANE();
            if (l == 0) cvec_finalize(F, args);
            const float* part = l > 0 ? partB : nullptr;
            pg8::Gemm g{XN, (const bf16*)(wt + WT_IN), M, ZW, DM}; pg8::StaticOrder S; S.init(M, ZW, F.G, (int)blockIdx.x);
            pg8::EpiZ E{Z, ZW, part, cv + CV_IN1, cv + CV_IN1 + 2576, F.lds + MX_TAB};
            pg8::gemm_phase<pg8::EpiZ, pg8::StaticOrder, true, true>(F.lds + RING_OFF, g, S, E, F.tid);
            FRESH_LANE();
            gates_phase(F, XN, (const bf16*)(wt + WT_G), GT, part, cv + CV_IN1 + ZW, cv + CV_IN1 + 2576 + ZW);
            if (l == 0) { FRESH_LANE(); quant_w_step(F); }
#endif
        } else if (sub == 1) {
#ifndef NO_MIX
            FRESH_LANE();
            MIXER_PASS1
#endif
        } else if (sub == 2) {
#ifndef NO_MIX
            FRESH_LANE();
            MIXER_PASS2
#endif
        } else if (sub == 3) {
#ifndef NO_RES
            FRESH_LANE();
            res_gemm_phase(F, Y, (const bf16*)(wt + WT_OUT), DM, XN, (DUP_MASK && rep == 0 && nrep == 2) ? (bf16*)(ws + 295 * MiB) : XN, l > 0 ? partB : (const float*)nullptr, INP(18) + (l > 0 ? l - 1 : 0) * DM, INP(19) + (l > 0 ? l - 1 : 0) * DM, (DUP_MASK && rep == 0 && nrep == 2) ? (float*)(ws + 400 * MiB) : partA);
#endif
        } else if (sub == 4) {
            FRESH_LANE();
            quant_a_phase(F, XN);
        } else if (sub == 5) {
#ifndef NO_GLU
            FRESH_LANE();
            pg8::Gemm g{(const bf16*)(ws + WS_V8), (const bf16*)(ws + WS_W8 + (size_t)l * 2 * DFF * DM), M, 2 * DFF, DM / 2}; pg8::StaticOrder S; S.init(M, 2 * DFF, F.G, (int)blockIdx.x);
            const float* cu = cv + (l == 0 ? CV_UP0 : CV_UP1); const float* swc = (const float*)(ws + WS_SWC) + (size_t)l * 4 * DFF;
            pg8::EpiGlu8 E{H, INP(15) + (size_t)l * 3 * DFF, INP(16) + l * DFF, G0, UP0, DFF, M / 64, partA, swc + 2 * DFF, cu + 5632, F.lds + MX_TAB, swc, (const float*)(ws + WS_SA)};
            pg8::gemm_phase<pg8::EpiGlu8, pg8::StaticOrder, true, true>(F.lds + RING_OFF, g, S, E, F.tid);
#endif
        } else if (sub == 6) {
            FRESH_LANE();
            glu_fixup_phase(F, G0, UP0, INP(15) + (size_t)l * 3 * DFF, INP(16) + l * DFF, H);
        } else {
#ifndef NO_RES
            FRESH_LANE();
            res_gemm_phase(F, H, (const bf16*)(wt + WT_DN), DFF, XN, (DUP_MASK && rep == 0 && nrep == 2) ? (bf16*)(ws + WS_T4) : XN, partA, INP(12) + l * DM, INP(13) + l * DM, (DUP_MASK && rep == 0 && nrep == 2) ? (float*)(ws + WS_T4 + 128 * MiB) : partB);
#endif
        }
        }
    }
    if (PROBE_CLK && hi == NPHASE) { xcd_barrier(bar, F.wave == 0 && mk_lane() == 0); if (blockIdx.x == 0 && F.tid == 0) {
        if (PROBE_CLK >= 10) { unsigned long long* ts = (unsigned long long*)(F.ws + WS_CTL + 16384); ts[NPHASE] = __builtin_amdgcn_s_memrealtime(); const int k = PROBE_CLK - 10;
            ((float*)INP(20))[0] += 0.1f + 1e-5f * (float)(ts[k + 1] - ts[k]); }
        else ((float*)INP(20))[0] += ((float*)(F.ws + WS_CTL))[2048]; } }
}

static void launch_mk(const Args& base, int lo, int hi, int region, hipStream_t stream) {
    Args a = base; a.ph_lo = lo; a.ph_hi = hi; a.bar_region = region; a.pad = 0;
    hipLaunchKernelGGL(mk_fwd, dim3(256), dim3(NWAVES * 64), LDS_BYTES, stream, a);
}

extern "C" void kernel_launch(void* const* d_in, const int* in_sizes, int n_in, void* d_out, int out_size, void* d_ws, size_t ws_size, hipStream_t stream) {
    static int inited = 0;
    if (!inited) {
        if (hipFuncSetAttribute((const void*)mk_fwd, hipFuncAttributeMaxDynamicSharedMemorySize, LDS_BYTES) != hipSuccess) fprintf(stderr, "kernel_launch: hipFuncSetAttribute failed\n");
        int dev = 0, cus = 0, per_cu = 0;
        if (hipGetDevice(&dev) != hipSuccess || hipDeviceGetAttribute(&cus, hipDeviceAttributeMultiprocessorCount, dev) != hipSuccess) cus = 0;
        if (hipOccupancyMaxActiveBlocksPerMultiprocessor(&per_cu, (const void*)mk_fwd, NWAVES * 64, LDS_BYTES) != hipSuccess) per_cu = 0;
        (void)hipGetLastError();
        if (cus * per_cu < 256) fprintf(stderr, "kernel_launch: %d CUs x %d resident workgroups per CU < the 256 workgroups this kernel's grid barriers need\n", cus, per_cu);
        inited = 1;
    }
    unsigned char* ws = (unsigned char*)d_ws;
    (void)hipMemsetAsync(ws + WS_CTL, 0, CTL_ZERO_BYTES, stream);
    Args a{};
    for (int i = 0; i < 20; ++i) a.in[i] = (const float*)d_in[i];
    a.out = (float*)d_out; a.ws = ws;
    launch_mk(a, 0, NPHASE, 0, stream);
}
```

```cpp
constexpr int PROBE_CLK = 0;
constexpr int PROBE_NULL = 0;
constexpr int DUP_MASK = 0;
#include <hip/hip_runtime.h>
#include <cstdint>
#include <cstdio>

constexpr int BATCH = 4, SEQ = 8192, DM = 1024, M = BATCH * SEQ, DEPTH = 2;
constexpr int DA = 512, DQK = 256, DB = 512, NH = 4;
constexpr int DIN = 2568, ZW = 2560, DFF = 2816;
constexpr float LN_EPS = 1e-5f, ALPHA = 1.41421356237f;

typedef unsigned short bf16;
typedef unsigned u32x4 __attribute__((ext_vector_type(4)));

__device__ __forceinline__ float bf2f(bf16 v) { return __uint_as_float(((unsigned)v) << 16); }
__device__ __forceinline__ bf16 f2bf(float f) { unsigned u = __float_as_uint(f); return (bf16)((u + 0x7fffu + ((u >> 16) & 1u)) >> 16); }
__device__ __forceinline__ float gelu_f(float x) { return 0.5f * x * (1.0f + erff(x * 0.70710678118f)); }
__device__ __forceinline__ float silu_f(float x) { return x / (1.0f + expf(-x)); }
__device__ __forceinline__ float sigmoid_f(float x) { return 1.0f / (1.0f + expf(-x)); }
__device__ __forceinline__ float logsigmoid_f(float x) { return fminf(x, 0.f) - log1pf(expf(-fabsf(x))); }

constexpr size_t MiB = 1u << 20;
constexpr size_t WS_XN = 0;
constexpr size_t WS_Z = 64 * MiB;
constexpr size_t WS_GT = 224 * MiB;
constexpr size_t WS_Y = 225 * MiB;
constexpr size_t WS_HM = 289 * MiB;
constexpr size_t WS_QC = 353 * MiB;
constexpr size_t WS_KC = 385 * MiB;
constexpr size_t WS_IG = 417 * MiB;
constexpr size_t WS_LF = 417 * MiB + 512 * 1024;
constexpr size_t WS_T3 = 64 * MiB;
constexpr size_t WS_H = 64 * MiB;
constexpr size_t WS_T4 = 240 * MiB;
constexpr size_t WS_T5 = 240 * MiB;


__device__ __forceinline__ int mk_lane() { return (int)__builtin_amdgcn_mbcnt_hi(~0u, __builtin_amdgcn_mbcnt_lo(~0u, 0u)); }
namespace pg8 {
#define PG8_LAS __attribute__((address_space(3)))
typedef unsigned short bf16_t;
typedef short bf16x8 __attribute__((ext_vector_type(8)));
typedef float f32x4 __attribute__((ext_vector_type(4)));
typedef unsigned u32x4 __attribute__((ext_vector_type(4)));
typedef int i32x4 __attribute__((ext_vector_type(4)));
constexpr int BM = 256, BK = 64, HALF = 128, HTB = HALF * BK * 2  , STAGE_BYTES = 8 * HTB, NXCD = 8, WGM = 8;

__host__ __device__ __forceinline__ int lds_byte(int r, int c) { const int st = (r >> 4) * 2 + (c >> 5), rr = r & 15, cc = c & 31, ob = rr * 64 + cc * 2; return st * 1024 + (ob ^ (((ob >> 9) & 1) << 5)); }
__host__ __device__ __forceinline__ void stage_rc(int b, int& R, int& C) { const int st = b / 1024, sb = b % 1024, swz = sb ^ (((sb >> 9) & 1) << 5); R = (st >> 1) * 16 + swz / 64; C = (st & 1) * 32 + (swz % 64) / 2; }
__host__ __device__ __forceinline__ int perm32(int rho) { const int n = rho >> 4, i = rho & 15; return 8 * (i >> 2) + 4 * n + (i & 3); }

struct Unit { int pm, pn; };
struct Gemm { const bf16_t* A; const bf16_t* Bt; int M, N, K; };

struct StaticOrder {
    int nM, nN, nwg, G, c;
    __host__ __device__ void init(int M, int N, int G_, int c_) { nM = M / BM; nN = N / BM; nwg = nM * nN; G = G_; c = c_; }
    __host__ __device__ bool next(int i, Unit& u) const {
        const long L = (long)i * G + c; if (L >= nwg) return false;
        int wgid = (int)L; { const int q = nwg / NXCD, r = nwg % NXCD, xcd = wgid % NXCD, off = wgid / NXCD; wgid = (xcd < r ? xcd * (q + 1) : r * (q + 1) + (xcd - r) * q) + off; }
        const int nig = WGM * nN, gid = wgid / nig, fm = gid * WGM, gsz = (nM - fm) < WGM ? (nM - fm) : WGM;
        u.pm = fm + ((wgid % nig) % gsz); u.pn = (wgid % nig) / gsz; return true;
    }
    __device__ __forceinline__ void a_ready(const Unit&) const {}
    __device__ __forceinline__ void done(const Unit&) const {}
};

__device__ __forceinline__ unsigned cvt_pk_bf16(float lo, float hi) { unsigned r; asm volatile("v_cvt_pk_bf16_f32 %0, %1, %2" : "=v"(r) : "v"(lo), "v"(hi)); return r; }
typedef float f32x2 __attribute__((ext_vector_type(2)));
__device__ __forceinline__ f32x2 gelu_pk(f32x2 v) {
    const f32x2 av = __builtin_elementwise_abs(v), d = av * 0.2316418882f + 1.0f;
    f32x2 t; t.x = __builtin_amdgcn_rcpf(d.x); t.y = __builtin_amdgcn_rcpf(d.y);
    f32x2 q = t * 0.5307027145f + (-0.7265760135f); q = q * t + 0.7107068705f; q = q * t + (-0.142248368f); q = q * t + 0.127414796f; q = q * t;
    const f32x2 s = (v * v) * (-0.72134752044f);
    f32x2 e; e.x = __builtin_amdgcn_exp2f(s.x); e.y = __builtin_amdgcn_exp2f(s.y);
    const f32x2 m = v * (q * e), r = v - m;
    f32x2 o; o.x = v.x < 0.f ? m.x : r.x; o.y = v.y < 0.f ? m.y : r.y; return o;
}

constexpr float K_EPS = 1e-5f, K_ALPHA = 1.41421356237f;
struct RowStat { float nmr, r; };
constexpr int TAB_STAT = 0, TAB_CONST = 8192, TAB_P = 12288, TAB_P2 = 20480, TAB_SW = 12288, TAB_R4 = 24576, TAB_SA = 28672;
__device__ __forceinline__ void glds16(const void* gsrc, PG8_LAS unsigned char* ldst) { __builtin_amdgcn_global_load_lds((const unsigned*)gsrc, (PG8_LAS unsigned*)ldst, 16, 0, 0); }
__device__ __forceinline__ void prefetch_stats(const float* part, int pm, PG8_LAS unsigned char* tab, int wid, int lane) {
    glds16(part + ((size_t)pm * BM + 32 * wid) * 8 + 4 * lane, tab + TAB_STAT + wid * 1024);
}
__device__ __forceinline__ RowStat row_stat_lds(const PG8_LAS unsigned char* tab, int rloc, float eps) {
    const f32x4 a = *(const PG8_LAS f32x4*)(tab + TAB_STAT + rloc * 32), b = *(const PG8_LAS f32x4*)(tab + TAB_STAT + rloc * 32 + 16);
    const float mean = ((a[0] + a[2]) + (b[0] + b[2])) * 0.25f;
    const float d0 = a[0] - mean, d1 = a[2] - mean, d2 = b[0] - mean, d3 = b[2] - mean;
    const float m2 = ((a[1] + a[3]) + (b[1] + b[3])) + 256.0f * ((d0 * d0 + d1 * d1) + (d2 * d2 + d3 * d3));
    RowStat o; o.r = __builtin_amdgcn_rsqf(m2 * (1.0f / 1024.0f) + eps); o.nmr = -mean * o.r; return o;
}
__device__ __forceinline__ void finalize_stats(PG8_LAS unsigned char* tab, int tid, int slot = TAB_P) {
    typedef float f32x2v __attribute__((ext_vector_type(2)));
    if (tid < 256) { const RowStat rs = row_stat_lds(tab, tid, K_EPS); *(PG8_LAS f32x2v*)(tab + slot + 8 * tid) = (f32x2v){rs.nmr, rs.r}; }
}
__device__ __forceinline__ RowStat stat_tab(const PG8_LAS unsigned char* tab, int rloc, int slot = TAB_P) {
    typedef float f32x2v __attribute__((ext_vector_type(2)));
    const f32x2v v = *(const PG8_LAS f32x2v*)(tab + slot + 8 * rloc); RowStat o; o.nmr = v.x; o.r = v.y; return o;
}
__device__ __forceinline__ float sum_fq4(float x) {
    auto a = __builtin_amdgcn_permlane16_swap(__float_as_uint(x), __float_as_uint(x), false, false); const float y = __uint_as_float(a[0]) + __uint_as_float(a[1]);
    auto b = __builtin_amdgcn_permlane32_swap(__float_as_uint(y), __float_as_uint(y), false, false); return __uint_as_float(b[0]) + __uint_as_float(b[1]);
}
__device__ __forceinline__ RowStat row_stat(const float* part, size_t row, float eps) {
    const f32x4 a = *(const f32x4*)(part + row * 8), b = *(const f32x4*)(part + row * 8 + 4);
    const float mean = ((a[0] + a[2]) + (b[0] + b[2])) * 0.25f;
    const float d0 = a[0] - mean, d1 = a[2] - mean, d2 = b[0] - mean, d3 = b[2] - mean;
    const float m2 = ((a[1] + a[3]) + (b[1] + b[3])) + 256.0f * ((d0 * d0 + d1 * d1) + (d2 * d2 + d3 * d3));
    RowStat o; o.r = 1.0f / sqrtf(m2 * (1.0f / 1024.0f) + eps); o.nmr = -mean * o.r; return o;
}
__device__ __forceinline__ f32x2 gelu_ns_pk(f32x2 v) {
    const f32x2 av = __builtin_elementwise_abs(v), d = av * 0.2316418882f + 1.0f;
    f32x2 t; t.x = __builtin_amdgcn_rcpf(d.x); t.y = __builtin_amdgcn_rcpf(d.y);
    f32x2 q = t * 0.5307027145f + (-0.7265760135f); q = q * t + 0.7107068705f; q = q * t + (-0.142248368f); q = q * t + 0.127414796f; q = q * t;
    const f32x2 s = (v * v) * (-0.72134752044f);
    f32x2 e; e.x = __builtin_amdgcn_exp2f(s.x); e.y = __builtin_amdgcn_exp2f(s.y);
    return __builtin_elementwise_max(v, (f32x2){0.f, 0.f}) - av * (q * e);
}
struct EpiZ {
    static constexpr bool PERM = true, AFTER_DRAIN = false, PERM_A = false, I8 = false;
    bf16_t* O; int ldc; const float* part; const float* c1; const float* c0; PG8_LAS unsigned char* tab;
    __device__ __forceinline__ void prefetch(const Unit& u, int wid, int lane) const {
        if (part) { prefetch_stats(part, u.pm, tab, wid, lane);
            if (wid < 2) glds16((wid ? c0 : c1) + u.pn * BM + 4 * lane, tab + TAB_CONST + wid * 1024); }
    }
    __device__ __forceinline__ void operator()(f32x4 (&acc)[2][2][4][2], const Unit& u, int wr, int wc, int fr, int fq) const {
        const int row0 = u.pm * BM + wr * 64 + fr, col0 = u.pn * BM + wc * 32 + 8 * fq, cl0 = wc * 32 + 8 * fq;
        const bool act = u.pn < 4;
        if (part) { finalize_stats(tab, (wr * 4 + wc) * 64 + fr + 16 * fq); asm volatile("s_waitcnt lgkmcnt(0)" ::: "memory"); __builtin_amdgcn_s_barrier(); asm volatile("" ::: "memory"); }
#pragma unroll
        for (int ai = 0; ai < 2; ++ai)
#pragma unroll
            for (int m = 0; m < 4; ++m) { const int rloc = ai * HALF + wr * 64 + m * 16 + fr; bf16_t* rowp = O + (size_t)(u.pm * BM + rloc) * ldc + col0;
                RowStat rs; rs.r = 1.f; rs.nmr = 0.f; if (part) rs = stat_tab(tab, rloc);
#pragma unroll
                for (int bj = 0; bj < 2; ++bj) { u32x4 w;
#pragma unroll
                    for (int n = 0; n < 2; ++n) { f32x4 v = acc[ai][bj][m][n];
                        if (part) { const f32x4 k1 = *(const PG8_LAS f32x4*)(tab + TAB_CONST + (cl0 + bj * HALF + 4 * n) * 4), k0 = *(const PG8_LAS f32x4*)(tab + TAB_CONST + 1024 + (cl0 + bj * HALF + 4 * n) * 4);
                            v = v * rs.r + (k1 * rs.nmr + k0); }
                        if (act) { const f32x2 a = gelu_ns_pk((f32x2){v[0], v[1]}), b = gelu_ns_pk((f32x2){v[2], v[3]}); v = (f32x4){a.x, a.y, b.x, b.y}; }
                        w[2 * n] = cvt_pk_bf16(v[0], v[1]); w[2 * n + 1] = cvt_pk_bf16(v[2], v[3]); }
                    *(u32x4*)(rowp + bj * HALF) = w; }
                asm volatile("" ::: "memory"); }
    }
};

struct EpiRes {
    static constexpr bool PERM = true, AFTER_DRAIN = false, PERM_A = false, I8 = false;
    bf16_t* V; bf16_t* Vout; int ldc; const float* part_prev; const float* gp; const float* bp; float* part_new; PG8_LAS unsigned char* tab;
    __device__ __forceinline__ void prefetch(const Unit& u, int wid, int lane) const {
        if (part_prev) { prefetch_stats(part_prev, u.pm, tab, wid, lane);
            if (wid < 2) glds16((wid ? bp : gp) + u.pn * BM + 4 * lane, tab + TAB_CONST + wid * 1024); }
    }
    __device__ __forceinline__ void operator()(f32x4 (&acc)[2][2][4][2], const Unit& u, int wr, int wc, int fr, int fq) const {
        typedef float f32x2v __attribute__((ext_vector_type(2)));
        const int col0 = u.pn * BM + wc * 32 + 8 * fq, cl0 = wc * 32 + 8 * fq, lane = fr + 16 * fq, wid = wr * 4 + wc;
        PG8_LAS f32x2v* P = (PG8_LAS f32x2v*)(tab + TAB_P);
        u32x4 bwv[2][4][2];
#pragma unroll
        for (int ai = 0; ai < 2; ++ai)
#pragma unroll
            for (int m = 0; m < 4; ++m)
#pragma unroll
                for (int bj = 0; bj < 2; ++bj) bwv[ai][m][bj] = *(const u32x4*)(V + (size_t)(u.pm * BM + ai * HALF + wr * 64 + m * 16 + fr) * ldc + col0 + bj * HALF);
        asm volatile("" ::: "memory");
        if (part_prev) { finalize_stats(tab, wid * 64 + lane, TAB_P2); asm volatile("s_waitcnt lgkmcnt(0)" ::: "memory"); __builtin_amdgcn_s_barrier(); asm volatile("" ::: "memory"); }
#pragma unroll
        for (int ai = 0; ai < 2; ++ai)
#pragma unroll
            for (int m = 0; m < 4; ++m) { const int rloc = ai * HALF + wr * 64 + m * 16 + fr; bf16_t* rowp = V + (size_t)(u.pm * BM + rloc) * ldc + col0; bf16_t* rowo = Vout + (size_t)(u.pm * BM + rloc) * ldc + col0;
                RowStat rs; rs.r = 1.f; rs.nmr = 0.f; if (part_prev) rs = stat_tab(tab, rloc, TAB_P2);
                float sm = 0.f;
#pragma unroll
                for (int bj = 0; bj < 2; ++bj) { const u32x4 bw = bwv[ai][m][bj];
#pragma unroll
                    for (int n = 0; n < 2; ++n) { const unsigned lo = bw[2 * n], hi = bw[2 * n + 1];
                        f32x4 xs = (f32x4){__uint_as_float(lo << 16), __uint_as_float(lo & 0xffff0000u), __uint_as_float(hi << 16), __uint_as_float(hi & 0xffff0000u)};
                        if (part_prev) { const f32x4 gv = *(const PG8_LAS f32x4*)(tab + TAB_CONST + (cl0 + bj * HALF + 4 * n) * 4), bv = *(const PG8_LAS f32x4*)(tab + TAB_CONST + 1024 + (cl0 + bj * HALF + 4 * n) * 4);
                            xs = (xs * rs.r + rs.nmr) * gv + bv; }
                        const f32x4 v = xs * K_ALPHA + acc[ai][bj][m][n]; acc[ai][bj][m][n] = v; sm += (v[0] + v[1]) + (v[2] + v[3]); } }
                sm = sum_fq4(sm);
                const float mw = sm * (1.0f / 64.0f); float q = 0.f;
#pragma unroll
                for (int bj = 0; bj < 2; ++bj)
#pragma unroll
                    for (int n = 0; n < 2; ++n) { const f32x4 d = acc[ai][bj][m][n] - mw; q += (d[0] * d[0] + d[1] * d[1]) + (d[2] * d[2] + d[3] * d[3]); }
                q = sum_fq4(q);
                if (fq == 0) P[rloc * 4 + wc] = (f32x2v){mw, q};
#pragma unroll
                for (int bj = 0; bj < 2; ++bj) { const f32x4 v0 = acc[ai][bj][m][0], v1 = acc[ai][bj][m][1];
                    u32x4 w; w.x = cvt_pk_bf16(v0[0], v0[1]); w.y = cvt_pk_bf16(v0[2], v0[3]); w.z = cvt_pk_bf16(v1[0], v1[1]); w.w = cvt_pk_bf16(v1[2], v1[3]);
                    *(u32x4*)(rowo + bj * HALF) = w; }
                asm volatile("" ::: "memory"); }
        asm volatile("s_waitcnt lgkmcnt(0)" ::: "memory"); __builtin_amdgcn_s_barrier(); asm volatile("" ::: "memory");
        { const int row = wid * 32 + (lane & 31);
          if (lane < 32) { const f32x2v a = P[row * 4 + 0], b = P[row * 4 + 1], c = P[row * 4 + 2], d = P[row * 4 + 3];
            const float mt = (a.x + b.x + c.x + d.x) * 0.25f; const float da = a.x - mt, db = b.x - mt, dc = c.x - mt, dd = d.x - mt;
            const float m2 = (a.y + b.y) + (c.y + d.y) + 64.0f * ((da * da + db * db) + (dc * dc + dd * dd));
            *(f32x2v*)(part_new + (size_t)(u.pm * BM + row) * 8 + 2 * u.pn) = (f32x2v){mt, m2}; } }
    }
};

#define PG8_DPP0(src, ctrl) __builtin_bit_cast(float, __builtin_amdgcn_update_dpp(0, __builtin_bit_cast(int, (float)(src)), (ctrl), 0xf, 0xf, true))
__device__ __forceinline__ f32x2 gelu_mul_pk(f32x2 v, f32x2 u) {
    const f32x2 av = __builtin_elementwise_abs(v), d = av * 0.2316418882f + 1.0f;
    f32x2 t; t.x = __builtin_amdgcn_rcpf(d.x); t.y = __builtin_amdgcn_rcpf(d.y);
    f32x2 q = t * 0.5307027145f + (-0.7265760135f); q = q * t + 0.7107068705f; q = q * t + (-0.142248368f); q = q * t + 0.127414796f; q = q * t;
    const f32x2 s = (v * v) * (-0.72134752044f);
    f32x2 e; e.x = __builtin_amdgcn_exp2f(s.x); e.y = __builtin_amdgcn_exp2f(s.y);
    const f32x2 r = __builtin_elementwise_max(v, (f32x2){0.f, 0.f}) - av * (q * e);
    return r * u;
}
template <int MODE  , bool I8_ = false> struct EpiGluT {
    static constexpr bool PERM = true, AFTER_DRAIN = false, PERM_A = true, I8 = I8_;
    bf16_t* H; const float* cw; const float* cb; float* G0; float* UP0; int dff; int ngrp; const float* part; const float* c1; const float* c0; PG8_LAS unsigned char* tab; const float* sw; const float* sa;
    __device__ __forceinline__ void prefetch(const Unit& u, int wid, int lane) const {
        if (!I8_) prefetch_stats(part, u.pm, tab, wid, lane);
        if (wid < 4) { const int v = 2 * wid + (lane >> 5), c4 = (lane & 31) * 4;
            const float* src = (v < 3) ? cw + v * dff : (v == 3) ? cb : (v & 1) ? c0 + ((v - 4) >> 1) * dff : c1 + ((v - 4) >> 1) * dff;
            glds16(src + u.pn * HALF + c4, tab + TAB_CONST + wid * 1024); }
        if (I8_) {
            if (wid == 4) glds16(sw + (lane >> 5) * dff + u.pn * HALF + (lane & 31) * 4, tab + TAB_SW);
            if (wid == 5) glds16(sa + (size_t)u.pm * BM + 4 * lane, tab + TAB_SA); }
    }
    __device__ __forceinline__ void operator()(f32x4 (&acc)[2][2][4][2], const Unit& u, int wr, int wc, int fr, int fq) const {
        const int hc0 = u.pn * HALF + wc * 32 + 8 * fq;
        const PG8_LAS unsigned char* wt_ = tab + TAB_CONST + (wc * 32 + 8 * fq) * 4;
#define PG8_TABV(v_, n_) (*(const PG8_LAS f32x4*)(wt_ + (v_) * 512 + (4 * (n_)) * 4))
        if (MODE == 0 && !I8_) { finalize_stats(tab, (wr * 4 + wc) * 64 + fr + 16 * fq); asm volatile("s_waitcnt lgkmcnt(0)" ::: "memory"); __builtin_amdgcn_s_barrier(); asm volatile("" ::: "memory"); }
#pragma unroll
        for (int ai = 0; ai < 2; ++ai) {
            const int tb = u.pm * BM + ai * HALF + wr * 64, grp = tb >> 6;
            if (MODE == 0 && I8_) {
                float sa4[4];
#pragma unroll
                for (int m = 0; m < 4; ++m) sa4[m] = *(const PG8_LAS float*)(tab + TAB_SA + 4 * (ai * HALF + wr * 64 + 4 * fr + m));
#pragma unroll
                for (int bj = 0; bj < 2; ++bj)
#pragma unroll
                    for (int n = 0; n < 2; ++n) { const f32x4 k0 = PG8_TABV(5 + 2 * bj, n), swv = PG8_TABV(8 + bj, n);
#pragma unroll
                        for (int m = 0; m < 4; ++m) { const f32x4 fv = __builtin_convertvector(__builtin_bit_cast(i32x4, acc[ai][bj][m][n]), f32x4);
                            acc[ai][bj][m][n] = fv * (swv * sa4[m]) + k0; } }
                asm volatile("" ::: "memory");
            }
            if (MODE == 0 && !I8_) {
                RowStat rs[4];
#pragma unroll
                for (int m = 0; m < 4; ++m) rs[m] = stat_tab(tab, ai * HALF + wr * 64 + 4 * fr + m);
#pragma unroll
                for (int bj = 0; bj < 2; ++bj)
#pragma unroll
                    for (int n = 0; n < 2; ++n) { const f32x4 k1 = PG8_TABV(4 + 2 * bj, n), k0 = PG8_TABV(5 + 2 * bj, n);
#pragma unroll
                        for (int m = 0; m < 4; ++m) acc[ai][bj][m][n] = acc[ai][bj][m][n] * rs[m].r + (k1 * rs[m].nmr + k0); }
                asm volatile("" ::: "memory");
            }
            unsigned hp[4][2];
#pragma unroll
            for (int n = 0; n < 2; ++n) {
                const f32x4 w0 = PG8_TABV(0, n), w1 = PG8_TABV(1, n), w2 = PG8_TABV(2, n), cbv = PG8_TABV(3, n);
#pragma unroll
                for (int m = 0; m < 4; ++m) {
                    const int t = tb + 4 * fr + m; const f32x4 gg = acc[ai][0][m][n], up = acc[ai][1][m][n]; f32x4 hv;
                    if (MODE == 1) { hv = gg * up; } else {
                    f32x4 g1, g2;
                    if (m == 0) {
#pragma unroll
                        for (int e = 0; e < 4; ++e) { g1[e] = PG8_DPP0(acc[ai][0][3][n][e], 0x111); g2[e] = PG8_DPP0(acc[ai][0][2][n][e], 0x111); } }
                    else if (m == 1) { g1 = acc[ai][0][0][n];
#pragma unroll
                        for (int e = 0; e < 4; ++e) g2[e] = PG8_DPP0(acc[ai][0][3][n][e], 0x111); }
                    else { g1 = acc[ai][0][m - 1][n]; g2 = acc[ai][0][m - 2][n]; }
                    const f32x4 cv = cbv + w0 * g2 + w1 * g1 + w2 * gg;
                    const f32x2 a = gelu_mul_pk((f32x2){cv[0], cv[1]}, (f32x2){up[0], up[1]}), b = gelu_mul_pk((f32x2){cv[2], cv[3]}, (f32x2){up[2], up[3]});
                    hv = (f32x4){a.x, a.y, b.x, b.y}; }
                    if (MODE == 0 && fr == 0 && m < 2) {
                        *(f32x4*)(G0 + ((size_t)grp * 4 + 2 + m) * dff + hc0 + 4 * n) = gg; *(f32x4*)(UP0 + ((size_t)grp * 2 + m) * dff + hc0 + 4 * n) = up; }
                    if (MODE == 0 && fr == 15 && m >= 2 && grp + 1 < ngrp)
                        *(f32x4*)(G0 + ((size_t)(grp + 1) * 4 + (m - 2)) * dff + hc0 + 4 * n) = gg;
                    const unsigned p0 = cvt_pk_bf16(hv[0], hv[1]), p1 = cvt_pk_bf16(hv[2], hv[3]);
                    if (n == 0) { hp[m][0] = p0; hp[m][1] = p1; }
                    else if (MODE == 2) { asm volatile("" :: "v"(p0), "v"(p1), "v"(hp[m][0]), "v"(hp[m][1])); }
                    else if (m >= 2 || fr > 0) { u32x4 w; w.x = hp[m][0]; w.y = hp[m][1]; w.z = p0; w.w = p1; __builtin_nontemporal_store(w, (u32x4*)(H + (size_t)t * dff + hc0)); }
                }
            }
            asm volatile("" ::: "memory");
        }
#undef PG8_TABV
    }
};
typedef EpiGluT<0> EpiGlu;
typedef EpiGluT<0, true> EpiGlu8;
struct EpiNull {
    static constexpr bool PERM = true, AFTER_DRAIN = false, PERM_A = false, I8 = false;
    __device__ __forceinline__ void prefetch(const Unit&, int, int) const {}
    __device__ __forceinline__ void operator()(f32x4 (&acc)[2][2][4][2], const Unit& u, int wr, int wc, int fr, int fq) const {
#pragma unroll
        for (int ai = 0; ai < 2; ++ai)
#pragma unroll
            for (int bj = 0; bj < 2; ++bj)
#pragma unroll
                for (int m = 0; m < 4; ++m) asm volatile("" :: "v"(acc[ai][bj][m][0]), "v"(acc[ai][bj][m][1]));
    }
};
template <class Epi, class Sched, bool ALIGN_EPI = false, bool SP2 = false>
__device__ __forceinline__ void gemm_phase(PG8_LAS unsigned char* lds, const Gemm g, const Sched& S, const Epi& E, int tid_in) {
    int tid_ = tid_in; asm volatile("" : "+v"(tid_));
    const int tid = tid_, wid = __builtin_amdgcn_readfirstlane(tid >> 6), lane = tid & 63, wr = wid >> 2, wc = wid & 3, fr = lane & 15, fq = lane >> 4;
    const int K = g.K, nt = K / BK;
    unsigned voffA[2], voffB[2];
#pragma unroll
    for (int i = 0; i < 2; ++i) { int R, C; stage_rc(tid * 16 + i * 8192, R, C); const int Rb = Epi::PERM ? ((R & ~31) + perm32(R & 31)) : R;
        const int Ra = Epi::PERM_A ? ((R & ~63) + 4 * (R & 15) + ((R >> 4) & 3)) : R;
        voffA[i] = (unsigned)(Ra * K + C) * 2u; voffB[i] = (unsigned)(Rb * K + C) * 2u; }
    const size_t kstep = (size_t)(BK * 2);
    const size_t hstep = (size_t)HALF * K * 2;
    const size_t tstep = 2 * hstep;
    const unsigned ldsw = (unsigned)wid * 1024u;
    const int aoff = lds_byte(wr * 64 + fr, fq * 8), boff = lds_byte(wc * 32 + fr, fq * 8);
#define PG8_SA(b, h) (((b) * 2 + (h)) * HTB)
#define PG8_SB(b, h) ((4 + (b) * 2 + (h)) * HTB)
#define PG8_STAGE(bufoff, gbase, voff) do { _Pragma("unroll") for (int _i = 0; _i < 2; ++_i) \
        __builtin_amdgcn_global_load_lds((const unsigned*)((const char*)(gbase) + (voff)[_i]), (PG8_LAS unsigned*)(lds + (bufoff) + ldsw + _i * 8192), 16, 0, 0); } while (0)
#define PG8_LDA(dst, b, h) do { _Pragma("unroll") for (int m = 0; m < 4; ++m) _Pragma("unroll") for (int k = 0; k < 2; ++k) dst[m][k] = *(const PG8_LAS bf16x8*)(lds + PG8_SA(b, h) + aoff + m * 2048 + k * 1024); } while (0)
#define PG8_LDB(dst, b, h) do { _Pragma("unroll") for (int n = 0; n < 2; ++n) _Pragma("unroll") for (int k = 0; k < 2; ++k) dst[n][k] = *(const PG8_LAS bf16x8*)(lds + PG8_SB(b, h) + boff + n * 2048 + k * 1024); } while (0)
#define PG8_MMA(ai, bj, At, Bt) do { __builtin_amdgcn_s_setprio(1); _Pragma("unroll") for (int m = 0; m < 4; ++m) _Pragma("unroll") for (int n = 0; n < 2; ++n) _Pragma("unroll") for (int k = 0; k < 2; ++k) \
        { if constexpr (Epi::I8) acc[ai][bj][m][n] = __builtin_bit_cast(f32x4, __builtin_amdgcn_mfma_i32_16x16x64_i8(__builtin_bit_cast(i32x4, Bt[n][k]), __builtin_bit_cast(i32x4, At[m][k]), __builtin_bit_cast(i32x4, acc[ai][bj][m][n]), 0, 0, 0)); \
          else acc[ai][bj][m][n] = __builtin_amdgcn_mfma_f32_16x16x32_bf16(Bt[n][k], At[m][k], acc[ai][bj][m][n], 0, 0, 0); } __builtin_amdgcn_s_setprio(0); } while (0)
#define PG8_WAIT_V(n) asm volatile("s_waitcnt vmcnt(" #n ")" ::: "memory")
#define PG8_WAIT_L(n) asm volatile("s_waitcnt lgkmcnt(" #n ")" ::: "memory")
#define PG8_BAR __builtin_amdgcn_s_barrier()
#define PG8_SCHED __builtin_amdgcn_sched_barrier(0)
    Unit cur, nxt; int ui = 0;
    if (!S.next(0, cur)) return;
    f32x4 acc[2][2][4][2];
    bf16x8 At[4][2], B0[2][2], B1[2][2];
    const char* cA = (const char*)g.A + (size_t)cur.pm * tstep; const char* cB = (const char*)g.Bt + (size_t)cur.pn * tstep;
    S.a_ready(cur);
    if constexpr (SP2) {
        PG8_STAGE(PG8_SB(0, 0), cB, voffB); PG8_STAGE(PG8_SB(0, 1), cB + hstep, voffB); PG8_STAGE(PG8_SA(0, 0), cA, voffA); PG8_STAGE(PG8_SA(0, 1), cA + hstep, voffA);
        if (wr == 1) PG8_BAR;
        PG8_WAIT_V(2); PG8_BAR;
        PG8_STAGE(PG8_SB(1, 0), cB + kstep, voffB); PG8_STAGE(PG8_SA(1, 0), cA + kstep, voffA); PG8_STAGE(PG8_SB(1, 1), cB + hstep + kstep, voffB);
        PG8_WAIT_V(6); PG8_BAR;
    } else {
        PG8_STAGE(PG8_SB(0, 0), cB, voffB); PG8_STAGE(PG8_SA(0, 0), cA, voffA); PG8_STAGE(PG8_SB(0, 1), cB + hstep, voffB); PG8_STAGE(PG8_SA(0, 1), cA + hstep, voffA);
        if (wr == 1) PG8_BAR;
        PG8_WAIT_V(4); PG8_BAR;
        PG8_STAGE(PG8_SB(1, 0), cB + kstep, voffB); PG8_STAGE(PG8_SA(1, 0), cA + kstep, voffA); PG8_STAGE(PG8_SB(1, 1), cB + hstep + kstep, voffB);
        PG8_WAIT_V(6); PG8_BAR;
    }
#pragma unroll
    for (int a = 0; a < 2; ++a)
#pragma unroll
        for (int b = 0; b < 2; ++b)
#pragma unroll
            for (int m = 0; m < 4; ++m)
#pragma unroll
                for (int n = 0; n < 2; ++n) acc[a][b][m][n] = (f32x4){0.f, 0.f, 0.f, 0.f};
    for (;;) {
        const bool has_next = S.next(ui + 1, nxt);
        const char* nA = has_next ? (const char*)g.A + (size_t)nxt.pm * tstep : cA; const char* nB = has_next ? (const char*)g.Bt + (size_t)nxt.pn * tstep : cB;
        { PG8_BAR; int ln_ = (int)__builtin_amdgcn_mbcnt_hi(~0u, __builtin_amdgcn_mbcnt_lo(~0u, 0u)); asm volatile("" : "+v"(ln_)); E.prefetch(cur, wid, ln_); }
        for (int t = 0; t < nt; t += 2) {
            const bool last = (t == nt - 2);
            const char* a1 = cA + (size_t)(t + 1) * kstep;
            const char* a2 = last ? nA : cA + (size_t)(t + 2) * kstep; const char* b2 = last ? nB : cB + (size_t)(t + 2) * kstep;
            const char* a3 = a2 + kstep; const char* b3 = b2 + kstep;
            if (last && has_next) S.a_ready(nxt);
            if constexpr (SP2) {
            PG8_LDB(B0, 0, 0); PG8_LDB(B1, 0, 1); PG8_SCHED; PG8_LDA(At, 0, 0); PG8_STAGE(PG8_SA(1, 1), a1 + hstep, voffA);
            PG8_WAIT_V(8); PG8_WAIT_L(0); PG8_BAR; PG8_MMA(0, 0, At, B0); PG8_MMA(0, 1, At, B1); PG8_BAR; PG8_SCHED;
            PG8_LDA(At, 0, 1); PG8_STAGE(PG8_SB(0, 0), b2, voffB); PG8_STAGE(PG8_SB(0, 1), b2 + hstep, voffB); PG8_STAGE(PG8_SA(0, 0), a2, voffA);
            PG8_WAIT_V(8); PG8_WAIT_L(0); PG8_BAR; PG8_MMA(1, 0, At, B0); PG8_MMA(1, 1, At, B1); PG8_BAR; PG8_SCHED;
            PG8_LDB(B0, 1, 0); PG8_LDB(B1, 1, 1); PG8_SCHED; PG8_LDA(At, 1, 0); PG8_STAGE(PG8_SA(0, 1), a2 + hstep, voffA);
            PG8_WAIT_V(8); PG8_WAIT_L(0); PG8_BAR; PG8_MMA(0, 0, At, B0); PG8_MMA(0, 1, At, B1); PG8_BAR; PG8_SCHED;
            PG8_LDA(At, 1, 1); PG8_STAGE(PG8_SB(1, 0), b3, voffB); PG8_STAGE(PG8_SB(1, 1), b3 + hstep, voffB); PG8_STAGE(PG8_SA(1, 0), a3, voffA);
            PG8_WAIT_V(8); PG8_WAIT_L(0); PG8_BAR; PG8_MMA(1, 0, At, B0); PG8_MMA(1, 1, At, B1); PG8_BAR; PG8_SCHED;
            } else {
            PG8_LDB(B0, 0, 0); PG8_SCHED; PG8_LDA(At, 0, 0); PG8_STAGE(PG8_SA(1, 1), a1 + hstep, voffA);
            PG8_WAIT_L(8); PG8_BAR; PG8_WAIT_L(0); PG8_MMA(0, 0, At, B0); PG8_BAR; PG8_SCHED;
            PG8_LDB(B1, 0, 1); PG8_STAGE(PG8_SB(0, 0), b2, voffB);
            PG8_BAR; PG8_WAIT_L(0); PG8_MMA(0, 1, At, B1); PG8_BAR;
            PG8_LDA(At, 0, 1); PG8_STAGE(PG8_SA(0, 0), a2, voffA);
            PG8_BAR; PG8_WAIT_L(0); PG8_MMA(1, 0, At, B0); PG8_BAR; PG8_SCHED;
            PG8_STAGE(PG8_SB(0, 1), b2 + hstep, voffB);
            PG8_WAIT_V(6); PG8_BAR; PG8_MMA(1, 1, At, B1); PG8_BAR;
            PG8_LDB(B0, 1, 0); PG8_SCHED; PG8_LDA(At, 1, 0); PG8_STAGE(PG8_SA(0, 1), a2 + hstep, voffA);
            PG8_WAIT_L(8); PG8_BAR; PG8_WAIT_L(0); PG8_MMA(0, 0, At, B0); PG8_BAR; PG8_SCHED;
            PG8_LDB(B1, 1, 1); PG8_STAGE(PG8_SB(1, 0), b3, voffB);
            PG8_BAR; PG8_WAIT_L(0); PG8_MMA(0, 1, At, B1); PG8_BAR;
            PG8_LDA(At, 1, 1); PG8_STAGE(PG8_SA(1, 0), a3, voffA);
            PG8_BAR; PG8_WAIT_L(0); PG8_MMA(1, 0, At, B0); PG8_BAR; PG8_SCHED;
            PG8_STAGE(PG8_SB(1, 1), b3 + hstep, voffB);
            PG8_WAIT_V(6); PG8_BAR; PG8_MMA(1, 1, At, B1); PG8_BAR;
            }
        }
        if constexpr (ALIGN_EPI) { if (wr == 0) PG8_BAR; }
        if constexpr (!Epi::AFTER_DRAIN) { int ln_ = (int)__builtin_amdgcn_mbcnt_hi(~0u, __builtin_amdgcn_mbcnt_lo(~0u, 0u)); asm volatile("" : "+v"(ln_));
            E(acc, cur, wr, wc, ln_ & 15, ln_ >> 4); S.done(cur); }
        if (!has_next) break;
#pragma unroll
        for (int a = 0; a < 2; ++a)
#pragma unroll
            for (int b = 0; b < 2; ++b)
#pragma unroll
                for (int m = 0; m < 4; ++m)
#pragma unroll
                    for (int n = 0; n < 2; ++n) acc[a][b][m][n] = (f32x4){0.f, 0.f, 0.f, 0.f};
        cur = nxt; cA = nA; cB = nB; ++ui;
        if constexpr (ALIGN_EPI) { if (wr == 1) PG8_BAR; }
    }
    PG8_WAIT_V(0);
    if constexpr (!ALIGN_EPI) { if (wr == 0) PG8_BAR; }
    PG8_BAR;
    if constexpr (Epi::AFTER_DRAIN) { E.fused(acc, cur, wr, wc, fr, fq, lds, wid, lane); S.done(cur); }
#undef PG8_SA
#undef PG8_SB
#undef PG8_STAGE
#undef PG8_LDA
#undef PG8_LDB
#undef PG8_MMA
#undef PG8_WAIT_V
#undef PG8_WAIT_L
#undef PG8_BAR
#undef PG8_SCHED
}
}
#define GAS __attribute__((address_space(1)))
#define LAS __attribute__((address_space(3)))
typedef unsigned short bf16;
typedef unsigned v4u __attribute__((ext_vector_type(4)));
typedef float f32x4 __attribute__((ext_vector_type(4)));
typedef short bf16x8 __attribute__((ext_vector_type(8)));
typedef GAS unsigned gu32;
typedef GAS unsigned long long gu64;
#define RLX_AGENT __ATOMIC_RELAXED, __HIP_MEMORY_SCOPE_AGENT
#define LDS_WAIT() asm volatile("s_waitcnt lgkmcnt(0)" ::: "memory")
#define VM_WAIT() asm volatile("s_waitcnt vmcnt(0)" ::: "memory")
__device__ __forceinline__ unsigned long long rt() { return __builtin_amdgcn_s_memrealtime(); }

#define XB_TMO      128
#define XB_XCNT(j)  (256  + 64 * (j))
#define XB_XSUB(j)  (1280 + 64 * (j))
#define XB_XGEN(j)  (2304 + 64 * (j))
#define XB_TOP      3328
#define XB_TOPGEN   3392
#define XCD_BAR_WORDS 3456
#define XB_SPIN_CAP (1u << 18)

__device__ __forceinline__ unsigned xb_ld(unsigned* p)              { return __hip_atomic_load(p, __ATOMIC_RELAXED, __HIP_MEMORY_SCOPE_AGENT); }
__device__ __forceinline__ unsigned xb_add(unsigned* p, unsigned v) { return __hip_atomic_fetch_add(p, v, __ATOMIC_RELAXED, __HIP_MEMORY_SCOPE_AGENT); }
__device__ __forceinline__ unsigned xb_xcc_id() { return (unsigned)__builtin_amdgcn_s_getreg((3 << 11) | 20) & 0xFu; }
#define XB_SPIN(cond, bar) do { unsigned _sp = 0; while (cond) { __builtin_amdgcn_s_sleep(1); \
    if ((++_sp & 255u) == 0u) { if (xb_ld(&(bar)[XB_TMO])) break; if (_sp > XB_SPIN_CAP) { atomicAdd(&(bar)[XB_TMO], 1u); break; } } } } while (0)

struct XcdBarrier {
    unsigned* bar; unsigned x;
    volatile LAS unsigned* st;
};

__device__ __forceinline__ XcdBarrier xcd_barrier_post(unsigned* bar, volatile LAS unsigned* st) {
    XcdBarrier b; b.bar = bar; b.x = xb_xcc_id(); b.st = st;
    if (threadIdx.x == 0) (void)xb_add(&bar[XB_XCNT(b.x)], 1u);
    return b;
}
__device__ __forceinline__ void xcd_barrier_complete(unsigned* bar, unsigned x, unsigned& nloc, unsigned& nx) {
    const unsigned G = gridDim.x * gridDim.y * gridDim.z;
    unsigned sum, cnt, mine, sp = 0u;
    for (;;) {
        sum = 0u; cnt = 0u; mine = 0u;
#pragma unroll
        for (unsigned j = 0; j < 16; ++j) { const unsigned c = xb_ld(&bar[XB_XCNT(j)]); sum += c; cnt += (c > 0u) ? 1u : 0u; mine = (j == x) ? c : mine; }
        if (sum == G) break;
        __builtin_amdgcn_s_sleep(1);
        if ((++sp & 255u) == 0u) { if (xb_ld(&bar[XB_TMO])) break; if (sp > XB_SPIN_CAP) { atomicAdd(&bar[XB_TMO], 1u); break; } }
    }
    nloc = mine > 0u ? mine : 1u; nx = cnt > 0u ? cnt : 1u;
}

__device__ __forceinline__ void xcd_barrier(const XcdBarrier& b, bool leader_thread) {
    asm volatile("s_waitcnt vmcnt(0)" ::: "memory");
    __syncthreads();
    if (leader_thread) {
        unsigned* bar = b.bar;
        __builtin_amdgcn_s_waitcnt(0);
        unsigned nloc = b.st[0], nx = b.st[1];
        if (nloc == 0u) { xcd_barrier_complete(bar, b.x, nloc, nx); b.st[0] = nloc; b.st[1] = nx; }
        const unsigned old = xb_add(&bar[XB_XSUB(b.x)], 1u);
        const unsigned gen = old / nloc;
        if (old + 1u == (gen + 1u) * nloc) {
            __builtin_amdgcn_fence(__ATOMIC_RELEASE, "agent");
            asm volatile("s_waitcnt vmcnt(0)" ::: "memory");
            const unsigned og = xb_add(&bar[XB_TOP], 1u);
            const unsigned tg = og / nx;
            if (og + 1u == (tg + 1u) * nx) xb_add(&bar[XB_TOPGEN], 1u);
            else XB_SPIN(xb_ld(&bar[XB_TOPGEN]) == tg, bar);
            __builtin_amdgcn_fence(__ATOMIC_ACQUIRE, "agent");
            xb_add(&bar[XB_XGEN(b.x)], 1u);
            asm volatile("s_waitcnt vmcnt(0)" ::: "memory");
        } else {
            XB_SPIN(xb_ld(&bar[XB_XGEN(b.x)]) == gen, bar);
            __builtin_amdgcn_fence(__ATOMIC_ACQUIRE, "agent");
            asm volatile("s_waitcnt vmcnt(0)" ::: "memory");
        }
    }
    __syncthreads();
}

constexpr int NWAVES = 8;
constexpr size_t WS_CTL = 420 * MiB, CTL_ZERO_BYTES = 64 * 1024;
constexpr size_t WS_XCH = 421 * MiB;
constexpr size_t WS_PARTA = WS_XCH, WS_PARTB = WS_XCH + 1 * MiB, WS_CV = WS_XCH + 2 * MiB, WS_CPART = WS_CV + 256 * 1024;
constexpr int CV_IN1 = 0, CV_UP0 = 2 * 2576, CV_UP1 = CV_UP0 + 2 * 5632, CV_END = CV_UP1 + 2 * 5632;
constexpr int CP_IN1 = 0, CP_UP0 = 16 * 2 * 2576, CP_UP1 = CP_UP0 + 16 * 2 * 5632, CP_END = CP_UP1 + 16 * 2 * 5632;
static_assert(CV_END * 4 <= 256 * 1024 && WS_CPART + (size_t)CP_END * 4 <= WS_XCH + 4 * MiB, "deferred-LN map");
constexpr size_t WS_G0 = 425 * MiB;
constexpr size_t WS_UP0 = 447 * MiB;
constexpr size_t WS_WT = 458 * MiB;
constexpr size_t WT_IN = 0, WT_G = (size_t)2560 * 1024 * 2, WT_OUT = WT_G + 16 * 1024 * 2, WT_UP = WT_OUT + (size_t)1024 * 1024 * 2, WT_DN = WT_UP + (size_t)5632 * 1024 * 2, WT_LAYER = WT_DN + (size_t)1024 * 2816 * 2;
constexpr size_t WS_W8 = 302 * MiB, WS_SWC = 314 * MiB, WS_V8 = 320 * MiB, WS_SA = 353 * MiB;
constexpr size_t WS_MST = 289 * MiB;
static_assert(WS_WT + 2 * WT_LAYER <= 512 * MiB, "ws map");
constexpr int CW_TMO = 0, CW_CODE = 1, CW_BAR = 4096, CW_SEAM = 16384, SEAM_BANK = 128 * 64;
constexpr int MX_TAB = 131072 + 512;
constexpr int RING_OFF = 0, RING_BYTES = 131072, LDSCTL_OFF = RING_BYTES, MISC_OFF = LDSCTL_OFF + 320, LDS_BYTES = 163840;
constexpr int NPHASE = 18;

struct Frame {
    LAS unsigned char* lds; volatile LAS unsigned* MISC; gu32* ctl; unsigned char* ws; int tid, lane, wave, vcu, G;
};
constexpr int PT_OFF = LDSCTL_OFF + 64;
#define INP(i) inptr(F, (i))
__device__ __forceinline__ const float* inptr(const Frame& F, int i) {
    const volatile LAS unsigned* p = (const volatile LAS unsigned*)(F.lds + PT_OFF) + 2 * i;
    const unsigned lo = __builtin_amdgcn_readfirstlane(p[0]), hi = __builtin_amdgcn_readfirstlane(p[1]);
    return (const float*)(const GAS float*)(((unsigned long long)hi << 32) | lo);
}
struct Args { const float* in[20]; float* out; unsigned char* ws; int ph_lo, ph_hi, bar_region, pad; };

__device__ __forceinline__ unsigned pk2(float lo, float hi) { return f2bf(lo) | ((unsigned)f2bf(hi) << 16); }

__device__ __forceinline__ void p0_transpose_item(const float* W, int K, int N, bf16* WT, int k0, int n0, int drow0, LAS float* scr, int lane, const float* gs, const float* bs, float* cp1, float* cp0) {
    float tv[32];
#pragma unroll
    for (int i = 0; i < 32; ++i) { const int kk = 2 * i + (lane >> 5); tv[i] = W[(size_t)(k0 + kk) * N + n0 + (lane & 31)]; }
    if (gs) {
        float s1 = 0.f, s0 = 0.f;
#pragma unroll
        for (int i = 0; i < 32; ++i) { const int kk = 2 * i + (lane >> 5); const float gk = gs[k0 + kk], bk = bs[k0 + kk]; s0 = __builtin_fmaf(bk, tv[i], s0); tv[i] *= gk; s1 += tv[i]; }
        s1 += __shfl_xor(s1, 32); s0 += __shfl_xor(s0, 32);
        if (lane < 32) { cp1[n0 + lane] = s1; cp0[n0 + lane] = s0; }
    }
#pragma unroll
    for (int i = 0; i < 32; ++i) { const int kk = 2 * i + (lane >> 5); scr[kk * 33 + (lane & 31)] = tv[i]; }
    LDS_WAIT(); asm volatile("" ::: "memory");
    const int c = lane & 7;
#pragma unroll
    for (int j = 0; j < 4; ++j) { const int n = (lane >> 3) + 8 * j; const LAS float* s = scr + (8 * c) * 33 + n;
        v4u o; o.x = pk2(s[0 * 33], s[1 * 33]); o.y = pk2(s[2 * 33], s[3 * 33]); o.z = pk2(s[4 * 33], s[5 * 33]); o.w = pk2(s[6 * 33], s[7 * 33]);
        *(GAS v4u*)(WT + (size_t)(drow0 + n) * K + k0 + 8 * c) = o; }
    LDS_WAIT(); asm volatile("" ::: "memory");
}

__device__ __forceinline__ void p0_prologue(Frame& F, const Args& a) {
    LAS float* scr = (LAS float*)(F.lds + RING_OFF + F.wave * 16384);
    const int gw = F.vcu * NWAVES + F.wave, NGW = F.G * NWAVES;
    constexpr int I_IN = 16 * 80, I_OUT = 16 * 32, I_UP = 16 * 176, I_DN = 44 * 32, I_LAYER = I_IN + I_OUT + I_UP + I_DN;
    for (int it = gw; it < DEPTH * I_LAYER; it += NGW) {
        const int l = it / I_LAYER; int r = it % I_LAYER; unsigned char* wt = F.ws + WS_WT + (size_t)l * WT_LAYER;
        float* cpart = (float*)(F.ws + WS_CPART);
        if (r < I_IN) { const int kb = r / 80, nb = r % 80; const bool sc = l > 0;
            p0_transpose_item(INP(1) + (size_t)l * DM * DIN, DM, DIN, (bf16*)(wt + WT_IN), 64 * kb, 32 * nb, 32 * nb, scr, F.lane, sc ? INP(18) + (l - 1) * DM : nullptr, sc ? INP(19) + (l - 1) * DM : nullptr,
                              cpart + CP_IN1 + kb * 2 * 2576, cpart + CP_IN1 + kb * 2 * 2576 + 2576); continue; } r -= I_IN;
        if (r < I_OUT) { const int kb = r / 32, nb = r % 32; p0_transpose_item(INP(11) + (size_t)l * DM * DM, DM, DM, (bf16*)(wt + WT_OUT), 64 * kb, 32 * nb, 32 * nb, scr, F.lane, nullptr, nullptr, nullptr, nullptr); continue; } r -= I_OUT;
        if (r < I_UP) { const int kb = r / 176, nb = r % 176, n0 = 32 * nb; const int isup = n0 >= DFF, c = isup ? n0 - DFF : n0; const int drow = (c >> 7) * 256 + isup * 128 + (c & 127);
            float* cp = cpart + (l == 0 ? CP_UP0 : CP_UP1) + kb * 2 * 5632;
            p0_transpose_item(INP(14) + (size_t)l * DM * 2 * DFF, DM, 2 * DFF, (bf16*)(wt + WT_UP), 64 * kb, n0, drow, scr, F.lane, INP(12) + l * DM, INP(13) + l * DM, cp, cp + 5632); continue; } r -= I_UP;
        { const int kb = r / 32, nb = r % 32; p0_transpose_item(INP(17) + (size_t)l * DFF * DM, DFF, DM, (bf16*)(wt + WT_DN), 64 * kb, 32 * nb, 32 * nb, scr, F.lane, nullptr, nullptr, nullptr, nullptr); }
    }
    for (int i = gw * 64 + F.lane; i < DEPTH * 16 * DM; i += NGW * 64) { const int l = i / (16 * DM), j = (i / DM) % 16, k = i % DM;
        float v = j < 8 ? INP(1)[(size_t)l * DM * DIN + (size_t)k * DIN + ZW + j] : 0.f; if (l > 0) v *= INP(18)[(l - 1) * DM + k];
        ((bf16*)(F.ws + WS_WT + (size_t)l * WT_LAYER + WT_G))[j * DM + k] = f2bf(v); }
    for (int j = gw; j < 8; j += NGW) { float s1 = 0.f, s0 = 0.f;
        for (int k = F.lane; k < DM; k += 64) { const float wv = INP(1)[(size_t)1 * DM * DIN + (size_t)k * DIN + ZW + j]; s1 = __builtin_fmaf(INP(18)[k], wv, s1); s0 = __builtin_fmaf(INP(19)[k], wv, s0); }
#pragma unroll
        for (int o = 1; o < 64; o <<= 1) { s1 += __shfl_xor(s1, o); s0 += __shfl_xor(s0, o); }
        if (F.lane == 0) { float* cv = (float*)(F.ws + WS_CV); cv[CV_IN1 + ZW + j] = s1; cv[CV_IN1 + 2576 + ZW + j] = s0; } }
    const float* x = INP(0); bf16* XN = (bf16*)(F.ws + WS_XN);
    for (size_t i0 = (size_t)gw * 64 + F.lane; i0 < (size_t)M * DM / 8; i0 += (size_t)NGW * 64 * 4) {
        f32x4 v0[4], v1[4];
#pragma unroll
        for (int q = 0; q < 4; ++q) { const size_t i = i0 + (size_t)q * NGW * 64; v0[q] = *(const GAS f32x4*)(x + i * 8); v1[q] = *(const GAS f32x4*)(x + i * 8 + 4); }
#pragma unroll
        for (int q = 0; q < 4; ++q) { const size_t i = i0 + (size_t)q * NGW * 64;
            v4u o; o.x = pk2(v0[q][0], v0[q][1]); o.y = pk2(v0[q][2], v0[q][3]); o.z = pk2(v1[q][0], v1[q][1]); o.w = pk2(v1[q][2], v1[q][3]);
            *(GAS v4u*)(XN + i * 8) = o; } }
}

__device__ __forceinline__ void cvec_finalize(Frame& F, const Args& a) {
    const float* cp = (const float*)(F.ws + WS_CPART); float* cv = (float*)(F.ws + WS_CV);
    const int gt = (F.vcu * NWAVES + F.wave) * 64 + F.lane, NT = F.G * NWAVES * 64;
    for (int i = gt; i < 2 * ZW + 4 * 5632; i += NT) {
        int src, dst, stride, idx = i;
        if (idx < 2 * ZW) { const int v = idx / ZW, n = idx % ZW; src = CP_IN1 + v * 2576 + n; dst = CV_IN1 + v * 2576 + n; stride = 2 * 2576; }
        else { idx -= 2 * ZW; const int m = idx / (2 * 5632), e = idx % (2 * 5632); src = (m ? CP_UP1 : CP_UP0) + e; dst = (m ? CV_UP1 : CV_UP0) + e; stride = 2 * 5632; }
        float sacc = 0.f;
#pragma unroll
        for (int kb = 0; kb < 16; ++kb) sacc += cp[src + kb * stride];
        cv[dst] = sacc; }
}
__device__ __forceinline__ float wave_max(float x) {
#pragma unroll
    for (int o = 32; o > 0; o >>= 1) x = fmaxf(x, __shfl_xor(x, o)); return x; }
__device__ __forceinline__ float wave_fsum(float x) {
#pragma unroll
    for (int o = 32; o > 0; o >>= 1) x += __shfl_xor(x, o); return x; }
__device__ __forceinline__ int wave_isum(int x) {
#pragma unroll
    for (int o = 32; o > 0; o >>= 1) x += __shfl_xor(x, o); return x; }
__device__ __forceinline__ void quant_unpack(const v4u a, const v4u b, float (&x)[16]) {
#pragma unroll
    for (int e = 0; e < 4; ++e) { x[2 * e] = __uint_as_float(a[e] << 16); x[2 * e + 1] = __uint_as_float(a[e] & 0xffff0000u); x[8 + 2 * e] = __uint_as_float(b[e] << 16); x[8 + 2 * e + 1] = __uint_as_float(b[e] & 0xffff0000u); }
}
__device__ __forceinline__ float quant_row16(const float (&x)[16], unsigned (&q8)[4], int& isum) {
    float am = 0.f;
#pragma unroll
    for (int e = 0; e < 16; ++e) am = fmaxf(am, fabsf(x[e]));
    am = wave_max(am);
    const float inv = am > 0.f ? 127.0f / am : 0.f;
    isum = 0;
#pragma unroll
    for (int j = 0; j < 4; ++j) { unsigned w = 0u;
#pragma unroll
        for (int e = 0; e < 4; ++e) { const int q = (int)__builtin_rintf(x[4 * j + e] * inv); isum += q; w |= ((unsigned)q & 0xffu) << (8 * e); }
        q8[j] = w; }
    return am * (1.0f / 127.0f);
}
typedef unsigned v2u __attribute__((ext_vector_type(2)));
__device__ __forceinline__ void quant_w_step(Frame& F) {
    const int gw = F.vcu * NWAVES + F.wave, NGW = F.G * NWAVES, lane = F.lane;
    for (int rr = gw; rr < DEPTH * 2 * DFF; rr += NGW) {
        const int l = rr / (2 * DFF), n = rr % (2 * DFF);
        const bf16* src = (const bf16*)(F.ws + WS_WT + (size_t)l * WT_LAYER + WT_UP) + (size_t)n * DM;
        const v4u a = *(const GAS v4u*)(src + 8 * lane), b = *(const GAS v4u*)(src + 512 + 8 * lane);
        float x[16]; quant_unpack(a, b, x);
        unsigned q8[4]; int isum; const float sc = quant_row16(x, q8, isum);
        isum = wave_isum(isum);
        unsigned char* dst = F.ws + WS_W8 + ((size_t)l * 2 * DFF + n) * DM;
        *(GAS v2u*)(dst + 8 * lane) = (v2u){q8[0], q8[1]}; *(GAS v2u*)(dst + 512 + 8 * lane) = (v2u){q8[2], q8[3]};
        if (lane == 0) { float* swc = (float*)(F.ws + WS_SWC) + (size_t)l * 4 * DFF; const int idx = ((n & 255) >= 128 ? DFF : 0) + 128 * (n >> 8) + (n & 127);
            swc[idx] = sc; swc[2 * DFF + idx] = sc * (float)isum; }
    }
}
__device__ __forceinline__ void quant_a_phase(Frame& F, const bf16* V) {
    const int gw = F.vcu * NWAVES + F.wave, NGW = F.G * NWAVES, lane = F.lane;
    unsigned char* V8 = F.ws + WS_V8; float* SA = (float*)(F.ws + WS_SA);
    for (int m0 = gw * 4; m0 < M; m0 += NGW * 4) {
        v4u a[4], b[4];
#pragma unroll
        for (int q = 0; q < 4; ++q) { const bf16* src = V + (size_t)(m0 + q) * DM; a[q] = *(const GAS v4u*)(src + 8 * lane); b[q] = *(const GAS v4u*)(src + 512 + 8 * lane); }
#pragma unroll
        for (int q = 0; q < 4; ++q) { float x[16]; quant_unpack(a[q], b[q], x);
            float sm = 0.f;
#pragma unroll
            for (int e = 0; e < 16; ++e) sm += x[e];
            const float mean = wave_fsum(sm) * (1.0f / DM); float sq = 0.f;
#pragma unroll
            for (int e = 0; e < 16; ++e) { x[e] -= mean; sq = __builtin_fmaf(x[e], x[e], sq); }
            const float rstd = rsqrtf(wave_fsum(sq) * (1.0f / DM) + LN_EPS);
#pragma unroll
            for (int e = 0; e < 16; ++e) x[e] *= rstd;
            unsigned q8[4]; int isum; const float sc = quant_row16(x, q8, isum);
            unsigned char* dst = V8 + (size_t)(m0 + q) * DM;
            *(GAS v2u*)(dst + 8 * lane) = (v2u){q8[0], q8[1]}; *(GAS v2u*)(dst + 512 + 8 * lane) = (v2u){q8[2], q8[3]};
            if (lane == 0) SA[m0 + q] = sc; }
    }
}
__device__ __forceinline__ void gates_phase(Frame& F, const bf16* XN, const bf16* WG, float* GT, const float* part, const float* c1, const float* c0) {
    const int gw = F.vcu * NWAVES + F.wave, NGW = F.G * NWAVES, l15 = F.lane & 15, lq = F.lane >> 4;
    for (int blk = gw; blk < M / 16; blk += NGW) {
        const bf16* ap = XN + (size_t)(blk * 16 + l15) * DM + 8 * lq; const bf16* bp = WG + (size_t)l15 * DM + 8 * lq;
        f32x4 acc = (f32x4){0.f, 0.f, 0.f, 0.f};
#pragma unroll 16
        for (int ks = 0; ks < DM / 32; ++ks) { const bf16x8 av = *(const GAS bf16x8*)(ap + ks * 32), bv = *(const GAS bf16x8*)(bp + ks * 32);
            acc = __builtin_amdgcn_mfma_f32_16x16x32_bf16(av, bv, acc, 0, 0, 0); }
        if (l15 < 8) {
            float k1 = 0.f, k0 = 0.f; if (part) { k1 = c1[l15]; k0 = c0[l15]; }
#pragma unroll
            for (int r = 0; r < 4; ++r) { const size_t row = (size_t)(blk * 16 + 4 * lq + r); float v = acc[r];
                if (part) { const pg8::RowStat rs = pg8::row_stat(part, row, LN_EPS); v = v * rs.r + (k1 * rs.nmr + k0); }
                GT[row * 8 + l15] = v; } }
    }
}

__device__ __forceinline__ void glu_fixup_phase(Frame& F, const float* G0, const float* UP0, const float* cw, const float* cb, bf16* H) {
    const int gt = (F.vcu * NWAVES + F.wave) * 64 + F.lane, NT = F.G * NWAVES * 64;
    constexpr int C4 = DFF / 4, NIT = (M / 64) * 2 * C4;
    for (int i0 = gt; i0 < NIT; i0 += 2 * NT) {
        f32x4 s0[2], s1[2], s2[2], up[2], w0[2], w1[2], w2[2], bb[2]; int rr[2], gg[2], cc[2]; bool ok[2];
#pragma unroll
        for (int q = 0; q < 2; ++q) { const int i = i0 + q * NT; ok[q] = i < NIT; const int ii = ok[q] ? i : gt;
            const int c = (ii % C4) * 4, r = (ii / C4) & 1, grp = ii / (2 * C4); rr[q] = r; gg[q] = grp; cc[q] = c;
            const float* gp = G0 + ((size_t)grp * 4 + r) * DFF + c;
            s0[q] = *(const GAS f32x4*)gp; s1[q] = *(const GAS f32x4*)(gp + DFF); s2[q] = *(const GAS f32x4*)(gp + 2 * DFF);
            up[q] = *(const GAS f32x4*)(UP0 + ((size_t)grp * 2 + r) * DFF + c);
            w0[q] = *(const GAS f32x4*)(cw + c); w1[q] = *(const GAS f32x4*)(cw + DFF + c); w2[q] = *(const GAS f32x4*)(cw + 2 * DFF + c); bb[q] = *(const GAS f32x4*)(cb + c); }
#pragma unroll
        for (int q = 0; q < 2; ++q) { if (!ok[q]) continue;
            const bool bs = (gg[q] & (SEQ / 64 - 1)) == 0;
            const f32x4 z = (f32x4){0.f, 0.f, 0.f, 0.f}; const f32x4 a0 = bs ? z : s0[q], a1 = (bs && rr[q] == 0) ? z : s1[q];
            const f32x4 cv = bb[q] + w0[q] * a0 + w1[q] * a1 + w2[q] * s2[q];
            const pg8::f32x2 ha = pg8::gelu_mul_pk((pg8::f32x2){cv[0], cv[1]}, (pg8::f32x2){up[q][0], up[q][1]}), hb = pg8::gelu_mul_pk((pg8::f32x2){cv[2], cv[3]}, (pg8::f32x2){up[q][2], up[q][3]});
            unsigned long long o = (unsigned long long)pg8::cvt_pk_bf16(ha.x, ha.y) | ((unsigned long long)pg8::cvt_pk_bf16(hb.x, hb.y) << 32);
            *(GAS unsigned long long*)(H + (size_t)(gg[q] * 64 + rr[q]) * DFF + cc[q]) = o; }
    }
}

struct SameTileOrder {
    int n, pm0, pn0;
    __device__ bool next(int i, pg8::Unit& u) const { if (i >= n) return false; u.pm = pm0; u.pn = pn0; return true; }
    __device__ __forceinline__ void a_ready(const pg8::Unit&) const {}
    __device__ __forceinline__ void done(const pg8::Unit&) const {}
};
struct OneUnit {
    int pm, pn;
    __device__ bool next(int i, pg8::Unit& u) const { if (i != 0) return false; u.pm = pm; u.pn = pn; return true; }
    __device__ __forceinline__ void a_ready(const pg8::Unit&) const {}
    __device__ __forceinline__ void done(const pg8::Unit&) const {}
};

__device__ __forceinline__ void res_gemm_phase(Frame& F, const bf16* A, const bf16* Bt, int K, bf16* V, bf16* Vout, const float* part_prev, const float* gp, const float* bp, float* part_new) {
    pg8::Gemm gm{A, Bt, M, DM, K}; pg8::StaticOrder S; S.init(M, DM, F.G, (int)blockIdx.x);
    pg8::EpiRes E{V, Vout, DM, part_prev, gp, bp, part_new, F.lds + MX_TAB};
    pg8::gemm_phase<pg8::EpiRes, pg8::StaticOrder, true, true>(F.lds + RING_OFF, gm, S, E, F.tid);
}
__device__ __forceinline__ void final_ln_phase(Frame& F, const bf16* V, const float* part, const float* g, const float* b, float* out) {
    const int gw = F.vcu * NWAVES + F.wave, NGW = F.G * NWAVES;
    f32x4 gv[4], bv[4];
#pragma unroll
    for (int j = 0; j < 4; ++j) { gv[j] = *(const GAS f32x4*)(g + 256 * j + 4 * F.lane); bv[j] = *(const GAS f32x4*)(b + 256 * j + 4 * F.lane); }
    for (int m0 = gw * 4; m0 < M; m0 += NGW * 4) {
        unsigned long long w[4][4]; pg8::RowStat rs[4];
#pragma unroll
        for (int q = 0; q < 4; ++q) { rs[q] = pg8::row_stat(part, (size_t)(m0 + q), LN_EPS);
#pragma unroll
            for (int j = 0; j < 4; ++j) w[q][j] = *(const GAS unsigned long long*)(V + (size_t)(m0 + q) * DM + 256 * j + 4 * F.lane); }
#pragma unroll
        for (int q = 0; q < 4; ++q)
#pragma unroll
            for (int j = 0; j < 4; ++j) { const unsigned lo = (unsigned)w[q][j], hi = (unsigned)(w[q][j] >> 32);
                f32x4 x = (f32x4){__uint_as_float(lo << 16), __uint_as_float(lo & 0xffff0000u), __uint_as_float(hi << 16), __uint_as_float(hi & 0xffff0000u)};
                x = (x * rs[q].r + rs[q].nmr) * gv[j] + bv[j];
                __builtin_nontemporal_store(x, (GAS f32x4*)(out + (size_t)(m0 + q) * DM + 256 * j + 4 * F.lane)); }
    }
}
constexpr int MX_RAWQK = 0, MX_RAWV = 18496, MX_HS = 0, MX_QS = 35904, MX_KS = 45120, MX_QP = 54336, MX_SS = 63552, MX_KWT = 72768, MX_VST = 81984, MX_CST = 102720, MX_CWB = 123456, MX_DEN = 126016;
constexpr int MX_GA = LDSCTL_OFF + 512;
constexpr int ST_FLOATS = 64 * 144 + 64;
typedef short s16x4v __attribute__((ext_vector_type(4)));

__device__ __forceinline__ float fexp(float x) { return __expf(x); }
__device__ __forceinline__ unsigned pkbf(float lo, float hi) { return pg8::cvt_pk_bf16(lo, hi); }
#define MX_DPPF(x, ctrl) __builtin_bit_cast(float, __builtin_amdgcn_update_dpp(0, __builtin_bit_cast(int, (float)(x)), (ctrl), 0xf, 0xf, true))
__device__ __forceinline__ float row_sum16(float x) {
    x += MX_DPPF(x, 0xB1); x += MX_DPPF(x, 0x4E); x += MX_DPPF(x, 0x141); x += MX_DPPF(x, 0x140); return x;
}
#define MX_LDS_FENCE() asm volatile("s_waitcnt lgkmcnt(0)" ::: "memory")

template <bool OUT>
__device__ __forceinline__ void mlstm_phase(Frame& F, const Args& args, int l) {
    const int tid = F.tid, lane = F.lane, w = F.wave, l15 = lane & 15, lq = lane >> 4;
    unsigned char* ws = F.ws;
    const bf16* Z = (const bf16*)(ws + WS_Z); const float* GT = (const float*)(ws + WS_GT); bf16* Y = (bf16*)(ws + WS_Y); float* ST = (float*)(ws + WS_MST);
    const int u = F.vcu, b = u >> 6, h = (u >> 4) & 3, seg = u & 15;
    const size_t gr_seg = (size_t)b * SEQ + (size_t)seg * 512;
    LAS unsigned char* L = F.lds;
    LAS float* gA = (LAS float*)(L + MX_GA); LAS float* gMX = gA + 512; LAS float* gFL = gA + 1024; LAS float* gBend = gA + 1536; LAS float* gAmax = gA + 1544; LAS float* gMP = gA + 1552; LAS float* gMXE = gA + 1560;
    LAS float* cwb = (LAS float*)(L + MX_CWB);
    const float* qcw = INP(4) + (size_t)l * 4 * 512; const float* qcb = INP(5) + l * 512;
    for (int i = tid; i < 640; i += 512) { const int j = i >> 7, c = i & 127; const int ch = (c < 64) ? (64 * h + c) : (256 + 64 * h + c - 64);
        cwb[i] = (j < 4) ? qcw[j * 512 + ch] : qcb[ch]; }
    for (int i = tid; i < 16 * 72; i += 512) { const int r = i / 72, c = i % 72; ((LAS bf16*)(L + MX_VST))[(128 + r) * 72 + c] = (r == 0 && c < 64) ? (bf16)0x3F80 : (bf16)0; }
    for (int i = tid; i < 144 * 72 / 2; i += 512) ((LAS unsigned*)(L + MX_CST))[i] = 0u;
    float bpos, apos, cmax;
    {
        const size_t t = gr_seg + 64 * w + lane; const float bi = INP(2)[l * 4 + h], bfg = INP(3)[l * 4 + h];
        const float ig = GT[t * 8 + h] + bi, lf = logsigmoid_f(GT[t * 8 + 4 + h] + bfg);
        float s = lf;
#pragma unroll
        for (int o = 1; o < 64; o <<= 1) { const float v = __shfl_up(s, o); if (lane >= o) s += v; }
        bpos = s; apos = ig - s; float c = apos;
#pragma unroll
        for (int o = 1; o < 64; o <<= 1) { const float v = __shfl_up(c, o); if (lane >= o) c = fmaxf(c, v); }
        cmax = c;
        gA[64 * w + lane] = apos;
        if (lane == 63) { gBend[w] = bpos; gAmax[w] = cmax; }
    }
    __syncthreads();
    float m_init = -INFINITY; asm volatile("" : "+v"(m_init));
    f32x4 cacc[4], nacc;
#pragma unroll
    for (int i = 0; i < 4; ++i) cacc[i] = (f32x4){0.f, 0.f, 0.f, 0.f};
    nacc = (f32x4){0.f, 0.f, 0.f, 0.f};
    if (OUT) {
        float ml_l = -INFINITY, bs_l = 0.f;
        if (lane < seg) { const float* sp_ = ST + (size_t)(u - seg + lane) * ST_FLOATS + 64 * 144; ml_l = sp_[0]; bs_l = sp_[1]; }
        float m_run = 0.f;
        for (int sp = 0; sp < seg; ++sp) m_run = fmaxf(__shfl(bs_l, sp) + m_run, __shfl(ml_l, sp));
        float pre = bs_l;
#pragma unroll
        for (int o = 1; o < 16; o <<= 1) { const float v = __shfl_up(pre, o); if (lane >= o) pre += v; }
        const float tot = __shfl(pre, 15);
        const float wgt_l = (lane < seg) ? fexp(ml_l + (tot - pre) - m_run) : 0.f;
#pragma unroll 1
        for (int sp0 = 0; sp0 < seg; sp0 += 3) {
            float v[3][16], vn[3][4], wj[3];
#pragma unroll
            for (int j = 0; j < 3; ++j) { const int sp = (sp0 + j < seg) ? sp0 + j : seg - 1; const float* st = ST + (size_t)(u - seg + sp) * ST_FLOATS;
                wj[j] = (sp0 + j < seg) ? __shfl(wgt_l, sp) : 0.f;
#pragma unroll
                for (int mt = 0; mt < 4; ++mt)
#pragma unroll
                    for (int r = 0; r < 4; ++r) v[j][4 * mt + r] = st[(16 * mt + 4 * lq + r) * 144 + 16 * w + l15];
#pragma unroll
                for (int r = 0; r < 4; ++r) vn[j][r] = (w < 4) ? st[(16 * w + 4 * lq + r) * 144 + 128 + l15] : 0.f; }
#pragma unroll
            for (int j = 0; j < 3; ++j) {
#pragma unroll
                for (int mt = 0; mt < 4; ++mt)
#pragma unroll
                    for (int r = 0; r < 4; ++r) cacc[mt][r] += wj[j] * v[j][4 * mt + r];
#pragma unroll
                for (int r = 0; r < 4; ++r) nacc[r] += wj[j] * vn[j][r]; }
        }
        m_init = m_run;
    }
    { float mp = m_init, mpw = m_init;
#pragma unroll
      for (int n = 0; n < 8; ++n) { const float mxe = fmaxf(mp, gAmax[n]); if (tid == 0) { gMP[n] = mp; gMXE[n] = mxe; } mpw = (w == n) ? mp : mpw; mp = gBend[n] + mxe; }
      if (!OUT) { if (tid == 0) { float bsum = 0.f;
#pragma unroll
            for (int n = 0; n < 8; ++n) bsum += gBend[n];
            ST[(size_t)u * ST_FLOATS + 64 * 144] = mp; ST[(size_t)u * ST_FLOATS + 64 * 144 + 1] = bsum; } }
      if (OUT) {
        const float mx = fmaxf(cmax, mpw); gMX[64 * w + lane] = mx; gFL[64 * w + lane] = fexp(-(bpos + mx));
#pragma unroll
        for (int mt = 0; mt < 4; ++mt) { unsigned long long v = (unsigned long long)pkbf(cacc[mt][0], cacc[mt][1]) | ((unsigned long long)pkbf(cacc[mt][2], cacc[mt][3]) << 32);
            *(LAS unsigned long long*)(L + MX_CST + ((16 * w + l15) * 72 + 16 * mt + 4 * lq) * 2) = v; }
        if (w < 4) { unsigned long long v = (unsigned long long)pkbf(nacc[0], nacc[1]) | ((unsigned long long)pkbf(nacc[2], nacc[3]) << 32);
            *(LAS unsigned long long*)(L + MX_CST + ((128 + l15) * 72 + 16 * w + 4 * lq) * 2) = v; }
      } }
    float gain[8];
    if (OUT) {
#pragma unroll
        for (int e = 0; e < 8; ++e) gain[e] = INP(10)[l * 512 + h * 128 + 8 * (tid & 15) + e]; }
    v4u rq[2][3], rv[2][2], ro[2];
#define MX_LOAD_RAW(n_, ps_) do { \
        const size_t gr0 = gr_seg + 64 * (n_); const int tc = seg * 512 + 64 * (n_); \
        _Pragma("unroll") \
        for (int k = 0; k < 3; ++k) { const int p = tid + 512 * k; const int r = p >> 4, c = p & 15; v4u v = (v4u){0u, 0u, 0u, 0u}; \
            if (p < 67 * 16 && tc - 3 + r >= 0) v = *(const GAS v4u*)(Z + (gr0 + r - 3) * ZW + (c < 8 ? 1024 + 64 * h + 8 * c : 1280 + 64 * h + 8 * (c - 8))); \
            rq[ps_][k] = v; } \
        _Pragma("unroll") \
        for (int k = 0; k < 2; ++k) { const int p = tid + 512 * k; const int r = p >> 4, c = p & 15; \
            rv[ps_][k] = *(const GAS v4u*)(Z + (gr0 + r) * ZW + 1536 + 128 * h + 8 * c); \
            } \
    } while (0)
#define MX_LOAD_O(n_) do { _Pragma("unroll") for (int k = 0; k < 2; ++k) { const int p = tid + 512 * k; ro[k] = *(const GAS v4u*)(Z + (gr_seg + 64 * (n_) + (p >> 4)) * ZW + 2048 + 128 * h + 8 * (p & 15)); } } while (0)
    MX_LOAD_RAW(0, 0); MX_LOAD_RAW(1, 1);
    if (OUT) MX_LOAD_O(0);
    __syncthreads();
#pragma unroll 1
    for (int n2 = 0; n2 < 8; n2 += 2) {
#pragma unroll
    for (int par = 0; par < 2; ++par) { const int n = n2 + par;
        int tid_ = F.tid; asm volatile("" : "+v"(tid_));
        const int tid = tid_, lane = tid & 63, l15 = lane & 15, lq = lane >> 4;
#pragma unroll
        for (int k = 0; k < 3; ++k) { const int p = tid + 512 * k; if (p < 67 * 16) *(LAS v4u*)(L + MX_RAWQK + (p >> 4) * 272 + (p & 15) * 16) = rq[par][k]; }
#pragma unroll
        for (int k = 0; k < 2; ++k) { const int p = tid + 512 * k; *(LAS v4u*)(L + MX_RAWV + (p >> 4) * 272 + (p & 15) * 16) = rv[par][k]; }
        __syncthreads();
        if (n + 2 < 8) MX_LOAD_RAW(n + 2, par);
        {
            const int s = lane;
            const float mxe = gMXE[n], mpv = gMP[n], a_s = gA[64 * n + s]; float mxs = 0.f; if (OUT) mxs = gMX[64 * n + s];
            v4u rvv[2];
#pragma unroll
            for (int cc = 0; cc < 2; ++cc) rvv[cc] = *(const LAS v4u*)(L + MX_RAWV + s * 272 + (2 * w + cc) * 16);
#pragma unroll
            for (int qk = (OUT ? 0 : 1); qk < 2; ++qk) {
                const int cb0 = 64 * qk + 8 * w;
                v4u rw[4]; f32x4 cw4[5][2];
#pragma unroll
                for (int j = 0; j < 4; ++j) rw[j] = *(const LAS v4u*)(L + MX_RAWQK + (s + j) * 272 + cb0 * 2);
#pragma unroll
                for (int j = 0; j < 5; ++j) { cw4[j][0] = *(const LAS f32x4*)(cwb + j * 128 + cb0); cw4[j][1] = *(const LAS f32x4*)(cwb + j * 128 + cb0 + 4); }
                MX_LDS_FENCE();
                float acc[8];
#pragma unroll
                for (int e = 0; e < 8; ++e) acc[e] = cw4[4][e >> 2][e & 3];
#pragma unroll
                for (int j = 0; j < 4; ++j)
#pragma unroll
                    for (int e2 = 0; e2 < 4; ++e2) { const unsigned x = rw[j][e2];
                        acc[2 * e2] = __builtin_fmaf(cw4[j][(2 * e2) >> 2][(2 * e2) & 3], __uint_as_float(x << 16), acc[2 * e2]);
                        acc[2 * e2 + 1] = __builtin_fmaf(cw4[j][(2 * e2 + 1) >> 2][(2 * e2 + 1) & 3], __uint_as_float(x & 0xffff0000u), acc[2 * e2 + 1]); }
#pragma unroll
                for (int e = 0; e < 8; ++e) acc[e] = acc[e] * __builtin_amdgcn_rcpf(1.0f + fexp(-acc[e]));
                if (qk == 0) {
                    const float wi = fexp(mpv - mxs);
                    v4u o; o.x = pkbf(acc[0], acc[1]); o.y = pkbf(acc[2], acc[3]); o.z = pkbf(acc[4], acc[5]); o.w = pkbf(acc[6], acc[7]);
                    *(LAS v4u*)(L + MX_QS + (s * 72 + 8 * w) * 2) = o;
                    v4u p; p.x = pkbf(acc[0] * wi, acc[1] * wi); p.y = pkbf(acc[2] * wi, acc[3] * wi); p.z = pkbf(acc[4] * wi, acc[5] * wi); p.w = pkbf(acc[6] * wi, acc[7] * wi);
                    *(LAS v4u*)(L + MX_QP + (s * 72 + 8 * w) * 2) = p;
                } else {
                    const float kwt = 0.125f * fexp(a_s - mxe);
                    if (OUT) { v4u o; o.x = pkbf(acc[0] * 0.125f, acc[1] * 0.125f); o.y = pkbf(acc[2] * 0.125f, acc[3] * 0.125f); o.z = pkbf(acc[4] * 0.125f, acc[5] * 0.125f); o.w = pkbf(acc[6] * 0.125f, acc[7] * 0.125f);
                        *(LAS v4u*)(L + MX_KS + (s * 72 + 8 * w) * 2) = o; }
#pragma unroll
                    for (int e2 = 0; e2 < 4; ++e2) { const unsigned pk = pkbf(acc[2 * e2] * kwt, acc[2 * e2 + 1] * kwt);
                        ((LAS bf16*)(L + MX_KWT))[(8 * w + 2 * e2) * 72 + s] = (bf16)(pk & 0xffffu); ((LAS bf16*)(L + MX_KWT))[(8 * w + 2 * e2 + 1) * 72 + s] = (bf16)(pk >> 16); }
                }
            }
#pragma unroll
            for (int cc = 0; cc < 2; ++cc) { const int c = 2 * w + cc; const v4u rw = rvv[cc];
#pragma unroll
                for (int e2 = 0; e2 < 4; ++e2) { ((LAS bf16*)(L + MX_VST))[(8 * c + 2 * e2) * 72 + s] = (bf16)(rw[e2] & 0xffffu); ((LAS bf16*)(L + MX_VST))[(8 * c + 2 * e2 + 1) * 72 + s] = (bf16)(rw[e2] >> 16); } }
        }
        __syncthreads();
        if (OUT) {
            const int mt = w >> 1;
#pragma unroll
            for (int ni = 0; ni < 2; ++ni) { const int nt = 2 * (w & 1) + ni; f32x4 sa = (f32x4){0.f, 0.f, 0.f, 0.f};
#pragma unroll
                for (int ks = 0; ks < 2; ++ks) { const bf16x8 av = *(const LAS bf16x8*)(L + MX_QS + ((16 * mt + l15) * 72 + 32 * ks + 8 * lq) * 2), bv = *(const LAS bf16x8*)(L + MX_KS + ((16 * nt + l15) * 72 + 32 * ks + 8 * lq) * 2);
                    sa = __builtin_amdgcn_mfma_f32_16x16x32_bf16(av, bv, sa, 0, 0, 0); }
                const int s = 16 * nt + l15; const float a_s = gA[64 * n + s]; const f32x4 mx4 = *(const LAS f32x4*)(gMX + 64 * n + 16 * mt + 4 * lq);
                float sw[4];
#pragma unroll
                for (int r = 0; r < 4; ++r) { const int t = 16 * mt + 4 * lq + r; sw[r] = (s <= t) ? sa[r] * fexp(a_s - mx4[r]) : 0.f; }
                const unsigned p01 = pkbf(sw[0], sw[1]), p23 = pkbf(sw[2], sw[3]); const int t0 = 16 * mt + 4 * lq;
                ((LAS bf16*)(L + MX_SS))[(t0 + 0) * 72 + s] = (bf16)(p01 & 0xffffu); ((LAS bf16*)(L + MX_SS))[(t0 + 1) * 72 + s] = (bf16)(p01 >> 16);
                ((LAS bf16*)(L + MX_SS))[(t0 + 2) * 72 + s] = (bf16)(p23 & 0xffffu); ((LAS bf16*)(L + MX_SS))[(t0 + 3) * 72 + s] = (bf16)(p23 >> 16); }
            __syncthreads();
            f32x4 na[4], da = (f32x4){0.f, 0.f, 0.f, 0.f};
#pragma unroll
            for (int i = 0; i < 4; ++i) na[i] = (f32x4){0.f, 0.f, 0.f, 0.f};
#pragma unroll
            for (int ks = 0; ks < 4; ++ks) {
                const int aoff = (ks < 2 ? MX_SS : MX_QP) + ((16 * mt + l15) * 72 + 32 * (ks & 1) + 8 * lq) * 2, bbase = (ks < 2 ? MX_VST : MX_CST) + (32 * (ks & 1) + 8 * lq) * 2;
                const bf16x8 av = *(const LAS bf16x8*)(L + aoff);
#pragma unroll
                for (int i = 0; i < 4; ++i) { const int nt = 4 * (w & 1) + i; const bf16x8 bv = *(const LAS bf16x8*)(L + bbase + (16 * nt + l15) * 144);
                    na[i] = __builtin_amdgcn_mfma_f32_16x16x32_bf16(av, bv, na[i], 0, 0, 0); }
                if ((w & 1) == 0) { const bf16x8 bv = *(const LAS bf16x8*)(L + bbase + (128 + l15) * 144); da = __builtin_amdgcn_mfma_f32_16x16x32_bf16(av, bv, da, 0, 0, 0); }
            }
#pragma unroll
            for (int i = 0; i < 4; ++i) { const int nt = 4 * (w & 1) + i;
#pragma unroll
                for (int r = 0; r < 4; ++r) ((LAS float*)(L + MX_HS))[(16 * mt + 4 * lq + r) * 132 + 16 * nt + l15] = na[i][r]; }
            if ((w & 1) == 0 && l15 == 0) {
#pragma unroll
                for (int r = 0; r < 4; ++r) ((LAS float*)(L + MX_DEN))[16 * mt + 4 * lq + r] = da[r]; }
        }
        {
            const float dec = fexp(gMP[n] - gMXE[n]);
#pragma unroll
            for (int mt2 = 0; mt2 < 4; ++mt2) cacc[mt2] = cacc[mt2] * dec;
            nacc = nacc * dec;
#pragma unroll
            for (int ks = 0; ks < 2; ++ks) { const bf16x8 bv = *(const LAS bf16x8*)(L + MX_VST + ((16 * w + l15) * 72 + 32 * ks + 8 * lq) * 2);
#pragma unroll
                for (int mt2 = 0; mt2 < 4; ++mt2) { const bf16x8 av = *(const LAS bf16x8*)(L + MX_KWT + ((16 * mt2 + l15) * 72 + 32 * ks + 8 * lq) * 2);
                    cacc[mt2] = __builtin_amdgcn_mfma_f32_16x16x32_bf16(av, bv, cacc[mt2], 0, 0, 0); }
                if (w < 4) { const bf16x8 av = *(const LAS bf16x8*)(L + MX_KWT + ((16 * w + l15) * 72 + 32 * ks + 8 * lq) * 2), bn = *(const LAS bf16x8*)(L + MX_VST + ((128 + l15) * 72 + 32 * ks + 8 * lq) * 2);
                    nacc = __builtin_amdgcn_mfma_f32_16x16x32_bf16(av, bn, nacc, 0, 0, 0); } }
        }
        __syncthreads();
        if (OUT) {
#pragma unroll
            for (int mt2 = 0; mt2 < 4; ++mt2) { unsigned long long v = (unsigned long long)pkbf(cacc[mt2][0], cacc[mt2][1]) | ((unsigned long long)pkbf(cacc[mt2][2], cacc[mt2][3]) << 32);
                *(LAS unsigned long long*)(L + MX_CST + ((16 * w + l15) * 72 + 16 * mt2 + 4 * lq) * 2) = v; }
            if (w < 4) { unsigned long long v = (unsigned long long)pkbf(nacc[0], nacc[1]) | ((unsigned long long)pkbf(nacc[2], nacc[3]) << 32);
                *(LAS unsigned long long*)(L + MX_CST + ((128 + l15) * 72 + 16 * w + 4 * lq) * 2) = v; }
            f32x4 hh[2][2]; float dn[2], flr[2];
#pragma unroll
            for (int k = 0; k < 2; ++k) { const int id = tid + 512 * k, t = id >> 4, c = id & 15;
                hh[k][0] = *(const LAS f32x4*)(L + MX_HS + (t * 132 + 8 * c) * 4); hh[k][1] = *(const LAS f32x4*)(L + MX_HS + (t * 132 + 8 * c + 4) * 4);
                dn[k] = ((const LAS float*)(L + MX_DEN))[t]; flr[k] = gFL[64 * n + t]; }
            MX_LDS_FENCE();
#pragma unroll
            for (int k = 0; k < 2; ++k) { const int id = tid + 512 * k, t = id >> 4, c = id & 15;
                const float inv = __builtin_amdgcn_rcpf(fmaxf(fabsf(dn[k]), flr[k]));
                float hv[8] = {hh[k][0][0] * inv, hh[k][0][1] * inv, hh[k][0][2] * inv, hh[k][0][3] * inv, hh[k][1][0] * inv, hh[k][1][1] * inv, hh[k][1][2] * inv, hh[k][1][3] * inv};
                float sm = 0.f;
#pragma unroll
                for (int e = 0; e < 8; ++e) sm += hv[e];
                sm = row_sum16(sm);
                const float mean = sm * (1.f / 128.f); float q = 0.f;
#pragma unroll
                for (int e = 0; e < 8; ++e) { hv[e] -= mean; q = __builtin_fmaf(hv[e], hv[e], q); }
                q = row_sum16(q);
                const float rstd = rsqrtf(q * (1.f / 128.f) + LN_EPS);
                float yv[8];
#pragma unroll
                for (int e2 = 0; e2 < 4; ++e2) { const unsigned x = ro[k][e2]; const float o0 = __uint_as_float(x << 16), o1 = __uint_as_float(x & 0xffff0000u);
                    yv[2 * e2] = hv[2 * e2] * rstd * gain[2 * e2] * __builtin_amdgcn_rcpf(1.0f + fexp(-o0)); yv[2 * e2 + 1] = hv[2 * e2 + 1] * rstd * gain[2 * e2 + 1] * __builtin_amdgcn_rcpf(1.0f + fexp(-o1)); }
                v4u o; o.x = pkbf(yv[0], yv[1]); o.y = pkbf(yv[2], yv[3]); o.z = pkbf(yv[4], yv[5]); o.w = pkbf(yv[6], yv[7]);
                *(GAS v4u*)(Y + (gr_seg + 64 * n + t) * DM + 512 + 128 * h + 8 * c) = o; }
            if (n + 1 < 8) MX_LOAD_O(n + 1);
            __syncthreads();
        }
    }
    }
    if (!OUT) {
        float* st = ST + (size_t)u * ST_FLOATS;
#pragma unroll
        for (int mt = 0; mt < 4; ++mt)
#pragma unroll
            for (int r = 0; r < 4; ++r) st[(16 * mt + 4 * lq + r) * 144 + 16 * w + l15] = cacc[mt][r];
        if (w < 4) {
#pragma unroll
            for (int r = 0; r < 4; ++r) st[(16 * w + 4 * lq + r) * 144 + 128 + l15] = nacc[r]; }
    }
    __syncthreads();
}

constexpr int SG_VNT = 0, SG_SOUT = 34816, SG_RAW = 34816;
__device__ __forceinline__ void sgu_phase(Frame& F, const Args& args, int l) {
    const int tid = F.tid, lane = F.lane, w = F.wave, l15 = lane & 15, lq = lane >> 4;
    unsigned char* ws = F.ws; const bf16* Z = (const bf16*)(ws + WS_Z); bf16* Y = (bf16*)(ws + WS_Y);
    LAS unsigned char* L = F.lds;
    const int h = F.vcu & 3;
    const float* sw = INP(6) + ((size_t)l * 4 + h) * 128 * 128; const float* sb = INP(7) + (l * 4 + h) * 128;
    const float* lg = INP(8) + (l * 4 + h) * 128; const float* lb = INP(9) + (l * 4 + h) * 128;
    bf16x8 wa[4];
#pragma unroll
    for (int ks = 0; ks < 4; ++ks) { const float* p = sw + (size_t)(16 * w + l15) * 128 + 32 * ks + 8 * lq; const f32x4 a = *(const GAS f32x4*)p, b = *(const GAS f32x4*)(p + 4);
        v4u o; o.x = pkbf(a[0], a[1]); o.y = pkbf(a[2], a[3]); o.z = pkbf(b[0], b[1]); o.w = pkbf(b[2], b[3]);
        if (w < 4 && ks >= 2) o = (v4u){0u, 0u, 0u, 0u};
        wa[ks] = __builtin_bit_cast(bf16x8, o); }
    float bsr[4];
#pragma unroll
    for (int r = 0; r < 4; ++r) bsr[r] = sb[16 * w + 4 * lq + r];
    float lgv[8], lbv[8];
#pragma unroll
    for (int e = 0; e < 8; ++e) { lgv[e] = lg[8 * (tid & 15) + e]; lbv[e] = lb[8 * (tid & 15) + e]; }
    v4u pv_[4], pu_[4];
#pragma unroll
    for (int k = 0; k < 4; ++k) { const int id = tid + 512 * k; pv_[k] = *(const GAS v4u*)(Z + ((size_t)((F.vcu >> 2) * 4) * 128 + (id >> 4)) * ZW + 512 + 128 * h + 8 * (id & 15)); }
#pragma unroll 1
    for (int it = 0; it < 4; ++it) {
        const int blk = (F.vcu >> 2) * 4 + it;
        const size_t r0 = (size_t)blk * 128;
#pragma unroll
        for (int k = 0; k < 4; ++k) { const int id = tid + 512 * k; pu_[k] = *(const GAS v4u*)(Z + (r0 + (id >> 4)) * ZW + 128 * h + 8 * (id & 15)); }
#pragma unroll
        for (int k = 0; k < 4; ++k) { const int id = tid + 512 * k, j = id >> 4, c = id & 15;
            const v4u rw = pv_[k];
            float v[8];
#pragma unroll
            for (int e2 = 0; e2 < 4; ++e2) { v[2 * e2] = __uint_as_float(rw[e2] << 16); v[2 * e2 + 1] = __uint_as_float(rw[e2] & 0xffff0000u); }
            float sm = 0.f;
#pragma unroll
            for (int e = 0; e < 8; ++e) sm += v[e];
            sm = row_sum16(sm);
            const float mean = sm * (1.f / 128.f); float q = 0.f;
#pragma unroll
            for (int e = 0; e < 8; ++e) { v[e] -= mean; q = __builtin_fmaf(v[e], v[e], q); }
            q = row_sum16(q);
            const float rstd = rsqrtf(q * (1.f / 128.f) + LN_EPS);
#pragma unroll
            for (int e = 0; e < 8; ++e) v[e] = v[e] * rstd * lgv[e] + lbv[e];
            v4u o; o.x = pkbf(v[0], v[1]); o.y = pkbf(v[2], v[3]); o.z = pkbf(v[4], v[5]); o.w = pkbf(v[6], v[7]);
            *(LAS v4u*)(L + SG_RAW + j * 272 + c * 16) = o; }
        if (it + 1 < 4) {
#pragma unroll
            for (int k = 0; k < 4; ++k) { const int id = tid + 512 * k; pv_[k] = *(const GAS v4u*)(Z + (r0 + 128 + (id >> 4)) * ZW + 512 + 128 * h + 8 * (id & 15)); } }
        __syncthreads();
#pragma unroll
        for (int k = 0; k < 4; ++k) { const int id = w + 8 * k;
            const int c = id & 15, j = 64 * (id >> 4) + lane; const v4u rw = *(const LAS v4u*)(L + SG_RAW + j * 272 + c * 16);
#pragma unroll
            for (int e2 = 0; e2 < 4; ++e2) { ((LAS bf16*)(L + SG_VNT))[(8 * c + 2 * e2) * 136 + j] = (bf16)(rw[e2] & 0xffffu); ((LAS bf16*)(L + SG_VNT))[(8 * c + 2 * e2 + 1) * 136 + j] = (bf16)(rw[e2] >> 16); } }
        __syncthreads();
        {
            f32x4 sa[8];
#pragma unroll
            for (int nt = 0; nt < 8; ++nt) sa[nt] = (f32x4){0.f, 0.f, 0.f, 0.f};
#pragma unroll
            for (int ks = 0; ks < 4; ++ks) {
                if (ks < 2 || w >= 4) {
#pragma unroll
                    for (int nt = 0; nt < 8; ++nt) { const bf16x8 bv = *(const LAS bf16x8*)(L + SG_VNT + ((16 * nt + l15) * 136 + 32 * ks + 8 * lq) * 2);
                        sa[nt] = __builtin_amdgcn_mfma_f32_16x16x32_bf16(wa[ks], bv, sa[nt], 0, 0, 0); } } }
#pragma unroll
            for (int nt = 0; nt < 8; ++nt)
#pragma unroll
                for (int r = 0; r < 4; ++r) ((LAS float*)(L + SG_SOUT))[(16 * w + 4 * lq + r) * 132 + 16 * nt + l15] = sa[nt][r] + bsr[r];
        }
        __syncthreads();
#pragma unroll
        for (int k = 0; k < 4; ++k) { const int id = tid + 512 * k, i = id >> 4, c = id & 15;
            const v4u rw = pu_[k];
            const f32x4 s0 = *(const LAS f32x4*)(L + SG_SOUT + (i * 132 + 8 * c) * 4), s1 = *(const LAS f32x4*)(L + SG_SOUT + (i * 132 + 8 * c + 4) * 4);
            v4u o; o.x = pkbf(__uint_as_float(rw[0] << 16) * s0[0], __uint_as_float(rw[0] & 0xffff0000u) * s0[1]); o.y = pkbf(__uint_as_float(rw[1] << 16) * s0[2], __uint_as_float(rw[1] & 0xffff0000u) * s0[3]);
            o.z = pkbf(__uint_as_float(rw[2] << 16) * s1[0], __uint_as_float(rw[2] & 0xffff0000u) * s1[1]); o.w = pkbf(__uint_as_float(rw[3] << 16) * s1[2], __uint_as_float(rw[3] & 0xffff0000u) * s1[3]);
            *(GAS v4u*)(Y + (r0 + i) * DM + 128 * h + 8 * c) = o; }
        __syncthreads();
    }
}
#define MIXER_PASS1 mlstm_phase<false>(F, args, l);
#define MIXER_PASS2 { mlstm_phase<true>(F, args, l); sgu_phase(F, args, l); }
__global__ void __launch_bounds__(NWAVES * 64, 2) mk_fwd(Args args) {
    extern __shared__ __attribute__((aligned(16))) unsigned char lds[];
    Frame F;
    F.lds = (LAS unsigned char*)lds;
    F.MISC = (volatile LAS unsigned*)(F.lds + MISC_OFF);
    F.tid = threadIdx.x; F.lane = F.tid & 63; F.wave = __builtin_amdgcn_readfirstlane(F.tid >> 6);
    F.G = gridDim.x; { const int bx = blockIdx.x; F.vcu = (F.G % 8 == 0) ? (bx % 8) * (F.G / 8) + bx / 8 : bx; }
    F.ws = args.ws;
    F.ctl = (gu32*)(F.ws + WS_CTL);
    for (int u = F.tid; u < (LDS_BYTES - LDSCTL_OFF) / 4; u += NWAVES * 64) ((LAS unsigned*)(F.lds + LDSCTL_OFF))[u] = 0u;
    __syncthreads();
    if (F.tid == 0) {
#pragma unroll
        for (int i = 0; i < 20; ++i) ((LAS unsigned long long*)(F.lds + PT_OFF))[i] = (unsigned long long)args.in[i];
        ((LAS unsigned long long*)(F.lds + PT_OFF))[20] = (unsigned long long)args.out; }
    __syncthreads();
    const int lo = args.ph_lo, hi = args.ph_hi;
    XcdBarrier bar; bar.bar = (unsigned*)(F.ctl + CW_BAR) + args.bar_region * XCD_BAR_WORDS; bar.x = 0; bar.st = nullptr;
    if (hi - lo > 1) bar = xcd_barrier_post((unsigned*)(F.ctl + CW_BAR) + args.bar_region * XCD_BAR_WORDS, F.MISC + 8);

#pragma unroll 1
    for (int ph = lo; ph < hi; ++ph) {
        const int l = (ph - 1) / 8, sub = (ph - 1) % 8;
        int nrep = 1;
        if (DUP_MASK && ph < NPHASE - 1) { if (ph == 0) nrep += (DUP_MASK >> 7) & 1; else nrep += (DUP_MASK >> sub) & 1; }
#pragma unroll 1
        for (int rep = 0; rep < nrep; ++rep) {
        if (ph > lo || rep) xcd_barrier(bar, F.wave == 0 && mk_lane() == 0);
        if (PROBE_CLK >= 10 && blockIdx.x == 0 && F.tid == 0) ((unsigned long long*)(F.ws + WS_CTL + 16384))[ph] = __builtin_amdgcn_s_memrealtime();
#define FRESH_LANE() do { F.lane = mk_lane(); asm volatile("" : "+v"(F.lane)); F.tid = F.wave * 64 + F.lane; } while (0)
        asm volatile("" : "+s"(F.vcu), "+s"(F.wave), "+s"(F.G));
        { unsigned long long wsi = (unsigned long long)F.ws; asm volatile("" : "+s"(wsi)); F.ws = (unsigned char*)(GAS unsigned char*)wsi; }
        unsigned char* ws = F.ws;
        bf16* XN = (bf16*)(ws + WS_XN); bf16* Z = (bf16*)(ws + WS_Z); float* GT = (float*)(ws + WS_GT); bf16* Y = (bf16*)(ws + WS_Y); bf16* H = (bf16*)(ws + WS_H);
        float* G0 = (float*)(ws + WS_G0); float* UP0 = (float*)(ws + WS_UP0);
        if (ph == 0) { FRESH_LANE(); p0_prologue(F, args); continue; }
        if (ph == NPHASE - 1) { FRESH_LANE(); final_ln_phase(F, XN, (const float*)(ws + WS_PARTB), INP(18) + (DEPTH - 1) * DM, INP(19) + (DEPTH - 1) * DM, ((float*)INP(20))); continue; }
        const unsigned char* wt = ws + WS_WT + (size_t)l * WT_LAYER;
        const float* cv = (const float*)(ws + WS_CV); float* partA = (float*)(ws + WS_PARTA); float* partB = (float*)(ws + WS_PARTB);
        if (sub == 0) {
#ifndef NO_Z
            FRESH_LANE();
            if (l == 0) cvec_finalize(F, args);
            const float* part = l > 0 ? partB : nullptr;
            pg8::Gemm g{XN, (const bf16*)(wt + WT_IN), M, ZW, DM}; pg8::StaticOrder S; S.init(M, ZW, F.G, (int)blockIdx.x);
            pg8::EpiZ E{Z, ZW, part, cv + CV_IN1, cv + CV_IN1 + 2576, F.lds + MX_TAB};
            pg8::gemm_phase<pg8::EpiZ, pg8::StaticOrder, true, true>(F.lds + RING_OFF, g, S, E, F.tid);
            FRESH_LANE();
            gates_phase(F, XN, (const bf16*)(wt + WT_G), GT, part, cv + CV_IN1 + ZW, cv + CV_IN1 + 2576 + ZW);
            if (l == 0) { FRESH_LANE(); quant_w_step(F); }
#endif
        } else if (sub == 1) {
#ifndef NO_MIX
            FRESH_LANE();
            MIXER_PASS1
#endif
        } else if (sub == 2) {
#ifndef NO_MIX
            FRESH_LANE();
            MIXER_PASS2
#endif
        } else if (sub == 3) {
#ifndef NO_RES
            FRESH_LANE();
            res_gemm_phase(F, Y, (const bf16*)(wt + WT_OUT), DM, XN, (DUP_MASK && rep == 0 && nrep == 2) ? (bf16*)(ws + 295 * MiB) : XN, l > 0 ? partB : (const float*)nullptr, INP(18) + (l > 0 ? l - 1 : 0) * DM, INP(19) + (l > 0 ? l - 1 : 0) * DM, (DUP_MASK && rep == 0 && nrep == 2) ? (float*)(ws + 400 * MiB) : partA);
#endif
        } else if (sub == 4) {
            FRESH_LANE();
            quant_a_phase(F, XN);
        } else if (sub == 5) {
#ifndef NO_GLU
            FRESH_LANE();
            pg8::Gemm g{(const bf16*)(ws + WS_V8), (const bf16*)(ws + WS_W8 + (size_t)l * 2 * DFF * DM), M, 2 * DFF, DM / 2}; pg8::StaticOrder S; S.init(M, 2 * DFF, F.G, (int)blockIdx.x);
            const float* cu = cv + (l == 0 ? CV_UP0 : CV_UP1); const float* swc = (const float*)(ws + WS_SWC) + (size_t)l * 4 * DFF;
            pg8::EpiGlu8 E{H, INP(15) + (size_t)l * 3 * DFF, INP(16) + l * DFF, G0, UP0, DFF, M / 64, partA, swc + 2 * DFF, cu + 5632, F.lds + MX_TAB, swc, (const float*)(ws + WS_SA)};
            pg8::gemm_phase<pg8::EpiGlu8, pg8::StaticOrder, true, true>(F.lds + RING_OFF, g, S, E, F.tid);
#endif
        } else if (sub == 6) {
            FRESH_LANE();
            glu_fixup_phase(F, G0, UP0, INP(15) + (size_t)l * 3 * DFF, INP(16) + l * DFF, H);
        } else {
#ifndef NO_RES
            FRESH_LANE();
            res_gemm_phase(F, H, (const bf16*)(wt + WT_DN), DFF, XN, (DUP_MASK && rep == 0 && nrep == 2) ? (bf16*)(ws + WS_T4) : XN, partA, INP(12) + l * DM, INP(13) + l * DM, (DUP_MASK && rep == 0 && nrep == 2) ? (float*)(ws + WS_T4 + 128 * MiB) : partB);
#endif
        }
        }
    }
    if (PROBE_CLK && hi == NPHASE) { xcd_barrier(bar, F.wave == 0 && mk_lane() == 0); if (blockIdx.x == 0 && F.tid == 0) {
        if (PROBE_CLK >= 10) { unsigned long long* ts = (unsigned long long*)(F.ws + WS_CTL + 16384); ts[NPHASE] = __builtin_amdgcn_s_memrealtime(); const int k = PROBE_CLK - 10;
            ((float*)INP(20))[0] += 0.1f + 1e-5f * (float)(ts[k + 1] - ts[k]); }
        else ((float*)INP(20))[0] += ((float*)(F.ws + WS_CTL))[2048]; } }
}

static void launch_mk(const Args& base, int lo, int hi, int region, hipStream_t stream) {
    Args a = base; a.ph_lo = lo; a.ph_hi = hi; a.bar_region = region; a.pad = 0;
    hipLaunchKernelGGL(mk_fwd, dim3(256), dim3(NWAVES * 64), LDS_BYTES, stream, a);
}

extern "C" void kernel_launch(void* const* d_in, const int* in_sizes, int n_in, void* d_out, int out_size, void* d_ws, size_t ws_size, hipStream_t stream) {
    static int inited = 0;
    if (!inited) {
        if (hipFuncSetAttribute((const void*)mk_fwd, hipFuncAttributeMaxDynamicSharedMemorySize, LDS_BYTES) != hipSuccess) fprintf(stderr, "kernel_launch: hipFuncSetAttribute failed\n");
        int dev = 0, cus = 0, per_cu = 0;
        if (hipGetDevice(&dev) != hipSuccess || hipDeviceGetAttribute(&cus, hipDeviceAttributeMultiprocessorCount, dev) != hipSuccess) cus = 0;
        if (hipOccupancyMaxActiveBlocksPerMultiprocessor(&per_cu, (const void*)mk_fwd, NWAVES * 64, LDS_BYTES) != hipSuccess) per_cu = 0;
        (void)hipGetLastError();
        if (cus * per_cu < 256) fprintf(stderr, "kernel_launch: %d CUs x %d resident workgroups per CU < the 256 workgroups this kernel's grid barriers need\n", cus, per_cu);
        inited = 1;
    }
    unsigned char* ws = (unsigned char*)d_ws;
    (void)hipMemsetAsync(ws + WS_CTL, 0, CTL_ZERO_BYTES, stream);
    Args a{};
    for (int i = 0; i < 20; ++i) a.in[i] = (const float*)d_in[i];
    a.out = (float*)d_out; a.ws = ws;
    launch_mk(a, 0, NPHASE, 0, stream);
}
```

```cpp
constexpr int PROBE_CLK = 0;
constexpr int PROBE_NULL = 0;
constexpr int DUP_MASK = 0;
#include <hip/hip_runtime.h>
#include <cstdint>
#include <cstdio>

constexpr int BATCH = 4, SEQ = 8192, DM = 1024, M = BATCH * SEQ, DEPTH = 2;
constexpr int DA = 512, DQK = 256, DB = 512, NH = 4;
constexpr int DIN = 2568, ZW = 2560, DFF = 2816;
constexpr float LN_EPS = 1e-5f, ALPHA = 1.41421356237f;

typedef unsigned short bf16;
typedef unsigned u32x4 __attribute__((ext_vector_type(4)));

__device__ __forceinline__ float bf2f(bf16 v) { return __uint_as_float(((unsigned)v) << 16); }
__device__ __forceinline__ bf16 f2bf(float f) { unsigned u = __float_as_uint(f); return (bf16)((u + 0x7fffu + ((u >> 16) & 1u)) >> 16); }
__device__ __forceinline__ float gelu_f(float x) { return 0.5f * x * (1.0f + erff(x * 0.70710678118f)); }
__device__ __forceinline__ float silu_f(float x) { return x / (1.0f + expf(-x)); }
__device__ __forceinline__ float sigmoid_f(float x) { return 1.0f / (1.0f + expf(-x)); }
__device__ __forceinline__ float logsigmoid_f(float x) { return fminf(x, 0.f) - log1pf(expf(-fabsf(x))); }

constexpr size_t MiB = 1u << 20;
constexpr size_t WS_XN = 0;
constexpr size_t WS_Z = 64 * MiB;
constexpr size_t WS_GT = 224 * MiB;
constexpr size_t WS_Y = 225 * MiB;
constexpr size_t WS_HM = 289 * MiB;
constexpr size_t WS_QC = 353 * MiB;
constexpr size_t WS_KC = 385 * MiB;
constexpr size_t WS_IG = 417 * MiB;
constexpr size_t WS_LF = 417 * MiB + 512 * 1024;
constexpr size_t WS_T3 = 64 * MiB;
constexpr size_t WS_H = 64 * MiB;
constexpr size_t WS_T4 = 240 * MiB;
constexpr size_t WS_T5 = 240 * MiB;


__device__ __forceinline__ int mk_lane() { return (int)__builtin_amdgcn_mbcnt_hi(~0u, __builtin_amdgcn_mbcnt_lo(~0u, 0u)); }
namespace pg8 {
#define PG8_LAS __attribute__((address_space(3)))
typedef unsigned short bf16_t;
typedef short bf16x8 __attribute__((ext_vector_type(8)));
typedef float f32x4 __attribute__((ext_vector_type(4)));
typedef unsigned u32x4 __attribute__((ext_vector_type(4)));
typedef int i32x4 __attribute__((ext_vector_type(4)));
constexpr int BM = 256, BK = 64, HALF = 128, HTB = HALF * BK * 2  , STAGE_BYTES = 8 * HTB, NXCD = 8, WGM = 8;

__host__ __device__ __forceinline__ int lds_byte(int r, int c) { const int st = (r >> 4) * 2 + (c >> 5), rr = r & 15, cc = c & 31, ob = rr * 64 + cc * 2; return st * 1024 + (ob ^ (((ob >> 9) & 1) << 5)); }
__host__ __device__ __forceinline__ void stage_rc(int b, int& R, int& C) { const int st = b / 1024, sb = b % 1024, swz = sb ^ (((sb >> 9) & 1) << 5); R = (st >> 1) * 16 + swz / 64; C = (st & 1) * 32 + (swz % 64) / 2; }
__host__ __device__ __forceinline__ int perm32(int rho) { const int n = rho >> 4, i = rho & 15; return 8 * (i >> 2) + 4 * n + (i & 3); }

struct Unit { int pm, pn; };
struct Gemm { const bf16_t* A; const bf16_t* Bt; int M, N, K; };

struct StaticOrder {
    int nM, nN, nwg, G, c;
    __host__ __device__ void init(int M, int N, int G_, int c_) { nM = M / BM; nN = N / BM; nwg = nM * nN; G = G_; c = c_; }
    __host__ __device__ bool next(int i, Unit& u) const {
        const long L = (long)i * G + c; if (L >= nwg) return false;
        int wgid = (int)L; { const int q = nwg / NXCD, r = nwg % NXCD, xcd = wgid % NXCD, off = wgid / NXCD; wgid = (xcd < r ? xcd * (q + 1) : r * (q + 1) + (xcd - r) * q) + off; }
        const int nig = WGM * nN, gid = wgid / nig, fm = gid * WGM, gsz = (nM - fm) < WGM ? (nM - fm) : WGM;
        u.pm = fm + ((wgid % nig) % gsz); u.pn = (wgid % nig) / gsz; return true;
    }
    __device__ __forceinline__ void a_ready(const Unit&) const {}
    __device__ __forceinline__ void done(const Unit&) const {}
};

__device__ __forceinline__ unsigned cvt_pk_bf16(float lo, float hi) { unsigned r; asm volatile("v_cvt_pk_bf16_f32 %0, %1, %2" : "=v"(r) : "v"(lo), "v"(hi)); return r; }
typedef float f32x2 __attribute__((ext_vector_type(2)));
__device__ __forceinline__ f32x2 gelu_pk(f32x2 v) {
    const f32x2 av = __builtin_elementwise_abs(v), d = av * 0.2316418882f + 1.0f;
    f32x2 t; t.x = __builtin_amdgcn_rcpf(d.x); t.y = __builtin_amdgcn_rcpf(d.y);
    f32x2 q = t * 0.5307027145f + (-0.7265760135f); q = q * t + 0.7107068705f; q = q * t + (-0.142248368f); q = q * t + 0.127414796f; q = q * t;
    const f32x2 s = (v * v) * (-0.72134752044f);
    f32x2 e; e.x = __builtin_amdgcn_exp2f(s.x); e.y = __builtin_amdgcn_exp2f(s.y);
    const f32x2 m = v * (q * e), r = v - m;
    f32x2 o; o.x = v.x < 0.f ? m.x : r.x; o.y = v.y < 0.f ? m.y : r.y; return o;
}

constexpr float K_EPS = 1e-5f, K_ALPHA = 1.41421356237f;
struct RowStat { float nmr, r; };
constexpr int TAB_STAT = 0, TAB_CONST = 8192, TAB_P = 12288, TAB_P2 = 20480, TAB_SW = 12288, TAB_R4 = 24576, TAB_SA = 28672;
__device__ __forceinline__ void glds16(const void* gsrc, PG8_LAS unsigned char* ldst) { __builtin_amdgcn_global_load_lds((const unsigned*)gsrc, (PG8_LAS unsigned*)ldst, 16, 0, 0); }
__device__ __forceinline__ void prefetch_stats(const float* part, int pm, PG8_LAS unsigned char* tab, int wid, int lane) {
    glds16(part + ((size_t)pm * BM + 32 * wid) * 8 + 4 * lane, tab + TAB_STAT + wid * 1024);
}
__device__ __forceinline__ RowStat row_stat_lds(const PG8_LAS unsigned char* tab, int rloc, float eps) {
    const f32x4 a = *(const PG8_LAS f32x4*)(tab + TAB_STAT + rloc * 32), b = *(const PG8_LAS f32x4*)(tab + TAB_STAT + rloc * 32 + 16);
    const float mean = ((a[0] + a[2]) + (b[0] + b[2])) * 0.25f;
    const float d0 = a[0] - mean, d1 = a[2] - mean, d2 = b[0] - mean, d3 = b[2] - mean;
    const float m2 = ((a[1] + a[3]) + (b[1] + b[3])) + 256.0f * ((d0 * d0 + d1 * d1) + (d2 * d2 + d3 * d3));
    RowStat o; o.r = __builtin_amdgcn_rsqf(m2 * (1.0f / 1024.0f) + eps); o.nmr = -mean * o.r; return o;
}
__device__ __forceinline__ void finalize_stats(PG8_LAS unsigned char* tab, int tid, int slot = TAB_P) {
    typedef float f32x2v __attribute__((ext_vector_type(2)));
    if (tid < 256) { const RowStat rs = row_stat_lds(tab, tid, K_EPS); *(PG8_LAS f32x2v*)(tab + slot + 8 * tid) = (f32x2v){rs.nmr, rs.r}; }
}
__device__ __forceinline__ RowStat stat_tab(const PG8_LAS unsigned char* tab, int rloc, int slot = TAB_P) {
    typedef float f32x2v __attribute__((ext_vector_type(2)));
    const f32x2v v = *(const PG8_LAS f32x2v*)(tab + slot + 8 * rloc); RowStat o; o.nmr = v.x; o.r = v.y; return o;
}
__device__ __forceinline__ float sum_fq4(float x) {
    auto a = __builtin_amdgcn_permlane16_swap(__float_as_uint(x), __float_as_uint(x), false, false); const float y = __uint_as_float(a[0]) + __uint_as_float(a[1]);
    auto b = __builtin_amdgcn_permlane32_swap(__float_as_uint(y), __float_as_uint(y), false, false); return __uint_as_float(b[0]) + __uint_as_float(b[1]);
}
__device__ __forceinline__ RowStat row_stat(const float* part, size_t row, float eps) {
    const f32x4 a = *(const f32x4*)(part + row * 8), b = *(const f32x4*)(part + row * 8 + 4);
    const float mean = ((a[0] + a[2]) + (b[0] + b[2])) * 0.25f;
    const float d0 = a[0] - mean, d1 = a[2] - mean, d2 = b[0] - mean, d3 = b[2] - mean;
    const float m2 = ((a[1] + a[3]) + (b[1] + b[3])) + 256.0f * ((d0 * d0 + d1 * d1) + (d2 * d2 + d3 * d3));
    RowStat o; o.r = 1.0f / sqrtf(m2 * (1.0f / 1024.0f) + eps); o.nmr = -mean * o.r; return o;
}
__device__ __forceinline__ f32x2 gelu_sig_pk(f32x2 v) {
    f32x2 u = v * v; u.x = fminf(u.x, 25.0f); u.y = fminf(u.y, 25.0f);
    f32x2 p = u * 1.606761657e-07f + (-8.002404684e-06f); p = p * u + 1.357175497e-04f; p = p * u + 1.694368402e-04f; p = p * u + (-1.049327254e-01f); p = p * u + (-2.302172184e+00f);
    const f32x2 z = v * p;
    f32x2 e; e.x = __builtin_amdgcn_exp2f(z.x); e.y = __builtin_amdgcn_exp2f(z.y);
    const f32x2 d = e + 1.0f;
    f32x2 r; r.x = __builtin_amdgcn_rcpf(d.x); r.y = __builtin_amdgcn_rcpf(d.y);
    return v * r;
}
__device__ __forceinline__ f32x2 gelu_ns_pk(f32x2 v) { return gelu_sig_pk(v); }
struct EpiZ {
    static constexpr bool PERM = true, AFTER_DRAIN = false, PERM_A = false, I8 = false;
    bf16_t* O; int ldc; const float* part; const float* c1; const float* c0; PG8_LAS unsigned char* tab;
    __device__ __forceinline__ void prefetch(const Unit& u, int wid, int lane) const {
        if (part) { prefetch_stats(part, u.pm, tab, wid, lane);
            if (wid < 2) glds16((wid ? c0 : c1) + u.pn * BM + 4 * lane, tab + TAB_CONST + wid * 1024); }
    }
    __device__ __forceinline__ void operator()(f32x4 (&acc)[2][2][4][2], const Unit& u, int wr, int wc, int fr, int fq) const {
        const int row0 = u.pm * BM + wr * 64 + fr, col0 = u.pn * BM + wc * 32 + 8 * fq, cl0 = wc * 32 + 8 * fq;
        const bool act = u.pn < 4;
        if (part) { finalize_stats(tab, (wr * 4 + wc) * 64 + fr + 16 * fq); asm volatile("s_waitcnt lgkmcnt(0)" ::: "memory"); __builtin_amdgcn_s_barrier(); asm volatile("" ::: "memory"); }
#pragma unroll
        for (int ai = 0; ai < 2; ++ai)
#pragma unroll
            for (int m = 0; m < 4; ++m) { const int rloc = ai * HALF + wr * 64 + m * 16 + fr; bf16_t* rowp = O + (size_t)(u.pm * BM + rloc) * ldc + col0;
                RowStat rs; rs.r = 1.f; rs.nmr = 0.f; if (part) rs = stat_tab(tab, rloc);
#pragma unroll
                for (int bj = 0; bj < 2; ++bj) { u32x4 w;
#pragma unroll
                    for (int n = 0; n < 2; ++n) { f32x4 v = acc[ai][bj][m][n];
                        if (part) { const f32x4 k1 = *(const PG8_LAS f32x4*)(tab + TAB_CONST + (cl0 + bj * HALF + 4 * n) * 4), k0 = *(const PG8_LAS f32x4*)(tab + TAB_CONST + 1024 + (cl0 + bj * HALF + 4 * n) * 4);
                            v = v * rs.r + (k1 * rs.nmr + k0); }
                        if (act) { const f32x2 a = gelu_ns_pk((f32x2){v[0], v[1]}), b = gelu_ns_pk((f32x2){v[2], v[3]}); v = (f32x4){a.x, a.y, b.x, b.y}; }
                        w[2 * n] = cvt_pk_bf16(v[0], v[1]); w[2 * n + 1] = cvt_pk_bf16(v[2], v[3]); }
                    *(u32x4*)(rowp + bj * HALF) = w; }
                asm volatile("" ::: "memory"); }
    }
};

__device__ __forceinline__ float max_fq4(float x) {
    auto a = __builtin_amdgcn_permlane16_swap(__float_as_uint(x), __float_as_uint(x), false, false); const float y = fmaxf(__uint_as_float(a[0]), __uint_as_float(a[1]));
    auto b = __builtin_amdgcn_permlane32_swap(__float_as_uint(y), __float_as_uint(y), false, false); return fmaxf(__uint_as_float(b[0]), __uint_as_float(b[1]));
}
constexpr int TAB_PM = 22528;
template <int QM> struct EpiResT {
    static constexpr bool QUANT = (QM == 1), FINAL = (QM == 2), RDV = (QM != 0);
    static constexpr bool PERM = true, AFTER_DRAIN = false, PERM_A = false, I8 = false;
    bf16_t* V; bf16_t* Vout; int ldc; const float* part_prev; const float* gp; const float* bp; float* part_new; PG8_LAS unsigned char* tab;
    unsigned char* V8; float* SA; float* MM; unsigned* cnt; const float* gF; const float* bF; float* outF;
    __device__ __forceinline__ void prefetch(const Unit& u, int wid, int lane) const {
        if (part_prev) { prefetch_stats(part_prev, u.pm, tab, wid, lane);
            if (wid < 2) glds16((wid ? bp : gp) + u.pn * BM + 4 * lane, tab + TAB_CONST + wid * 1024); }
        if (FINAL && (wid == 2 || wid == 3)) glds16((wid == 3 ? bF : gF) + u.pn * BM + 4 * lane, tab + TAB_CONST + wid * 1024);
    }
    __device__ __forceinline__ void operator()(f32x4 (&acc)[2][2][4][2], const Unit& u, int wr, int wc, int fr, int fq) const {
        typedef float f32x2v __attribute__((ext_vector_type(2)));
        const int col0 = u.pn * BM + wc * 32 + 8 * fq, cl0 = wc * 32 + 8 * fq, lane = fr + 16 * fq, wid = wr * 4 + wc;
        PG8_LAS f32x2v* P = (PG8_LAS f32x2v*)(tab + TAB_P);
        u32x4 bwv[2][4][2];
#pragma unroll
        for (int ai = 0; ai < 2; ++ai)
#pragma unroll
            for (int m = 0; m < 4; ++m)
#pragma unroll
                for (int bj = 0; bj < 2; ++bj) bwv[ai][m][bj] = *(const u32x4*)(V + (size_t)(u.pm * BM + ai * HALF + wr * 64 + m * 16 + fr) * ldc + col0 + bj * HALF);
        asm volatile("" ::: "memory");
        if (part_prev) { finalize_stats(tab, wid * 64 + lane, TAB_P2); asm volatile("s_waitcnt lgkmcnt(0)" ::: "memory"); __builtin_amdgcn_s_barrier(); asm volatile("" ::: "memory"); }
#pragma unroll
        for (int ai = 0; ai < 2; ++ai)
#pragma unroll
            for (int m = 0; m < 4; ++m) { const int rloc = ai * HALF + wr * 64 + m * 16 + fr; bf16_t* rowp = V + (size_t)(u.pm * BM + rloc) * ldc + col0; bf16_t* rowo = Vout + (size_t)(u.pm * BM + rloc) * ldc + col0;
                RowStat rs; rs.r = 1.f; rs.nmr = 0.f; if (part_prev) rs = stat_tab(tab, rloc, TAB_P2);
                float sm = 0.f;
#pragma unroll
                for (int bj = 0; bj < 2; ++bj) { const u32x4 bw = bwv[ai][m][bj];
#pragma unroll
                    for (int n = 0; n < 2; ++n) { const unsigned lo = bw[2 * n], hi = bw[2 * n + 1];
                        f32x4 xs = (f32x4){__uint_as_float(lo << 16), __uint_as_float(lo & 0xffff0000u), __uint_as_float(hi << 16), __uint_as_float(hi & 0xffff0000u)};
                        if (part_prev) { const f32x4 gv = *(const PG8_LAS f32x4*)(tab + TAB_CONST + (cl0 + bj * HALF + 4 * n) * 4), bv = *(const PG8_LAS f32x4*)(tab + TAB_CONST + 1024 + (cl0 + bj * HALF + 4 * n) * 4);
                            xs = (xs * rs.r + rs.nmr) * gv + bv; }
                        const f32x4 v = xs * K_ALPHA + acc[ai][bj][m][n]; acc[ai][bj][m][n] = v; sm += (v[0] + v[1]) + (v[2] + v[3]); } }
                sm = sum_fq4(sm);
                const float mw = sm * (1.0f / 64.0f); float q = 0.f;
#pragma unroll
                for (int bj = 0; bj < 2; ++bj)
#pragma unroll
                    for (int n = 0; n < 2; ++n) { const f32x4 d = acc[ai][bj][m][n] - mw; q += (d[0] * d[0] + d[1] * d[1]) + (d[2] * d[2] + d[3] * d[3]); }
                q = sum_fq4(q);
                if (fq == 0) P[rloc * 4 + wc] = (f32x2v){mw, q};
                if (QUANT) { float mx = -3.0e38f, mn = 3.0e38f;
#pragma unroll
                    for (int bj = 0; bj < 2; ++bj)
#pragma unroll
                        for (int n = 0; n < 2; ++n) { const f32x4 v = acc[ai][bj][m][n]; mx = fmaxf(fmaxf(mx, fmaxf(v[0], v[1])), fmaxf(v[2], v[3])); mn = fminf(fminf(mn, fminf(v[0], v[1])), fminf(v[2], v[3])); }
                    mx = max_fq4(mx); mn = -max_fq4(-mn);
                    if (fq == 0) ((PG8_LAS f32x2v*)(tab + TAB_PM))[rloc * 4 + wc] = (f32x2v){mx, mn}; }
                if (!FINAL) {
#pragma unroll
                for (int bj = 0; bj < 2; ++bj) { const f32x4 v0 = acc[ai][bj][m][0], v1 = acc[ai][bj][m][1];
                    u32x4 w; w.x = cvt_pk_bf16(v0[0], v0[1]); w.y = cvt_pk_bf16(v0[2], v0[3]); w.z = cvt_pk_bf16(v1[0], v1[1]); w.w = cvt_pk_bf16(v1[2], v1[3]);
                    *(u32x4*)(rowo + bj * HALF) = w; } }
                asm volatile("" ::: "memory"); }
        asm volatile("s_waitcnt lgkmcnt(0)" ::: "memory"); __builtin_amdgcn_s_barrier(); asm volatile("" ::: "memory");
        { const int row = wid * 32 + (lane & 31);
          if (lane < 32) { const f32x2v a = P[row * 4 + 0], b = P[row * 4 + 1], c = P[row * 4 + 2], d = P[row * 4 + 3];
            const float mt = (a.x + b.x + c.x + d.x) * 0.25f; const float da = a.x - mt, db = b.x - mt, dc = c.x - mt, dd = d.x - mt;
            const float m2 = (a.y + b.y) + (c.y + d.y) + 64.0f * ((da * da + db * db) + (dc * dc + dd * dd));
            if (!RDV) *(f32x2v*)(part_new + (size_t)(u.pm * BM + row) * 8 + 2 * u.pn) = (f32x2v){mt, m2};
            else if (FINAL) { float* pp = part_new + (size_t)(u.pm * BM + row) * 8 + 2 * u.pn;
                P[row * 4] = (f32x2v){mt, m2};
                __hip_atomic_store((unsigned long long*)pp, ((unsigned long long)__float_as_uint(m2) << 32) | __float_as_uint(mt), __ATOMIC_RELAXED, __HIP_MEMORY_SCOPE_AGENT); }
            else { const PG8_LAS f32x2v* Pm = (const PG8_LAS f32x2v*)(tab + TAB_PM); const f32x2v e = Pm[row * 4 + 0], f = Pm[row * 4 + 1], g = Pm[row * 4 + 2], h = Pm[row * 4 + 3];
                float* pp = part_new + (size_t)(u.pm * BM + row) * 8 + 2 * u.pn; float* pm_ = MM + (size_t)(u.pm * BM + row) * 8 + 2 * u.pn;
                P[row * 4] = (f32x2v){mt, m2}; ((PG8_LAS f32x2v*)(tab + TAB_PM))[row * 4] = (f32x2v){fmaxf(fmaxf(e.x, f.x), fmaxf(g.x, h.x)), fminf(fminf(e.y, f.y), fminf(g.y, h.y))};
                __hip_atomic_store((unsigned long long*)pp, ((unsigned long long)__float_as_uint(m2) << 32) | __float_as_uint(mt), __ATOMIC_RELAXED, __HIP_MEMORY_SCOPE_AGENT);
                __hip_atomic_store((unsigned long long*)pm_, ((unsigned long long)__float_as_uint(fminf(fminf(e.y, f.y), fminf(g.y, h.y))) << 32) | __float_as_uint(fmaxf(fmaxf(e.x, f.x), fmaxf(g.x, h.x))), __ATOMIC_RELAXED, __HIP_MEMORY_SCOPE_AGENT); } } }
        if (RDV) {
            const int tid_ = wid * 64 + lane;
            asm volatile("s_waitcnt vmcnt(0) lgkmcnt(0)" ::: "memory"); __builtin_amdgcn_s_barrier(); asm volatile("" ::: "memory");
            if (tid_ == 0) { __hip_atomic_fetch_add(cnt + u.pm, 1u, __ATOMIC_RELAXED, __HIP_MEMORY_SCOPE_AGENT);
                for (int it = 0; it < (1 << 20) && __hip_atomic_load(cnt + u.pm, __ATOMIC_RELAXED, __HIP_MEMORY_SCOPE_AGENT) < 4u; ++it) __builtin_amdgcn_s_sleep(1); }
            asm volatile("" ::: "memory"); __builtin_amdgcn_s_barrier(); asm volatile("" ::: "memory");
            if (tid_ < 256) { const float* pp = part_new + (size_t)(u.pm * BM + tid_) * 8; const float* pm_ = (QUANT ? MM : part_new) + (size_t)(u.pm * BM + tid_) * 8;
                float a[8], b[8];
#pragma unroll
                for (int j = 0; j < 4; ++j) { b[2 * j] = 0.f; b[2 * j + 1] = 0.f;
                    if (j == u.pn) { const f32x2v o = P[tid_ * 4]; a[2 * j] = o.x; a[2 * j + 1] = o.y;
                        if (QUANT) { const f32x2v o2 = ((const PG8_LAS f32x2v*)(tab + TAB_PM))[tid_ * 4]; b[2 * j] = o2.x; b[2 * j + 1] = o2.y; } }
                    else { const unsigned long long wa = __hip_atomic_load((const unsigned long long*)pp + j, __ATOMIC_RELAXED, __HIP_MEMORY_SCOPE_AGENT);
                        a[2 * j] = __uint_as_float((unsigned)wa); a[2 * j + 1] = __uint_as_float((unsigned)(wa >> 32));
                        if (QUANT) { const unsigned long long wb = __hip_atomic_load((const unsigned long long*)pm_ + j, __ATOMIC_RELAXED, __HIP_MEMORY_SCOPE_AGENT);
                            b[2 * j] = __uint_as_float((unsigned)wb); b[2 * j + 1] = __uint_as_float((unsigned)(wb >> 32)); } } }
                const float mean = ((a[0] + a[2]) + (a[4] + a[6])) * 0.25f; const float d0 = a[0] - mean, d1 = a[2] - mean, d2 = a[4] - mean, d3 = a[6] - mean;
                const float m2 = ((a[1] + a[3]) + (a[5] + a[7])) + 256.0f * ((d0 * d0 + d1 * d1) + (d2 * d2 + d3 * d3));
                const float r = __builtin_amdgcn_rsqf(m2 * (1.0f / 1024.0f) + K_EPS);
                const float mx = fmaxf(fmaxf(b[0], b[2]), fmaxf(b[4], b[6])), mn = fminf(fminf(b[1], b[3]), fminf(b[5], b[7]));
                const float am = fmaxf(mx - mean, mean - mn) * r;
                const float inv = am > 0.f ? 127.0f / am : 0.f;
                *(PG8_LAS f32x2v*)(tab + TAB_STAT + 8 * tid_) = (f32x2v){mean, QUANT ? r * inv : r};
                if (QUANT && u.pn == 0) SA[(size_t)u.pm * BM + tid_] = am * (1.0f / 127.0f); }
            asm volatile("s_waitcnt lgkmcnt(0)" ::: "memory"); __builtin_amdgcn_s_barrier(); asm volatile("" ::: "memory");
#pragma unroll
            for (int ai = 0; ai < 2; ++ai)
#pragma unroll
                for (int m = 0; m < 4; ++m) { const int rloc = ai * HALF + wr * 64 + m * 16 + fr; const f32x2v t = *(const PG8_LAS f32x2v*)(tab + TAB_STAT + 8 * rloc);
                    if (FINAL) { float* orow = outF + (size_t)(u.pm * BM + rloc) * ldc + col0;
#pragma unroll
                        for (int bj = 0; bj < 2; ++bj)
#pragma unroll
                            for (int n = 0; n < 2; ++n) { const f32x4 gv = *(const PG8_LAS f32x4*)(tab + TAB_CONST + 2048 + (cl0 + bj * HALF + 4 * n) * 4), bv = *(const PG8_LAS f32x4*)(tab + TAB_CONST + 3072 + (cl0 + bj * HALF + 4 * n) * 4);
                                const f32x4 o = ((acc[ai][bj][m][n] - t.x) * t.y) * gv + bv;
                                *(f32x4*)(orow + bj * HALF + 4 * n) = o; }
                        continue; }
                    unsigned char* dst = V8 + (size_t)(u.pm * BM + rloc) * 1024 + col0;
#pragma unroll
                    for (int bj = 0; bj < 2; ++bj) { unsigned w2[2];
#pragma unroll
                        for (int n = 0; n < 2; ++n) { const f32x4 v = (acc[ai][bj][m][n] - t.x) * t.y; unsigned w = 0u;
#pragma unroll
                            for (int e = 0; e < 4; ++e) w |= ((unsigned)(int)__builtin_rintf(v[e]) & 0xffu) << (8 * e);
                            w2[n] = w; }
                        typedef unsigned v2u_ __attribute__((ext_vector_type(2)));
                        *(v2u_*)(dst + bj * HALF) = (v2u_){w2[0], w2[1]}; } }
        }
    }
};
typedef EpiResT<0> EpiRes;
typedef EpiResT<1> EpiResQ;
typedef EpiResT<2> EpiResF;

#define PG8_DPP0(src, ctrl) __builtin_bit_cast(float, __builtin_amdgcn_update_dpp(0, __builtin_bit_cast(int, (float)(src)), (ctrl), 0xf, 0xf, true))
__device__ __forceinline__ f32x2 gelu_mul_pk(f32x2 v, f32x2 u) { return gelu_sig_pk(v) * u; }
template <int MODE  , bool I8_ = false> struct EpiGluT {
    static constexpr bool PERM = true, AFTER_DRAIN = false, PERM_A = true, I8 = I8_;
    bf16_t* H; const float* cw; const float* cb; float* G0; float* UP0; int dff; int ngrp; const float* part; const float* c1; const float* c0; PG8_LAS unsigned char* tab; const float* sw; const float* sa;
    __device__ __forceinline__ void prefetch(const Unit& u, int wid, int lane) const {
        if (!I8_) prefetch_stats(part, u.pm, tab, wid, lane);
        if (wid < 4) { const int v = 2 * wid + (lane >> 5), c4 = (lane & 31) * 4;
            const float* src = (v < 3) ? cw + v * dff : (v == 3) ? cb : (v & 1) ? c0 + ((v - 4) >> 1) * dff : c1 + ((v - 4) >> 1) * dff;
            glds16(src + u.pn * HALF + c4, tab + TAB_CONST + wid * 1024); }
        if (I8_) {
            if (wid == 4) glds16(sw + (lane >> 5) * dff + u.pn * HALF + (lane & 31) * 4, tab + TAB_SW);
            if (wid == 5) glds16(sa + (size_t)u.pm * BM + 4 * lane, tab + TAB_SA); }
    }
    __device__ __forceinline__ void operator()(f32x4 (&acc)[2][2][4][2], const Unit& u, int wr, int wc, int fr, int fq) const {
        const int hc0 = u.pn * HALF + wc * 32 + 8 * fq;
        const PG8_LAS unsigned char* wt_ = tab + TAB_CONST + (wc * 32 + 8 * fq) * 4;
#define PG8_TABV(v_, n_) (*(const PG8_LAS f32x4*)(wt_ + (v_) * 512 + (4 * (n_)) * 4))
        if (MODE == 0 && !I8_) { finalize_stats(tab, (wr * 4 + wc) * 64 + fr + 16 * fq); asm volatile("s_waitcnt lgkmcnt(0)" ::: "memory"); __builtin_amdgcn_s_barrier(); asm volatile("" ::: "memory"); }
#pragma unroll
        for (int ai = 0; ai < 2; ++ai) {
            const int tb = u.pm * BM + ai * HALF + wr * 64, grp = tb >> 6;
            if (MODE == 0 && I8_) {
                float sa4[4];
#pragma unroll
                for (int m = 0; m < 4; ++m) sa4[m] = *(const PG8_LAS float*)(tab + TAB_SA + 4 * (ai * HALF + wr * 64 + 4 * fr + m));
#pragma unroll
                for (int bj = 0; bj < 2; ++bj)
#pragma unroll
                    for (int n = 0; n < 2; ++n) { const f32x4 k0 = PG8_TABV(5 + 2 * bj, n), swv = PG8_TABV(8 + bj, n);
#pragma unroll
                        for (int m = 0; m < 4; ++m) { const f32x4 fv = __builtin_convertvector(__builtin_bit_cast(i32x4, acc[ai][bj][m][n]), f32x4);
                            acc[ai][bj][m][n] = fv * (swv * sa4[m]) + k0; } }
                asm volatile("" ::: "memory");
            }
            if (MODE == 0 && !I8_) {
                RowStat rs[4];
#pragma unroll
                for (int m = 0; m < 4; ++m) rs[m] = stat_tab(tab, ai * HALF + wr * 64 + 4 * fr + m);
#pragma unroll
                for (int bj = 0; bj < 2; ++bj)
#pragma unroll
                    for (int n = 0; n < 2; ++n) { const f32x4 k1 = PG8_TABV(4 + 2 * bj, n), k0 = PG8_TABV(5 + 2 * bj, n);
#pragma unroll
                        for (int m = 0; m < 4; ++m) acc[ai][bj][m][n] = acc[ai][bj][m][n] * rs[m].r + (k1 * rs[m].nmr + k0); }
                asm volatile("" ::: "memory");
            }
            unsigned hp[4][2];
#pragma unroll
            for (int n = 0; n < 2; ++n) {
                const f32x4 w0 = PG8_TABV(0, n), w1 = PG8_TABV(1, n), w2 = PG8_TABV(2, n), cbv = PG8_TABV(3, n);
#pragma unroll
                for (int m = 0; m < 4; ++m) {
                    const int t = tb + 4 * fr + m; const f32x4 gg = acc[ai][0][m][n], up = acc[ai][1][m][n]; f32x4 hv;
                    if (MODE == 1) { hv = gg * up; } else {
                    f32x4 g1, g2;
                    if (m == 0) {
#pragma unroll
                        for (int e = 0; e < 4; ++e) { g1[e] = PG8_DPP0(acc[ai][0][3][n][e], 0x111); g2[e] = PG8_DPP0(acc[ai][0][2][n][e], 0x111); } }
                    else if (m == 1) { g1 = acc[ai][0][0][n];
#pragma unroll
                        for (int e = 0; e < 4; ++e) g2[e] = PG8_DPP0(acc[ai][0][3][n][e], 0x111); }
                    else { g1 = acc[ai][0][m - 1][n]; g2 = acc[ai][0][m - 2][n]; }
                    const f32x4 cv = cbv + w0 * g2 + w1 * g1 + w2 * gg;
                    const f32x2 a = gelu_mul_pk((f32x2){cv[0], cv[1]}, (f32x2){up[0], up[1]}), b = gelu_mul_pk((f32x2){cv[2], cv[3]}, (f32x2){up[2], up[3]});
                    hv = (f32x4){a.x, a.y, b.x, b.y}; }
                    if (MODE == 0 && fr == 0 && m < 2) {
                        *(f32x4*)(G0 + ((size_t)grp * 4 + 2 + m) * dff + hc0 + 4 * n) = gg; *(f32x4*)(UP0 + ((size_t)grp * 2 + m) * dff + hc0 + 4 * n) = up; }
                    if (MODE == 0 && fr == 15 && m >= 2 && grp + 1 < ngrp)
                        *(f32x4*)(G0 + ((size_t)(grp + 1) * 4 + (m - 2)) * dff + hc0 + 4 * n) = gg;
                    const unsigned p0 = cvt_pk_bf16(hv[0], hv[1]), p1 = cvt_pk_bf16(hv[2], hv[3]);
                    if (n == 0) { hp[m][0] = p0; hp[m][1] = p1; }
                    else if (MODE == 2) { asm volatile("" :: "v"(p0), "v"(p1), "v"(hp[m][0]), "v"(hp[m][1])); }
                    else if (m >= 2 || fr > 0) { u32x4 w; w.x = hp[m][0]; w.y = hp[m][1]; w.z = p0; w.w = p1; __builtin_nontemporal_store(w, (u32x4*)(H + (size_t)t * dff + hc0)); }
                }
            }
            asm volatile("" ::: "memory");
        }
#undef PG8_TABV
    }
};
typedef EpiGluT<0> EpiGlu;
typedef EpiGluT<0, true> EpiGlu8;
struct EpiNull {
    static constexpr bool PERM = true, AFTER_DRAIN = false, PERM_A = false, I8 = false;
    __device__ __forceinline__ void prefetch(const Unit&, int, int) const {}
    __device__ __forceinline__ void operator()(f32x4 (&acc)[2][2][4][2], const Unit& u, int wr, int wc, int fr, int fq) const {
#pragma unroll
        for (int ai = 0; ai < 2; ++ai)
#pragma unroll
            for (int bj = 0; bj < 2; ++bj)
#pragma unroll
                for (int m = 0; m < 4; ++m) asm volatile("" :: "v"(acc[ai][bj][m][0]), "v"(acc[ai][bj][m][1]));
    }
};
template <class Epi, class Sched, bool ALIGN_EPI = false, bool SP2 = false>
__device__ __forceinline__ void gemm_phase(PG8_LAS unsigned char* lds, const Gemm g, const Sched& S, const Epi& E, int tid_in) {
    int tid_ = tid_in; asm volatile("" : "+v"(tid_));
    const int tid = tid_, wid = __builtin_amdgcn_readfirstlane(tid >> 6), lane = tid & 63, wr = wid >> 2, wc = wid & 3, fr = lane & 15, fq = lane >> 4;
    const int K = g.K, nt = K / BK;
    unsigned voffA[2], voffB[2];
#pragma unroll
    for (int i = 0; i < 2; ++i) { int R, C; stage_rc(tid * 16 + i * 8192, R, C); const int Rb = Epi::PERM ? ((R & ~31) + perm32(R & 31)) : R;
        const int Ra = Epi::PERM_A ? ((R & ~63) + 4 * (R & 15) + ((R >> 4) & 3)) : R;
        voffA[i] = (unsigned)(Ra * K + C) * 2u; voffB[i] = (unsigned)(Rb * K + C) * 2u; }
    const size_t kstep = (size_t)(BK * 2);
    const size_t hstep = (size_t)HALF * K * 2;
    const size_t tstep = 2 * hstep;
    const unsigned ldsw = (unsigned)wid * 1024u;
    const int aoff = lds_byte(wr * 64 + fr, fq * 8), boff = lds_byte(wc * 32 + fr, fq * 8);
#define PG8_SA(b, h) (((b) * 2 + (h)) * HTB)
#define PG8_SB(b, h) ((4 + (b) * 2 + (h)) * HTB)
#define PG8_STAGE(bufoff, gbase, voff) do { _Pragma("unroll") for (int _i = 0; _i < 2; ++_i) \
        __builtin_amdgcn_global_load_lds((const unsigned*)((const char*)(gbase) + (voff)[_i]), (PG8_LAS unsigned*)(lds + (bufoff) + ldsw + _i * 8192), 16, 0, 0); } while (0)
#define PG8_LDA(dst, b, h) do { _Pragma("unroll") for (int m = 0; m < 4; ++m) _Pragma("unroll") for (int k = 0; k < 2; ++k) dst[m][k] = *(const PG8_LAS bf16x8*)(lds + PG8_SA(b, h) + aoff + m * 2048 + k * 1024); } while (0)
#define PG8_LDB(dst, b, h) do { _Pragma("unroll") for (int n = 0; n < 2; ++n) _Pragma("unroll") for (int k = 0; k < 2; ++k) dst[n][k] = *(const PG8_LAS bf16x8*)(lds + PG8_SB(b, h) + boff + n * 2048 + k * 1024); } while (0)
#define PG8_MMA(ai, bj, At, Bt) do { __builtin_amdgcn_s_setprio(1); _Pragma("unroll") for (int m = 0; m < 4; ++m) _Pragma("unroll") for (int n = 0; n < 2; ++n) _Pragma("unroll") for (int k = 0; k < 2; ++k) \
        { if constexpr (Epi::I8) acc[ai][bj][m][n] = __builtin_bit_cast(f32x4, __builtin_amdgcn_mfma_i32_16x16x64_i8(__builtin_bit_cast(i32x4, Bt[n][k]), __builtin_bit_cast(i32x4, At[m][k]), __builtin_bit_cast(i32x4, acc[ai][bj][m][n]), 0, 0, 0)); \
          else acc[ai][bj][m][n] = __builtin_amdgcn_mfma_f32_16x16x32_bf16(Bt[n][k], At[m][k], acc[ai][bj][m][n], 0, 0, 0); } __builtin_amdgcn_s_setprio(0); } while (0)
#define PG8_WAIT_V(n) asm volatile("s_waitcnt vmcnt(" #n ")" ::: "memory")
#define PG8_WAIT_L(n) asm volatile("s_waitcnt lgkmcnt(" #n ")" ::: "memory")
#define PG8_BAR __builtin_amdgcn_s_barrier()
#define PG8_SCHED __builtin_amdgcn_sched_barrier(0)
    Unit cur, nxt; int ui = 0;
    if (!S.next(0, cur)) return;
    f32x4 acc[2][2][4][2];
    bf16x8 At[4][2], B0[2][2], B1[2][2];
    const char* cA = (const char*)g.A + (size_t)cur.pm * tstep; const char* cB = (const char*)g.Bt + (size_t)cur.pn * tstep;
    S.a_ready(cur);
    if constexpr (SP2) {
        PG8_STAGE(PG8_SB(0, 0), cB, voffB); PG8_STAGE(PG8_SB(0, 1), cB + hstep, voffB); PG8_STAGE(PG8_SA(0, 0), cA, voffA); PG8_STAGE(PG8_SA(0, 1), cA + hstep, voffA);
        if (wr == 1) PG8_BAR;
        PG8_WAIT_V(2); PG8_BAR;
        PG8_STAGE(PG8_SB(1, 0), cB + kstep, voffB); PG8_STAGE(PG8_SA(1, 0), cA + kstep, voffA); PG8_STAGE(PG8_SB(1, 1), cB + hstep + kstep, voffB);
        PG8_WAIT_V(6); PG8_BAR;
    } else {
        PG8_STAGE(PG8_SB(0, 0), cB, voffB); PG8_STAGE(PG8_SA(0, 0), cA, voffA); PG8_STAGE(PG8_SB(0, 1), cB + hstep, voffB); PG8_STAGE(PG8_SA(0, 1), cA + hstep, voffA);
        if (wr == 1) PG8_BAR;
        PG8_WAIT_V(4); PG8_BAR;
        PG8_STAGE(PG8_SB(1, 0), cB + kstep, voffB); PG8_STAGE(PG8_SA(1, 0), cA + kstep, voffA); PG8_STAGE(PG8_SB(1, 1), cB + hstep + kstep, voffB);
        PG8_WAIT_V(6); PG8_BAR;
    }
#pragma unroll
    for (int a = 0; a < 2; ++a)
#pragma unroll
        for (int b = 0; b < 2; ++b)
#pragma unroll
            for (int m = 0; m < 4; ++m)
#pragma unroll
                for (int n = 0; n < 2; ++n) acc[a][b][m][n] = (f32x4){0.f, 0.f, 0.f, 0.f};
    for (;;) {
        const bool has_next = S.next(ui + 1, nxt);
        const char* nA = has_next ? (const char*)g.A + (size_t)nxt.pm * tstep : cA; const char* nB = has_next ? (const char*)g.Bt + (size_t)nxt.pn * tstep : cB;
        { PG8_BAR; int ln_ = (int)__builtin_amdgcn_mbcnt_hi(~0u, __builtin_amdgcn_mbcnt_lo(~0u, 0u)); asm volatile("" : "+v"(ln_)); E.prefetch(cur, wid, ln_); }
        for (int t = 0; t < nt; t += 2) {
            const bool last = (t == nt - 2);
            const char* a1 = cA + (size_t)(t + 1) * kstep;
            const char* a2 = last ? nA : cA + (size_t)(t + 2) * kstep; const char* b2 = last ? nB : cB + (size_t)(t + 2) * kstep;
            const char* a3 = a2 + kstep; const char* b3 = b2 + kstep;
            if (last && has_next) S.a_ready(nxt);
            if constexpr (SP2) {
            PG8_LDB(B0, 0, 0); PG8_LDB(B1, 0, 1); PG8_SCHED; PG8_LDA(At, 0, 0); PG8_STAGE(PG8_SA(1, 1), a1 + hstep, voffA);
            PG8_WAIT_V(8); PG8_WAIT_L(0); PG8_BAR; PG8_MMA(0, 0, At, B0); PG8_MMA(0, 1, At, B1); PG8_BAR; PG8_SCHED;
            PG8_LDA(At, 0, 1); PG8_STAGE(PG8_SB(0, 0), b2, voffB); PG8_STAGE(PG8_SB(0, 1), b2 + hstep, voffB); PG8_STAGE(PG8_SA(0, 0), a2, voffA);
            PG8_WAIT_V(8); PG8_WAIT_L(0); PG8_BAR; PG8_MMA(1, 0, At, B0); PG8_MMA(1, 1, At, B1); PG8_BAR; PG8_SCHED;
            PG8_LDB(B0, 1, 0); PG8_LDB(B1, 1, 1); PG8_SCHED; PG8_LDA(At, 1, 0); PG8_STAGE(PG8_SA(0, 1), a2 + hstep, voffA);
            PG8_WAIT_V(8); PG8_WAIT_L(0); PG8_BAR; PG8_MMA(0, 0, At, B0); PG8_MMA(0, 1, At, B1); PG8_BAR; PG8_SCHED;
            PG8_LDA(At, 1, 1); PG8_STAGE(PG8_SB(1, 0), b3, voffB); PG8_STAGE(PG8_SB(1, 1), b3 + hstep, voffB); PG8_STAGE(PG8_SA(1, 0), a3, voffA);
            PG8_WAIT_V(8); PG8_WAIT_L(0); PG8_BAR; PG8_MMA(1, 0, At, B0); PG8_MMA(1, 1, At, B1); PG8_BAR; PG8_SCHED;
            } else {
            PG8_LDB(B0, 0, 0); PG8_SCHED; PG8_LDA(At, 0, 0); PG8_STAGE(PG8_SA(1, 1), a1 + hstep, voffA);
            PG8_WAIT_L(8); PG8_BAR; PG8_WAIT_L(0); PG8_MMA(0, 0, At, B0); PG8_BAR; PG8_SCHED;
            PG8_LDB(B1, 0, 1); PG8_STAGE(PG8_SB(0, 0), b2, voffB);
            PG8_BAR; PG8_WAIT_L(0); PG8_MMA(0, 1, At, B1); PG8_BAR;
            PG8_LDA(At, 0, 1); PG8_STAGE(PG8_SA(0, 0), a2, voffA);
            PG8_BAR; PG8_WAIT_L(0); PG8_MMA(1, 0, At, B0); PG8_BAR; PG8_SCHED;
            PG8_STAGE(PG8_SB(0, 1), b2 + hstep, voffB);
            PG8_WAIT_V(6); PG8_BAR; PG8_MMA(1, 1, At, B1); PG8_BAR;
            PG8_LDB(B0, 1, 0); PG8_SCHED; PG8_LDA(At, 1, 0); PG8_STAGE(PG8_SA(0, 1), a2 + hstep, voffA);
            PG8_WAIT_L(8); PG8_BAR; PG8_WAIT_L(0); PG8_MMA(0, 0, At, B0); PG8_BAR; PG8_SCHED;
            PG8_LDB(B1, 1, 1); PG8_STAGE(PG8_SB(1, 0), b3, voffB);
            PG8_BAR; PG8_WAIT_L(0); PG8_MMA(0, 1, At, B1); PG8_BAR;
            PG8_LDA(At, 1, 1); PG8_STAGE(PG8_SA(1, 0), a3, voffA);
            PG8_BAR; PG8_WAIT_L(0); PG8_MMA(1, 0, At, B0); PG8_BAR; PG8_SCHED;
            PG8_STAGE(PG8_SB(1, 1), b3 + hstep, voffB);
            PG8_WAIT_V(6); PG8_BAR; PG8_MMA(1, 1, At, B1); PG8_BAR;
            }
        }
        if constexpr (ALIGN_EPI) { if (wr == 0) PG8_BAR; }
        if constexpr (!Epi::AFTER_DRAIN) { int ln_ = (int)__builtin_amdgcn_mbcnt_hi(~0u, __builtin_amdgcn_mbcnt_lo(~0u, 0u)); asm volatile("" : "+v"(ln_));
            E(acc, cur, wr, wc, ln_ & 15, ln_ >> 4); S.done(cur); }
        if (!has_next) break;
#pragma unroll
        for (int a = 0; a < 2; ++a)
#pragma unroll
            for (int b = 0; b < 2; ++b)
#pragma unroll
                for (int m = 0; m < 4; ++m)
#pragma unroll
                    for (int n = 0; n < 2; ++n) acc[a][b][m][n] = (f32x4){0.f, 0.f, 0.f, 0.f};
        cur = nxt; cA = nA; cB = nB; ++ui;
        if constexpr (ALIGN_EPI) { if (wr == 1) PG8_BAR; }
    }
    PG8_WAIT_V(0);
    if constexpr (!ALIGN_EPI) { if (wr == 0) PG8_BAR; }
    PG8_BAR;
    if constexpr (Epi::AFTER_DRAIN) { E.fused(acc, cur, wr, wc, fr, fq, lds, wid, lane); S.done(cur); }
#undef PG8_SA
#undef PG8_SB
#undef PG8_STAGE
#undef PG8_LDA
#undef PG8_LDB
#undef PG8_MMA
#undef PG8_WAIT_V
#undef PG8_WAIT_L
#undef PG8_BAR
#undef PG8_SCHED
}
}
#define GAS __attribute__((address_space(1)))
#define LAS __attribute__((address_space(3)))
typedef unsigned short bf16;
typedef unsigned v4u __attribute__((ext_vector_type(4)));
typedef float f32x4 __attribute__((ext_vector_type(4)));
typedef short bf16x8 __attribute__((ext_vector_type(8)));
typedef GAS unsigned gu32;
typedef GAS unsigned long long gu64;
#define RLX_AGENT __ATOMIC_RELAXED, __HIP_MEMORY_SCOPE_AGENT
#define LDS_WAIT() asm volatile("s_waitcnt lgkmcnt(0)" ::: "memory")
#define VM_WAIT() asm volatile("s_waitcnt vmcnt(0)" ::: "memory")
__device__ __forceinline__ unsigned long long rt() { return __builtin_amdgcn_s_memrealtime(); }

#define XB_TMO      128
#define XB_XCNT(j)  (256  + 64 * (j))
#define XB_XSUB(j)  (1280 + 64 * (j))
#define XB_XGEN(j)  (2304 + 64 * (j))
#define XB_TOP      3328
#define XB_TOPGEN   3392
#define XCD_BAR_WORDS 3456
#define XB_SPIN_CAP (1u << 18)

__device__ __forceinline__ unsigned xb_ld(unsigned* p)              { return __hip_atomic_load(p, __ATOMIC_RELAXED, __HIP_MEMORY_SCOPE_AGENT); }
__device__ __forceinline__ unsigned xb_add(unsigned* p, unsigned v) { return __hip_atomic_fetch_add(p, v, __ATOMIC_RELAXED, __HIP_MEMORY_SCOPE_AGENT); }
__device__ __forceinline__ unsigned xb_xcc_id() { return (unsigned)__builtin_amdgcn_s_getreg((3 << 11) | 20) & 0xFu; }
#define XB_SPIN(cond, bar) do { unsigned _sp = 0; while (cond) { __builtin_amdgcn_s_sleep(1); \
    if ((++_sp & 255u) == 0u) { if (xb_ld(&(bar)[XB_TMO])) break; if (_sp > XB_SPIN_CAP) { atomicAdd(&(bar)[XB_TMO], 1u); break; } } } } while (0)

struct XcdBarrier {
    unsigned* bar; unsigned x;
    volatile LAS unsigned* st;
};

__device__ __forceinline__ XcdBarrier xcd_barrier_post(unsigned* bar, volatile LAS unsigned* st) {
    XcdBarrier b; b.bar = bar; b.x = xb_xcc_id(); b.st = st;
    if (threadIdx.x == 0) (void)xb_add(&bar[XB_XCNT(b.x)], 1u);
    return b;
}
__device__ __forceinline__ void xcd_barrier_complete(unsigned* bar, unsigned x, unsigned& nloc, unsigned& nx) {
    const unsigned G = gridDim.x * gridDim.y * gridDim.z;
    unsigned sum, cnt, mine, sp = 0u;
    for (;;) {
        sum = 0u; cnt = 0u; mine = 0u;
#pragma unroll
        for (unsigned j = 0; j < 16; ++j) { const unsigned c = xb_ld(&bar[XB_XCNT(j)]); sum += c; cnt += (c > 0u) ? 1u : 0u; mine = (j == x) ? c : mine; }
        if (sum == G) break;
        __builtin_amdgcn_s_sleep(1);
        if ((++sp & 255u) == 0u) { if (xb_ld(&bar[XB_TMO])) break; if (sp > XB_SPIN_CAP) { atomicAdd(&bar[XB_TMO], 1u); break; } }
    }
    nloc = mine > 0u ? mine : 1u; nx = cnt > 0u ? cnt : 1u;
}

__device__ __forceinline__ void xcd_barrier(const XcdBarrier& b, bool leader_thread) {
    asm volatile("s_waitcnt vmcnt(0)" ::: "memory");
    __syncthreads();
    if (leader_thread) {
        unsigned* bar = b.bar;
        __builtin_amdgcn_s_waitcnt(0);
        unsigned nloc = b.st[0], nx = b.st[1];
        if (nloc == 0u) { xcd_barrier_complete(bar, b.x, nloc, nx); b.st[0] = nloc; b.st[1] = nx; }
        const unsigned old = xb_add(&bar[XB_XSUB(b.x)], 1u);
        const unsigned gen = old / nloc;
        if (old + 1u == (gen + 1u) * nloc) {
            __builtin_amdgcn_fence(__ATOMIC_RELEASE, "agent");
            asm volatile("s_waitcnt vmcnt(0)" ::: "memory");
            const unsigned og = xb_add(&bar[XB_TOP], 1u);
            const unsigned tg = og / nx;
            if (og + 1u == (tg + 1u) * nx) xb_add(&bar[XB_TOPGEN], 1u);
            else XB_SPIN(xb_ld(&bar[XB_TOPGEN]) == tg, bar);
            __builtin_amdgcn_fence(__ATOMIC_ACQUIRE, "agent");
            xb_add(&bar[XB_XGEN(b.x)], 1u);
            asm volatile("s_waitcnt vmcnt(0)" ::: "memory");
        } else {
            XB_SPIN(xb_ld(&bar[XB_XGEN(b.x)]) == gen, bar);
            __builtin_amdgcn_fence(__ATOMIC_ACQUIRE, "agent");
            asm volatile("s_waitcnt vmcnt(0)" ::: "memory");
        }
    }
    __syncthreads();
}

constexpr int NWAVES = 8;
constexpr size_t WS_CTL = 420 * MiB, CTL_ZERO_BYTES = 64 * 1024;
constexpr size_t WS_XCH = 421 * MiB;
constexpr size_t WS_PARTA = WS_XCH, WS_PARTB = WS_XCH + 1 * MiB, WS_CV = WS_XCH + 2 * MiB, WS_CPART = WS_CV + 256 * 1024;
constexpr int CV_IN1 = 0, CV_UP0 = 2 * 2576, CV_UP1 = CV_UP0 + 2 * 5632, CV_END = CV_UP1 + 2 * 5632;
constexpr int CP_IN1 = 0, CP_UP0 = 16 * 2 * 2576, CP_UP1 = CP_UP0 + 16 * 2 * 5632, CP_END = CP_UP1 + 16 * 2 * 5632;
static_assert(CV_END * 4 <= 256 * 1024 && WS_CPART + (size_t)CP_END * 4 <= WS_XCH + 4 * MiB, "deferred-LN map");
constexpr size_t WS_G0 = 425 * MiB;
constexpr size_t WS_UP0 = 447 * MiB;
constexpr size_t WS_WT = 458 * MiB;
constexpr size_t WT_IN = 0, WT_G = (size_t)2560 * 1024 * 2, WT_OUT = WT_G + 16 * 1024 * 2, WT_UP = WT_OUT + (size_t)1024 * 1024 * 2, WT_DN = WT_UP + (size_t)5632 * 1024 * 2, WT_LAYER = WT_DN + (size_t)1024 * 2816 * 2;
constexpr size_t WS_W8 = 302 * MiB, WS_SWC = 314 * MiB, WS_V8 = 320 * MiB, WS_SA = 353 * MiB;
constexpr size_t WS_MM = 356 * MiB;
constexpr int CW_PANEL = 12288;
constexpr size_t WS_MST = 289 * MiB;
static_assert(WS_WT + 2 * WT_LAYER <= 512 * MiB, "ws map");
constexpr int CW_TMO = 0, CW_CODE = 1, CW_BAR = 4096, CW_SEAM = 16384, SEAM_BANK = 128 * 64;
constexpr int MX_TAB = 131072 + 512;
constexpr int RING_OFF = 0, RING_BYTES = 131072, LDSCTL_OFF = RING_BYTES, MISC_OFF = LDSCTL_OFF + 320, LDS_BYTES = 163840;
constexpr int NPHASE = 15;

struct Frame {
    LAS unsigned char* lds; volatile LAS unsigned* MISC; gu32* ctl; unsigned char* ws; int tid, lane, wave, vcu, G;
};
constexpr int PT_OFF = LDSCTL_OFF + 64;
#define INP(i) inptr(F, (i))
__device__ __forceinline__ const float* inptr(const Frame& F, int i) {
    const volatile LAS unsigned* p = (const volatile LAS unsigned*)(F.lds + PT_OFF) + 2 * i;
    const unsigned lo = __builtin_amdgcn_readfirstlane(p[0]), hi = __builtin_amdgcn_readfirstlane(p[1]);
    return (const float*)(const GAS float*)(((unsigned long long)hi << 32) | lo);
}
struct Args { const float* in[20]; float* out; unsigned char* ws; int ph_lo, ph_hi, bar_region, pad; };

__device__ __forceinline__ unsigned pk2(float lo, float hi) { return f2bf(lo) | ((unsigned)f2bf(hi) << 16); }

__device__ __forceinline__ void p0_transpose_item(const float* W, int K, int N, bf16* WT, int k0, int n0, int drow0, LAS float* scr, int lane, const float* gs, const float* bs, float* cp1, float* cp0) {
    float tv[32];
#pragma unroll
    for (int i = 0; i < 32; ++i) { const int kk = 2 * i + (lane >> 5); tv[i] = __builtin_nontemporal_load((const GAS float*)(W + (size_t)(k0 + kk) * N + n0 + (lane & 31))); }
    if (gs) {
        float s1 = 0.f, s0 = 0.f;
#pragma unroll
        for (int i = 0; i < 32; ++i) { const int kk = 2 * i + (lane >> 5); const float gk = gs[k0 + kk], bk = bs[k0 + kk]; s0 = __builtin_fmaf(bk, tv[i], s0); tv[i] *= gk; s1 += tv[i]; }
        s1 += __shfl_xor(s1, 32); s0 += __shfl_xor(s0, 32);
        if (lane < 32) { cp1[n0 + lane] = s1; cp0[n0 + lane] = s0; }
    }
#pragma unroll
    for (int i = 0; i < 32; ++i) { const int kk = 2 * i + (lane >> 5); scr[kk * 33 + (lane & 31)] = tv[i]; }
    LDS_WAIT(); asm volatile("" ::: "memory");
    const int c = lane & 7;
#pragma unroll
    for (int j = 0; j < 4; ++j) { const int n = (lane >> 3) + 8 * j; const LAS float* s = scr + (8 * c) * 33 + n;
        v4u o; o.x = pk2(s[0 * 33], s[1 * 33]); o.y = pk2(s[2 * 33], s[3 * 33]); o.z = pk2(s[4 * 33], s[5 * 33]); o.w = pk2(s[6 * 33], s[7 * 33]);
        *(GAS v4u*)(WT + (size_t)(drow0 + n) * K + k0 + 8 * c) = o; }
    LDS_WAIT(); asm volatile("" ::: "memory");
}

__device__ __forceinline__ void p0_prologue(Frame& F, const Args& a) {
    LAS float* scr = (LAS float*)(F.lds + RING_OFF + F.wave * 16384);
    const int gw = F.vcu * NWAVES + F.wave, NGW = F.G * NWAVES;
    constexpr int I_IN = 16 * 80, I_OUT = 16 * 32, I_UP = 16 * 176, I_DN = 44 * 32, I_LAYER = I_IN + I_OUT + I_UP + I_DN;
    for (int it = gw; it < DEPTH * I_LAYER; it += NGW) {
        const int l = it / I_LAYER; int r = it % I_LAYER; unsigned char* wt = F.ws + WS_WT + (size_t)l * WT_LAYER;
        float* cpart = (float*)(F.ws + WS_CPART);
        if (r < I_IN) { const int kb = r / 80, nb = r % 80; const bool sc = l > 0;
            p0_transpose_item(INP(1) + (size_t)l * DM * DIN, DM, DIN, (bf16*)(wt + WT_IN), 64 * kb, 32 * nb, 32 * nb, scr, F.lane, sc ? INP(18) + (l - 1) * DM : nullptr, sc ? INP(19) + (l - 1) * DM : nullptr,
                              cpart + CP_IN1 + kb * 2 * 2576, cpart + CP_IN1 + kb * 2 * 2576 + 2576); continue; } r -= I_IN;
        if (r < I_OUT) { const int kb = r / 32, nb = r % 32; p0_transpose_item(INP(11) + (size_t)l * DM * DM, DM, DM, (bf16*)(wt + WT_OUT), 64 * kb, 32 * nb, 32 * nb, scr, F.lane, nullptr, nullptr, nullptr, nullptr); continue; } r -= I_OUT;
        if (r < I_UP) { const int kb = r / 176, nb = r % 176, n0 = 32 * nb; const int isup = n0 >= DFF, c = isup ? n0 - DFF : n0; const int drow = (c >> 7) * 256 + isup * 128 + (c & 127);
            float* cp = cpart + (l == 0 ? CP_UP0 : CP_UP1) + kb * 2 * 5632;
            p0_transpose_item(INP(14) + (size_t)l * DM * 2 * DFF, DM, 2 * DFF, (bf16*)(wt + WT_UP), 64 * kb, n0, drow, scr, F.lane, INP(12) + l * DM, INP(13) + l * DM, cp, cp + 5632); continue; } r -= I_UP;
        { const int kb = r / 32, nb = r % 32; p0_transpose_item(INP(17) + (size_t)l * DFF * DM, DFF, DM, (bf16*)(wt + WT_DN), 64 * kb, 32 * nb, 32 * nb, scr, F.lane, nullptr, nullptr, nullptr, nullptr); }
    }
    for (int i = gw * 64 + F.lane; i < DEPTH * 16 * DM; i += NGW * 64) { const int l = i / (16 * DM), j = (i / DM) % 16, k = i % DM;
        float v = j < 8 ? INP(1)[(size_t)l * DM * DIN + (size_t)k * DIN + ZW + j] : 0.f; if (l > 0) v *= INP(18)[(l - 1) * DM + k];
        ((bf16*)(F.ws + WS_WT + (size_t)l * WT_LAYER + WT_G))[j * DM + k] = f2bf(v); }
    for (int j = gw; j < 8; j += NGW) { float s1 = 0.f, s0 = 0.f;
        for (int k = F.lane; k < DM; k += 64) { const float wv = INP(1)[(size_t)1 * DM * DIN + (size_t)k * DIN + ZW + j]; s1 = __builtin_fmaf(INP(18)[k], wv, s1); s0 = __builtin_fmaf(INP(19)[k], wv, s0); }
#pragma unroll
        for (int o = 1; o < 64; o <<= 1) { s1 += __shfl_xor(s1, o); s0 += __shfl_xor(s0, o); }
        if (F.lane == 0) { float* cv = (float*)(F.ws + WS_CV); cv[CV_IN1 + ZW + j] = s1; cv[CV_IN1 + 2576 + ZW + j] = s0; } }
    const float* x = INP(0); bf16* XN = (bf16*)(F.ws + WS_XN);
    for (size_t i0 = (size_t)gw * 64 + F.lane; i0 < (size_t)M * DM / 8; i0 += (size_t)NGW * 64 * 4) {
        f32x4 v0[4], v1[4];
#pragma unroll
        for (int q = 0; q < 4; ++q) { const size_t i = i0 + (size_t)q * NGW * 64; v0[q] = __builtin_nontemporal_load((const GAS f32x4*)(x + i * 8)); v1[q] = __builtin_nontemporal_load((const GAS f32x4*)(x + i * 8 + 4)); }
#pragma unroll
        for (int q = 0; q < 4; ++q) { const size_t i = i0 + (size_t)q * NGW * 64;
            v4u o; o.x = pk2(v0[q][0], v0[q][1]); o.y = pk2(v0[q][2], v0[q][3]); o.z = pk2(v1[q][0], v1[q][1]); o.w = pk2(v1[q][2], v1[q][3]);
            *(GAS v4u*)(XN + i * 8) = o; } }
}

__device__ __forceinline__ void cvec_finalize(Frame& F, const Args& a) {
    const float* cp = (const float*)(F.ws + WS_CPART); float* cv = (float*)(F.ws + WS_CV);
    const int gt = (F.vcu * NWAVES + F.wave) * 64 + F.lane, NT = F.G * NWAVES * 64;
    for (int i = gt; i < 2 * ZW + 4 * 5632; i += NT) {
        int src, dst, stride, idx = i;
        if (idx < 2 * ZW) { const int v = idx / ZW, n = idx % ZW; src = CP_IN1 + v * 2576 + n; dst = CV_IN1 + v * 2576 + n; stride = 2 * 2576; }
        else { idx -= 2 * ZW; const int m = idx / (2 * 5632), e = idx % (2 * 5632); src = (m ? CP_UP1 : CP_UP0) + e; dst = (m ? CV_UP1 : CV_UP0) + e; stride = 2 * 5632; }
        float sacc = 0.f;
#pragma unroll
        for (int kb = 0; kb < 16; ++kb) sacc += cp[src + kb * stride];
        cv[dst] = sacc; }
}
__device__ __forceinline__ float wave_max(float x) {
#pragma unroll
    for (int o = 32; o > 0; o >>= 1) x = fmaxf(x, __shfl_xor(x, o)); return x; }
__device__ __forceinline__ float wave_fsum(float x) {
#pragma unroll
    for (int o = 32; o > 0; o >>= 1) x += __shfl_xor(x, o); return x; }
__device__ __forceinline__ int wave_isum(int x) {
#pragma unroll
    for (int o = 32; o > 0; o >>= 1) x += __shfl_xor(x, o); return x; }
__device__ __forceinline__ void quant_unpack(const v4u a, const v4u b, float (&x)[16]) {
#pragma unroll
    for (int e = 0; e < 4; ++e) { x[2 * e] = __uint_as_float(a[e] << 16); x[2 * e + 1] = __uint_as_float(a[e] & 0xffff0000u); x[8 + 2 * e] = __uint_as_float(b[e] << 16); x[8 + 2 * e + 1] = __uint_as_float(b[e] & 0xffff0000u); }
}
__device__ __forceinline__ float quant_row16(const float (&x)[16], unsigned (&q8)[4], int& isum) {
    float am = 0.f;
#pragma unroll
    for (int e = 0; e < 16; ++e) am = fmaxf(am, fabsf(x[e]));
    am = wave_max(am);
    const float inv = am > 0.f ? 127.0f / am : 0.f;
    isum = 0;
#pragma unroll
    for (int j = 0; j < 4; ++j) { unsigned w = 0u;
#pragma unroll
        for (int e = 0; e < 4; ++e) { const int q = (int)__builtin_rintf(x[4 * j + e] * inv); isum += q; w |= ((unsigned)q & 0xffu) << (8 * e); }
        q8[j] = w; }
    return am * (1.0f / 127.0f);
}
typedef unsigned v2u __attribute__((ext_vector_type(2)));
__device__ __forceinline__ void quant_w_step(Frame& F) {
    const int gw = F.vcu * NWAVES + F.wave, NGW = F.G * NWAVES, lane = F.lane;
    for (int rr = gw; rr < DEPTH * 2 * DFF; rr += NGW) {
        const int l = rr / (2 * DFF), n = rr % (2 * DFF);
        const bf16* src = (const bf16*)(F.ws + WS_WT + (size_t)l * WT_LAYER + WT_UP) + (size_t)n * DM;
        const v4u a = *(const GAS v4u*)(src + 8 * lane), b = *(const GAS v4u*)(src + 512 + 8 * lane);
        float x[16]; quant_unpack(a, b, x);
        unsigned q8[4]; int isum; const float sc = quant_row16(x, q8, isum);
        isum = wave_isum(isum);
        unsigned char* dst = F.ws + WS_W8 + ((size_t)l * 2 * DFF + n) * DM;
        *(GAS v2u*)(dst + 8 * lane) = (v2u){q8[0], q8[1]}; *(GAS v2u*)(dst + 512 + 8 * lane) = (v2u){q8[2], q8[3]};
        if (lane == 0) { float* swc = (float*)(F.ws + WS_SWC) + (size_t)l * 4 * DFF; const int idx = ((n & 255) >= 128 ? DFF : 0) + 128 * (n >> 8) + (n & 127);
            swc[idx] = sc; swc[2 * DFF + idx] = sc * (float)isum; }
    }
}
__device__ __forceinline__ void gates_phase(Frame& F, const bf16* XN, const bf16* WG, float* GT, const float* part, const float* c1, const float* c0) {
    const int gw = F.vcu * NWAVES + F.wave, NGW = F.G * NWAVES, l15 = F.lane & 15, lq = F.lane >> 4;
    for (int blk = gw; blk < M / 16; blk += NGW) {
        const bf16* ap = XN + (size_t)(blk * 16 + l15) * DM + 8 * lq; const bf16* bp = WG + (size_t)l15 * DM + 8 * lq;
        f32x4 acc = (f32x4){0.f, 0.f, 0.f, 0.f};
#pragma unroll 16
        for (int ks = 0; ks < DM / 32; ++ks) { const bf16x8 av = *(const GAS bf16x8*)(ap + ks * 32), bv = *(const GAS bf16x8*)(bp + ks * 32);
            acc = __builtin_amdgcn_mfma_f32_16x16x32_bf16(av, bv, acc, 0, 0, 0); }
        if (l15 < 8) {
            float k1 = 0.f, k0 = 0.f; if (part) { k1 = c1[l15]; k0 = c0[l15]; }
#pragma unroll
            for (int r = 0; r < 4; ++r) { const size_t row = (size_t)(blk * 16 + 4 * lq + r); float v = acc[r];
                if (part) { const pg8::RowStat rs = pg8::row_stat(part, row, LN_EPS); v = v * rs.r + (k1 * rs.nmr + k0); }
                GT[row * 8 + l15] = v; } }
    }
}

__device__ __forceinline__ void glu_fixup_phase(Frame& F, const float* G0, const float* UP0, const float* cw, const float* cb, bf16* H) {
    const int gt = (F.vcu * NWAVES + F.wave) * 64 + F.lane, NT = F.G * NWAVES * 64;
    constexpr int C4 = DFF / 4, NIT = (M / 64) * 2 * C4;
    for (int i0 = gt; i0 < NIT; i0 += 3 * NT) {
        f32x4 s0[3], s1[3], s2[3], up[3], w0[3], w1[3], w2[3], bb[3]; int rr[3], gg[3], cc[3]; bool ok[3];
#pragma unroll
        for (int q = 0; q < 3; ++q) { const int i = i0 + q * NT; ok[q] = i < NIT; const int ii = ok[q] ? i : gt;
            const int c = (ii % C4) * 4, r = (ii / C4) & 1, grp = ii / (2 * C4); rr[q] = r; gg[q] = grp; cc[q] = c;
            const float* gp = G0 + ((size_t)grp * 4 + r) * DFF + c;
            s0[q] = *(const GAS f32x4*)gp; s1[q] = *(const GAS f32x4*)(gp + DFF); s2[q] = *(const GAS f32x4*)(gp + 2 * DFF);
            up[q] = *(const GAS f32x4*)(UP0 + ((size_t)grp * 2 + r) * DFF + c);
            w0[q] = *(const GAS f32x4*)(cw + c); w1[q] = *(const GAS f32x4*)(cw + DFF + c); w2[q] = *(const GAS f32x4*)(cw + 2 * DFF + c); bb[q] = *(const GAS f32x4*)(cb + c); }
#pragma unroll
        for (int q = 0; q < 3; ++q) { if (!ok[q]) continue;
            const bool bs = (gg[q] & (SEQ / 64 - 1)) == 0;
            const f32x4 z = (f32x4){0.f, 0.f, 0.f, 0.f}; const f32x4 a0 = bs ? z : s0[q], a1 = (bs && rr[q] == 0) ? z : s1[q];
            const f32x4 cv = bb[q] + w0[q] * a0 + w1[q] * a1 + w2[q] * s2[q];
            const pg8::f32x2 ha = pg8::gelu_mul_pk((pg8::f32x2){cv[0], cv[1]}, (pg8::f32x2){up[q][0], up[q][1]}), hb = pg8::gelu_mul_pk((pg8::f32x2){cv[2], cv[3]}, (pg8::f32x2){up[q][2], up[q][3]});
            unsigned long long o = (unsigned long long)pg8::cvt_pk_bf16(ha.x, ha.y) | ((unsigned long long)pg8::cvt_pk_bf16(hb.x, hb.y) << 32);
            *(GAS unsigned long long*)(H + (size_t)(gg[q] * 64 + rr[q]) * DFF + cc[q]) = o; }
    }
}

struct SameTileOrder {
    int n, pm0, pn0;
    __device__ bool next(int i, pg8::Unit& u) const { if (i >= n) return false; u.pm = pm0; u.pn = pn0; return true; }
    __device__ __forceinline__ void a_ready(const pg8::Unit&) const {}
    __device__ __forceinline__ void done(const pg8::Unit&) const {}
};
struct OneUnit {
    int pm, pn;
    __device__ bool next(int i, pg8::Unit& u) const { if (i != 0) return false; u.pm = pm; u.pn = pn; return true; }
    __device__ __forceinline__ void a_ready(const pg8::Unit&) const {}
    __device__ __forceinline__ void done(const pg8::Unit&) const {}
};

__device__ __forceinline__ void res_gemm_phase(Frame& F, const bf16* A, const bf16* Bt, int K, bf16* V, bf16* Vout, const float* part_prev, const float* gp, const float* bp, float* part_new) {
    pg8::Gemm gm{A, Bt, M, DM, K}; pg8::StaticOrder S; S.init(M, DM, F.G, (int)blockIdx.x);
    pg8::EpiRes E{V, Vout, DM, part_prev, gp, bp, part_new, F.lds + MX_TAB, nullptr, nullptr, nullptr, nullptr, nullptr, nullptr, nullptr};
    pg8::gemm_phase<pg8::EpiRes, pg8::StaticOrder, true, true>(F.lds + RING_OFF, gm, S, E, F.tid);
}
__device__ __forceinline__ void res_gemm_phase_q(Frame& F, const bf16* A, const bf16* Bt, int K, bf16* V, bf16* Vout, const float* part_prev, const float* gp, const float* bp, float* part_new, unsigned* cnt) {
    pg8::Gemm gm{A, Bt, M, DM, K}; pg8::StaticOrder S; S.init(M, DM, F.G, (int)blockIdx.x);
    pg8::EpiResQ E{V, Vout, DM, part_prev, gp, bp, part_new, F.lds + MX_TAB, F.ws + WS_V8, (float*)(F.ws + WS_SA), (float*)(F.ws + WS_MM), cnt, nullptr, nullptr, nullptr};
    pg8::gemm_phase<pg8::EpiResQ, pg8::StaticOrder, true, true>(F.lds + RING_OFF, gm, S, E, F.tid);
}
__device__ __forceinline__ void res_gemm_phase_f(Frame& F, const bf16* A, const bf16* Bt, int K, bf16* V, const float* part_prev, const float* gp, const float* bp, float* part_new, unsigned* cnt, const float* gF, const float* bF, float* out) {
    pg8::Gemm gm{A, Bt, M, DM, K}; pg8::StaticOrder S; S.init(M, DM, F.G, (int)blockIdx.x);
    pg8::EpiResF E{V, V, DM, part_prev, gp, bp, part_new, F.lds + MX_TAB, nullptr, nullptr, nullptr, cnt, gF, bF, out};
    pg8::gemm_phase<pg8::EpiResF, pg8::StaticOrder, true, true>(F.lds + RING_OFF, gm, S, E, F.tid);
}
typedef short s16x4t __attribute__((ext_vector_type(4)));
constexpr int MX_KW = 72768, MX_HSB = 81984;
constexpr int MX_RAWQK = 0, MX_RAWV = 18496, MX_HS = 0, MX_QS = 35904, MX_KS = 45120, MX_QP = 54336, MX_SS = 63552, MX_KWT = 72768, MX_VST = 81984, MX_CST = 102720, MX_CWB = 123456, MX_DEN = 126016;
constexpr int MX_GA = LDSCTL_OFF + 512;
constexpr int ST_FLOATS = 64 * 144 + 64;
typedef short s16x4v __attribute__((ext_vector_type(4)));

__device__ __forceinline__ float fexp(float x) { return __expf(x); }
__device__ __forceinline__ unsigned pkbf(float lo, float hi) { return pg8::cvt_pk_bf16(lo, hi); }
#define MX_DPPF(x, ctrl) __builtin_bit_cast(float, __builtin_amdgcn_update_dpp(0, __builtin_bit_cast(int, (float)(x)), (ctrl), 0xf, 0xf, true))
__device__ __forceinline__ float row_sum16(float x) {
    x += MX_DPPF(x, 0xB1); x += MX_DPPF(x, 0x4E); x += MX_DPPF(x, 0x141); x += MX_DPPF(x, 0x140); return x;
}
#define MX_LDS_FENCE() asm volatile("s_waitcnt lgkmcnt(0)" ::: "memory")

__device__ __forceinline__ bf16x8 mx_trfrag16(LAS unsigned char* lp, int coff, int pitch) {
    const s16x4t t0 = __builtin_amdgcn_ds_read_tr16_b64_v4i16((LAS s16x4t*)(lp + coff)), t1 = __builtin_amdgcn_ds_read_tr16_b64_v4i16((LAS s16x4t*)(lp + coff + 16 * pitch));
    return __builtin_shufflevector(t0, t1, 0, 1, 2, 3, 4, 5, 6, 7);
}
__device__ __forceinline__ bf16x8 mx_trfrag(LAS unsigned char* lp, int coff, int pitch) {
    const s16x4t t0 = __builtin_amdgcn_ds_read_tr16_b64_v4i16((LAS s16x4t*)(lp + coff)), t1 = __builtin_amdgcn_ds_read_tr16_b64_v4i16((LAS s16x4t*)(lp + coff + 4 * pitch));
    return __builtin_shufflevector(t0, t1, 0, 1, 2, 3, 4, 5, 6, 7);
}
template <bool OUT>
__device__ __forceinline__ void mlstm_phase(Frame& F, const Args& args, int l) {
    const int tid = F.tid, lane = F.lane, w = F.wave, l15 = lane & 15, lq = lane >> 4;
    unsigned char* ws = F.ws;
    const bf16* Z = (const bf16*)(ws + WS_Z); const float* GT = (const float*)(ws + WS_GT); bf16* Y = (bf16*)(ws + WS_Y); float* ST = (float*)(ws + WS_MST);
    const int u = F.vcu, b = u >> 6, h = (u >> 4) & 3, seg = u & 15;
    if (!OUT && seg == 15) return;
    const size_t gr_seg = (size_t)b * SEQ + (size_t)seg * 512;
    LAS unsigned char* L = F.lds;
    LAS float* gA = (LAS float*)(L + MX_GA); LAS float* gMX = gA + 512; LAS float* gFL = gA + 1024; LAS float* gBend = gA + 1536; LAS float* gAmax = gA + 1544; LAS float* gMP = gA + 1552; LAS float* gMXE = gA + 1560;
    LAS float* cwb = (LAS float*)(L + MX_CWB);
    const float* qcw = INP(4) + (size_t)l * 4 * 512; const float* qcb = INP(5) + l * 512;
    for (int i = tid; i < 640; i += 512) { const int j = i >> 7, c = i & 127; const int ch = (c < 64) ? (64 * h + c) : (256 + 64 * h + c - 64);
        cwb[i] = (j < 4) ? qcw[j * 512 + ch] : qcb[ch]; }
    if (tid < 64) *(LAS v4u*)(L + MX_RAWV + tid * 272 + 256) = (v4u){0x00003F80u, 0u, 0u, 0u};
    for (int i = tid; i < 144 * 72 / 2; i += 512) ((LAS unsigned*)(L + MX_CST))[i] = 0u;
    float bpos, apos, cmax;
    {
        const size_t t = gr_seg + 64 * w + lane; const float bi = INP(2)[l * 4 + h], bfg = INP(3)[l * 4 + h];
        const float ig = GT[t * 8 + h] + bi, lf = logsigmoid_f(GT[t * 8 + 4 + h] + bfg);
        float s = lf;
#pragma unroll
        for (int o = 1; o < 64; o <<= 1) { const float v = __shfl_up(s, o); if (lane >= o) s += v; }
        bpos = s; apos = ig - s; float c = apos;
#pragma unroll
        for (int o = 1; o < 64; o <<= 1) { const float v = __shfl_up(c, o); if (lane >= o) c = fmaxf(c, v); }
        cmax = c;
        gA[64 * w + lane] = apos;
        if (lane == 63) { gBend[w] = bpos; gAmax[w] = cmax; }
    }
    __syncthreads();
    float m_init = -INFINITY; asm volatile("" : "+v"(m_init));
    f32x4 cacc[4], nacc;
#pragma unroll
    for (int i = 0; i < 4; ++i) cacc[i] = (f32x4){0.f, 0.f, 0.f, 0.f};
    nacc = (f32x4){0.f, 0.f, 0.f, 0.f};
    if (OUT) {
        float ml_l = -INFINITY, bs_l = 0.f;
        if (lane < seg) { const float* sp_ = ST + (size_t)(u - seg + lane) * ST_FLOATS + 64 * 144; ml_l = sp_[0]; bs_l = sp_[1]; }
        float m_run = 0.f;
        for (int sp = 0; sp < seg; ++sp) m_run = fmaxf(__shfl(bs_l, sp) + m_run, __shfl(ml_l, sp));
        float pre = bs_l;
#pragma unroll
        for (int o = 1; o < 16; o <<= 1) { const float v = __shfl_up(pre, o); if (lane >= o) pre += v; }
        const float tot = __shfl(pre, 15);
        const float wgt_l = (lane < seg) ? fexp(ml_l + (tot - pre) - m_run) : 0.f;
#pragma unroll 1
        for (int sp0 = 0; sp0 < seg; sp0 += 3) {
            float v[3][16], vn[3][4], wj[3];
#pragma unroll
            for (int j = 0; j < 3; ++j) { const int sp = (sp0 + j < seg) ? sp0 + j : seg - 1; const float* st = ST + (size_t)(u - seg + sp) * ST_FLOATS;
                wj[j] = (sp0 + j < seg) ? __shfl(wgt_l, sp) : 0.f;
#pragma unroll
                for (int mt = 0; mt < 4; ++mt)
#pragma unroll
                    for (int r = 0; r < 4; ++r) v[j][4 * mt + r] = st[(16 * mt + 4 * lq + r) * 144 + 16 * w + l15];
#pragma unroll
                for (int r = 0; r < 4; ++r) vn[j][r] = (w < 4) ? st[(16 * w + 4 * lq + r) * 144 + 128 + l15] : 0.f; }
#pragma unroll
            for (int j = 0; j < 3; ++j) {
#pragma unroll
                for (int mt = 0; mt < 4; ++mt)
#pragma unroll
                    for (int r = 0; r < 4; ++r) cacc[mt][r] += wj[j] * v[j][4 * mt + r];
#pragma unroll
                for (int r = 0; r < 4; ++r) nacc[r] += wj[j] * vn[j][r]; }
        }
        m_init = m_run;
    }
    { float mp = m_init, mpw = m_init;
#pragma unroll
      for (int n = 0; n < 8; ++n) { const float mxe = fmaxf(mp, gAmax[n]); if (tid == 0) { gMP[n] = mp; gMXE[n] = mxe; } mpw = (w == n) ? mp : mpw; mp = gBend[n] + mxe; }
      if (!OUT) { if (tid == 0) { float bsum = 0.f;
#pragma unroll
            for (int n = 0; n < 8; ++n) bsum += gBend[n];
            ST[(size_t)u * ST_FLOATS + 64 * 144] = mp; ST[(size_t)u * ST_FLOATS + 64 * 144 + 1] = bsum; } }
      if (OUT) {
        const float mx = fmaxf(cmax, mpw); gMX[64 * w + lane] = mx; gFL[64 * w + lane] = fexp(-(bpos + mx));
#pragma unroll
        for (int mt = 0; mt < 4; ++mt) { unsigned long long v = (unsigned long long)pkbf(cacc[mt][0], cacc[mt][1]) | ((unsigned long long)pkbf(cacc[mt][2], cacc[mt][3]) << 32);
            *(LAS unsigned long long*)(L + MX_CST + ((16 * w + l15) * 72 + 16 * mt + 4 * lq) * 2) = v; }
        if (w < 4) { unsigned long long v = (unsigned long long)pkbf(nacc[0], nacc[1]) | ((unsigned long long)pkbf(nacc[2], nacc[3]) << 32);
            *(LAS unsigned long long*)(L + MX_CST + ((128 + l15) * 72 + 16 * w + 4 * lq) * 2) = v; }
      } }
    float gain[8];
    if (OUT) {
#pragma unroll
        for (int e = 0; e < 8; ++e) gain[e] = INP(10)[l * 512 + h * 128 + 8 * (tid & 15) + e]; }
    v4u rq[2][3], rv[2][2], ro[2];
#define MX_LOAD_RAW(n_, ps_) do { \
        const size_t gr0 = gr_seg + 64 * (n_); const int tc = seg * 512 + 64 * (n_); \
        _Pragma("unroll") \
        for (int k = 0; k < (OUT ? 3 : 2); ++k) { const int p = tid + 512 * k; const int r = OUT ? p >> 4 : p >> 3, c = OUT ? p & 15 : 8 + (p & 7); v4u v = (v4u){0u, 0u, 0u, 0u}; \
            if (p < (OUT ? 67 * 16 : 67 * 8) && tc - 3 + r >= 0) { const GAS v4u* zp_ = (const GAS v4u*)(Z + (gr0 + r - 3) * ZW + (c < 8 ? 1024 + 64 * h + 8 * c : 1280 + 64 * h + 8 * (c - 8))); v = OUT ? __builtin_nontemporal_load(zp_) : *zp_; } \
            rq[ps_][k] = v; } \
        _Pragma("unroll") \
        for (int k = 0; k < 2; ++k) { const int p = tid + 512 * k; const int r = p >> 4, c = p & 15; \
            { const GAS v4u* zp_ = (const GAS v4u*)(Z + (gr0 + r) * ZW + 1536 + 128 * h + 8 * c); rv[ps_][k] = OUT ? __builtin_nontemporal_load(zp_) : *zp_; } \
            } \
    } while (0)
#define MX_LOAD_O(n_) do { _Pragma("unroll") for (int k = 0; k < 2; ++k) { const int p = tid + 512 * k; ro[k] = __builtin_nontemporal_load((const GAS v4u*)(Z + (gr_seg + 64 * (n_) + (p >> 4)) * ZW + 2048 + 128 * h + 8 * (p & 15))); } } while (0)
    MX_LOAD_RAW(0, 0); MX_LOAD_RAW(1, 1);
    if (OUT) MX_LOAD_O(0);
    __syncthreads();
#pragma unroll 1
    for (int n2 = 0; n2 < 8; n2 += 2) {
#pragma unroll
    for (int par = 0; par < 2; ++par) { const int n = n2 + par;
        int tid_ = F.tid; asm volatile("" : "+v"(tid_));
        const int tid = tid_, lane = tid & 63, l15 = lane & 15, lq = lane >> 4;
        LAS unsigned char* const lpV = L + MX_RAWV + (8 * lq + (l15 >> 2)) * 272 + 8 * (l15 & 3); LAS unsigned char* const lpK = L + MX_KW + (8 * lq + (l15 >> 2)) * 144 + 8 * (l15 & 3); LAS unsigned char* const lpV2 = L + MX_RAWV + (4 * lq + (l15 >> 2)) * 272 + 8 * (l15 & 3);
#pragma unroll
        for (int k = 0; k < (OUT ? 3 : 2); ++k) { const int p = tid + 512 * k; if (p < (OUT ? 67 * 16 : 67 * 8)) *(LAS v4u*)(L + MX_RAWQK + (OUT ? p >> 4 : p >> 3) * 272 + (OUT ? p & 15 : 8 + (p & 7)) * 16) = rq[par][k]; }
#pragma unroll
        for (int k = 0; k < 2; ++k) { const int p = tid + 512 * k; *(LAS v4u*)(L + MX_RAWV + (p >> 4) * 272 + (p & 15) * 16) = rv[par][k]; }
        __syncthreads();
        if (n + 2 < 8) MX_LOAD_RAW(n + 2, par);
        {
            const int s = lane;
            const float mxe = gMXE[n], mpv = gMP[n], a_s = gA[64 * n + s]; float mxs = 0.f; if (OUT) mxs = gMX[64 * n + s];
#pragma unroll
            for (int qk = (OUT ? 0 : 1); qk < 2; ++qk) {
                const int cb0 = 64 * qk + 8 * w;
                v4u rw[4]; f32x4 cw4[5][2];
#pragma unroll
                for (int j = 0; j < 4; ++j) rw[j] = *(const LAS v4u*)(L + MX_RAWQK + (s + j) * 272 + cb0 * 2);
#pragma unroll
                for (int j = 0; j < 5; ++j) { cw4[j][0] = *(const LAS f32x4*)(cwb + j * 128 + cb0); cw4[j][1] = *(const LAS f32x4*)(cwb + j * 128 + cb0 + 4); }
                MX_LDS_FENCE();
                float acc[8];
#pragma unroll
                for (int e = 0; e < 8; ++e) acc[e] = cw4[4][e >> 2][e & 3];
#pragma unroll
                for (int j = 0; j < 4; ++j)
#pragma unroll
                    for (int e2 = 0; e2 < 4; ++e2) { const unsigned x = rw[j][e2];
                        acc[2 * e2] = __builtin_fmaf(cw4[j][(2 * e2) >> 2][(2 * e2) & 3], __uint_as_float(x << 16), acc[2 * e2]);
                        acc[2 * e2 + 1] = __builtin_fmaf(cw4[j][(2 * e2 + 1) >> 2][(2 * e2 + 1) & 3], __uint_as_float(x & 0xffff0000u), acc[2 * e2 + 1]); }
#pragma unroll
                for (int e = 0; e < 8; ++e) acc[e] = acc[e] * __builtin_amdgcn_rcpf(1.0f + fexp(-acc[e]));
                if (qk == 0) {
                    const float wi = fexp(mpv - mxs);
                    v4u o; o.x = pkbf(acc[0], acc[1]); o.y = pkbf(acc[2], acc[3]); o.z = pkbf(acc[4], acc[5]); o.w = pkbf(acc[6], acc[7]);
                    *(LAS v4u*)(L + MX_QS + (s * 72 + 8 * w) * 2) = o;
                    v4u p; p.x = pkbf(acc[0] * wi, acc[1] * wi); p.y = pkbf(acc[2] * wi, acc[3] * wi); p.z = pkbf(acc[4] * wi, acc[5] * wi); p.w = pkbf(acc[6] * wi, acc[7] * wi);
                    *(LAS v4u*)(L + MX_QP + (s * 72 + 8 * w) * 2) = p;
                } else {
                    const float kwt = 0.125f * fexp(a_s - mxe);
                    if (OUT) { v4u o; o.x = pkbf(acc[0] * 0.125f, acc[1] * 0.125f); o.y = pkbf(acc[2] * 0.125f, acc[3] * 0.125f); o.z = pkbf(acc[4] * 0.125f, acc[5] * 0.125f); o.w = pkbf(acc[6] * 0.125f, acc[7] * 0.125f);
                        *(LAS v4u*)(L + MX_KS + (s * 72 + 8 * w) * 2) = o; }
                    { v4u kq; kq.x = pkbf(acc[0] * kwt, acc[1] * kwt); kq.y = pkbf(acc[2] * kwt, acc[3] * kwt); kq.z = pkbf(acc[4] * kwt, acc[5] * kwt); kq.w = pkbf(acc[6] * kwt, acc[7] * kwt);
                      *(LAS v4u*)(L + MX_KW + (s * 72 + 8 * w) * 2) = kq; }
                }
            }
        }
        __syncthreads();
        if (OUT) {
            const int mt = w >> 1;
            unsigned sp_[4][2];
            { const float mxt = gMX[64 * n + 16 * mt + l15]; const int t = 16 * mt + l15;
#pragma unroll
              for (int nt = 0; nt < 4; ++nt) { sp_[nt][0] = 0u; sp_[nt][1] = 0u;
                if (nt <= mt) { f32x4 sa = (f32x4){0.f, 0.f, 0.f, 0.f};
#pragma unroll
                    for (int ks = 0; ks < 2; ++ks) { const bf16x8 av = *(const LAS bf16x8*)(L + MX_QS + ((16 * mt + l15) * 72 + 32 * ks + 8 * lq) * 2), bv = *(const LAS bf16x8*)(L + MX_KS + ((16 * nt + l15) * 72 + 32 * ks + 8 * lq) * 2);
                        sa = __builtin_amdgcn_mfma_f32_16x16x32_bf16(bv, av, sa, 0, 0, 0); }
                    const f32x4 a4 = *(const LAS f32x4*)(gA + 64 * n + 16 * nt + 4 * lq);
                    float sw[4];
#pragma unroll
                    for (int r = 0; r < 4; ++r) { const int sidx = 16 * nt + 4 * lq + r; sw[r] = (sidx <= t) ? sa[r] * fexp(a4[r] - mxt) : 0.f; }
                    sp_[nt][0] = pkbf(sw[0], sw[1]); sp_[nt][1] = pkbf(sw[2], sw[3]); } } }
            f32x4 na[4], da = (f32x4){0.f, 0.f, 0.f, 0.f};
#pragma unroll
            for (int i = 0; i < 4; ++i) na[i] = (f32x4){0.f, 0.f, 0.f, 0.f};
#pragma unroll
            for (int ks = 0; ks < 4; ++ks) {
                if (ks < 2 && 2 * ks > mt) continue;
                const int aoff = MX_QP + ((16 * mt + l15) * 72 + 32 * (ks & 1) + 8 * lq) * 2, bbase = MX_CST + (32 * (ks & 1) + 8 * lq) * 2;
                bf16x8 av;
                if (ks < 2) { const v4u pk4 = (v4u){sp_[2 * (ks & 1)][0], sp_[2 * (ks & 1)][1], sp_[2 * (ks & 1) + 1][0], sp_[2 * (ks & 1) + 1][1]}; av = __builtin_bit_cast(bf16x8, pk4); }
                else av = *(const LAS bf16x8*)(L + aoff);
#pragma unroll
                for (int i = 0; i < 4; ++i) { const int nt = 4 * (w & 1) + i;
                    const bf16x8 bv = (ks < 2) ? mx_trfrag16(lpV2, 32 * (ks & 1) * 272 + 32 * nt, 272) : *(const LAS bf16x8*)(L + bbase + (16 * nt + l15) * 144);
                    na[i] = __builtin_amdgcn_mfma_f32_16x16x32_bf16(bv, av, na[i], 0, 0, 0); }
                if ((w & 1) == 0) { const bf16x8 bv = (ks < 2) ? mx_trfrag16(lpV2, 32 * (ks & 1) * 272 + 256, 272) : *(const LAS bf16x8*)(L + bbase + (128 + l15) * 144);
                    da = __builtin_amdgcn_mfma_f32_16x16x32_bf16(bv, av, da, 0, 0, 0); }
            }
            LAS unsigned char* const hsp = L + MX_HSB + ((16 * mt + l15) * 136 + 64 * (w & 1) + 4 * lq) * 2;
#pragma unroll
            for (int i = 0; i < 4; ++i) {
                *(LAS v2u*)(hsp + 32 * i) = (v2u){pkbf(na[i][0], na[i][1]), pkbf(na[i][2], na[i][3])}; }
            if ((w & 1) == 0 && lq == 0) ((LAS float*)(L + MX_DEN))[16 * mt + l15] = da[0];
        }
        if (!OUT || n < 7) {
            const float dec = fexp(gMP[n] - gMXE[n]);
#pragma unroll
            for (int mt2 = 0; mt2 < 4; ++mt2) cacc[mt2] = cacc[mt2] * dec;
            nacc = nacc * dec;
#pragma unroll
            for (int ks = 0; ks < 2; ++ks) { const bf16x8 bv = mx_trfrag(lpV + 32 * w, 32 * ks * 272, 272);
#pragma unroll
                for (int mt2 = 0; mt2 < 4; ++mt2) { const bf16x8 av = mx_trfrag(lpK, 32 * ks * 144 + 32 * mt2, 144);
                    cacc[mt2] = __builtin_amdgcn_mfma_f32_16x16x32_bf16(av, bv, cacc[mt2], 0, 0, 0); }
                if (w < 4) { const bf16x8 av = mx_trfrag(lpK + 32 * w, 32 * ks * 144, 144), bn = mx_trfrag(lpV, 32 * ks * 272 + 256, 272);
                    nacc = __builtin_amdgcn_mfma_f32_16x16x32_bf16(av, bn, nacc, 0, 0, 0); } }
        }
        __syncthreads();
        if (OUT) {
            if (n < 7) {
#pragma unroll
            for (int mt2 = 0; mt2 < 4; ++mt2) { unsigned long long v = (unsigned long long)pkbf(cacc[mt2][0], cacc[mt2][1]) | ((unsigned long long)pkbf(cacc[mt2][2], cacc[mt2][3]) << 32);
                *(LAS unsigned long long*)(L + MX_CST + ((16 * w + l15) * 72 + 16 * mt2 + 4 * lq) * 2) = v; }
            if (w < 4) { unsigned long long v = (unsigned long long)pkbf(nacc[0], nacc[1]) | ((unsigned long long)pkbf(nacc[2], nacc[3]) << 32);
                *(LAS unsigned long long*)(L + MX_CST + ((128 + l15) * 72 + 16 * w + 4 * lq) * 2) = v; } }
            f32x4 hh[2][2]; float dn[2], flr[2];
#pragma unroll
            for (int k = 0; k < 2; ++k) { const int id = tid + 512 * k, t = id >> 4, c = id & 15;
                { const v4u hw = *(const LAS v4u*)(L + MX_HSB + (t * 136 + 8 * c) * 2);
                  hh[k][0] = (f32x4){__uint_as_float(hw[0] << 16), __uint_as_float(hw[0] & 0xffff0000u), __uint_as_float(hw[1] << 16), __uint_as_float(hw[1] & 0xffff0000u)};
                  hh[k][1] = (f32x4){__uint_as_float(hw[2] << 16), __uint_as_float(hw[2] & 0xffff0000u), __uint_as_float(hw[3] << 16), __uint_as_float(hw[3] & 0xffff0000u)}; }
                dn[k] = ((const LAS float*)(L + MX_DEN))[t]; flr[k] = gFL[64 * n + t]; }
            MX_LDS_FENCE();
#pragma unroll
            for (int k = 0; k < 2; ++k) { const int id = tid + 512 * k, t = id >> 4, c = id & 15;
                const float inv = __builtin_amdgcn_rcpf(fmaxf(fabsf(dn[k]), flr[k]));
                float hv[8] = {hh[k][0][0] * inv, hh[k][0][1] * inv, hh[k][0][2] * inv, hh[k][0][3] * inv, hh[k][1][0] * inv, hh[k][1][1] * inv, hh[k][1][2] * inv, hh[k][1][3] * inv};
                float sm = 0.f;
#pragma unroll
                for (int e = 0; e < 8; ++e) sm += hv[e];
                sm = row_sum16(sm);
                const float mean = sm * (1.f / 128.f); float q = 0.f;
#pragma unroll
                for (int e = 0; e < 8; ++e) { hv[e] -= mean; q = __builtin_fmaf(hv[e], hv[e], q); }
                q = row_sum16(q);
                const float rstd = rsqrtf(q * (1.f / 128.f) + LN_EPS);
                float yv[8];
#pragma unroll
                for (int e2 = 0; e2 < 4; ++e2) { const unsigned x = ro[k][e2]; const float o0 = __uint_as_float(x << 16), o1 = __uint_as_float(x & 0xffff0000u);
                    yv[2 * e2] = hv[2 * e2] * rstd * gain[2 * e2] * __builtin_amdgcn_rcpf(1.0f + fexp(-o0)); yv[2 * e2 + 1] = hv[2 * e2 + 1] * rstd * gain[2 * e2 + 1] * __builtin_amdgcn_rcpf(1.0f + fexp(-o1)); }
                v4u o; o.x = pkbf(yv[0], yv[1]); o.y = pkbf(yv[2], yv[3]); o.z = pkbf(yv[4], yv[5]); o.w = pkbf(yv[6], yv[7]);
                __builtin_nontemporal_store(o, (GAS v4u*)(Y + (gr_seg + 64 * n + t) * DM + 512 + 128 * h + 8 * c)); }
            if (n + 1 < 8) MX_LOAD_O(n + 1);
            __syncthreads();
        }
    }
    }
    if (!OUT) {
        float* st = ST + (size_t)u * ST_FLOATS;
#pragma unroll
        for (int mt = 0; mt < 4; ++mt)
#pragma unroll
            for (int r = 0; r < 4; ++r) st[(16 * mt + 4 * lq + r) * 144 + 16 * w + l15] = cacc[mt][r];
        if (w < 4) {
#pragma unroll
            for (int r = 0; r < 4; ++r) st[(16 * w + 4 * lq + r) * 144 + 128 + l15] = nacc[r]; }
    }
    __syncthreads();
}

constexpr int SG_RAW = 0, SG_SOUT = 34816;

__device__ __forceinline__ void sgu_phase(Frame& F, const Args& args, int l) {
    const int tid = F.tid, lane = F.lane, w = F.wave, l15 = lane & 15, lq = lane >> 4;
    unsigned char* ws = F.ws; const bf16* Z = (const bf16*)(ws + WS_Z); bf16* Y = (bf16*)(ws + WS_Y);
    LAS unsigned char* L = F.lds;
    const int h = F.vcu & 3;
    const float* sw = INP(6) + ((size_t)l * 4 + h) * 128 * 128; const float* sb = INP(7) + (l * 4 + h) * 128;
    const float* lg = INP(8) + (l * 4 + h) * 128; const float* lb = INP(9) + (l * 4 + h) * 128;
    bf16x8 wa[4];
#pragma unroll
    for (int ks = 0; ks < 4; ++ks) { const float* p = sw + (size_t)(16 * w + l15) * 128 + 32 * ks + 8 * lq; const f32x4 a = *(const GAS f32x4*)p, b = *(const GAS f32x4*)(p + 4);
        v4u o; o.x = pkbf(a[0], a[1]); o.y = pkbf(a[2], a[3]); o.z = pkbf(b[0], b[1]); o.w = pkbf(b[2], b[3]);
        if (w < 4 && ks >= 2) o = (v4u){0u, 0u, 0u, 0u};
        wa[ks] = __builtin_bit_cast(bf16x8, o); }
    const float bsi = sb[16 * w + l15];
    float lgv[8], lbv[8];
#pragma unroll
    for (int e = 0; e < 8; ++e) { lgv[e] = lg[8 * (tid & 15) + e]; lbv[e] = lb[8 * (tid & 15) + e]; }
    v4u pv_[4], pu_[4];
#pragma unroll
    for (int k = 0; k < 4; ++k) { const int id = tid + 512 * k; pv_[k] = __builtin_nontemporal_load((const GAS v4u*)(Z + ((size_t)((F.vcu >> 2) * 4) * 128 + (id >> 4)) * ZW + 512 + 128 * h + 8 * (id & 15))); }
#pragma unroll 1
    for (int it = 0; it < 4; ++it) {
        const int blk = (F.vcu >> 2) * 4 + it;
        const size_t r0 = (size_t)blk * 128;
#pragma unroll
        for (int k = 0; k < 4; ++k) { const int id = tid + 512 * k; pu_[k] = __builtin_nontemporal_load((const GAS v4u*)(Z + (r0 + (id >> 4)) * ZW + 128 * h + 8 * (id & 15))); }
#pragma unroll
        for (int k = 0; k < 4; ++k) { const int id = tid + 512 * k, j = id >> 4, c = id & 15;
            const v4u rw = pv_[k];
            float v[8];
#pragma unroll
            for (int e2 = 0; e2 < 4; ++e2) { v[2 * e2] = __uint_as_float(rw[e2] << 16); v[2 * e2 + 1] = __uint_as_float(rw[e2] & 0xffff0000u); }
            float sm = 0.f;
#pragma unroll
            for (int e = 0; e < 8; ++e) sm += v[e];
            sm = row_sum16(sm);
            const float mean = sm * (1.f / 128.f); float q = 0.f;
#pragma unroll
            for (int e = 0; e < 8; ++e) { v[e] -= mean; q = __builtin_fmaf(v[e], v[e], q); }
            q = row_sum16(q);
            const float rstd = rsqrtf(q * (1.f / 128.f) + LN_EPS);
#pragma unroll
            for (int e = 0; e < 8; ++e) v[e] = v[e] * rstd * lgv[e] + lbv[e];
            v4u o; o.x = pkbf(v[0], v[1]); o.y = pkbf(v[2], v[3]); o.z = pkbf(v[4], v[5]); o.w = pkbf(v[6], v[7]);
            *(LAS v4u*)(L + SG_RAW + j * 272 + c * 16) = o; }
        if (it + 1 < 4) {
#pragma unroll
            for (int k = 0; k < 4; ++k) { const int id = tid + 512 * k; pv_[k] = __builtin_nontemporal_load((const GAS v4u*)(Z + (r0 + 128 + (id >> 4)) * ZW + 512 + 128 * h + 8 * (id & 15))); } }
        __syncthreads();
        {
            f32x4 sa[8];
#pragma unroll
            for (int nt = 0; nt < 8; ++nt) sa[nt] = (f32x4){0.f, 0.f, 0.f, 0.f};
#pragma unroll
            for (int ks = 0; ks < 4; ++ks) {
                if (ks < 2 || w >= 4) {
#pragma unroll
                    for (int nt = 0; nt < 8; ++nt) {
                        LAS unsigned char* tp = L + SG_RAW + (32 * ks + 8 * lq + (l15 >> 2)) * 272 + (16 * nt + 4 * (l15 & 3)) * 2;
                        const s16x4t t0 = __builtin_amdgcn_ds_read_tr16_b64_v4i16((LAS s16x4t*)tp), t1 = __builtin_amdgcn_ds_read_tr16_b64_v4i16((LAS s16x4t*)(tp + 4 * 272));
                        const bf16x8 bv = __builtin_shufflevector(t0, t1, 0, 1, 2, 3, 4, 5, 6, 7);
                        sa[nt] = __builtin_amdgcn_mfma_f32_16x16x32_bf16(bv, wa[ks], sa[nt], 0, 0, 0); } } }
#pragma unroll
            for (int nt = 0; nt < 8; ++nt) *(LAS f32x4*)(L + SG_SOUT + ((16 * w + l15) * 132 + 16 * nt + 4 * lq) * 4) = sa[nt] + bsi;
        }
        __syncthreads();
#pragma unroll
        for (int k = 0; k < 4; ++k) { const int id = tid + 512 * k, i = id >> 4, c = id & 15;
            const v4u rw = pu_[k];
            const f32x4 s0 = *(const LAS f32x4*)(L + SG_SOUT + (i * 132 + 8 * c) * 4), s1 = *(const LAS f32x4*)(L + SG_SOUT + (i * 132 + 8 * c + 4) * 4);
            v4u o; o.x = pkbf(__uint_as_float(rw[0] << 16) * s0[0], __uint_as_float(rw[0] & 0xffff0000u) * s0[1]); o.y = pkbf(__uint_as_float(rw[1] << 16) * s0[2], __uint_as_float(rw[1] & 0xffff0000u) * s0[3]);
            o.z = pkbf(__uint_as_float(rw[2] << 16) * s1[0], __uint_as_float(rw[2] & 0xffff0000u) * s1[1]); o.w = pkbf(__uint_as_float(rw[3] << 16) * s1[2], __uint_as_float(rw[3] & 0xffff0000u) * s1[3]);
            __builtin_nontemporal_store(o, (GAS v4u*)(Y + (r0 + i) * DM + 128 * h + 8 * c)); }
    }
    __syncthreads();
}
#define MIXER_PASS1 mlstm_phase<false>(F, args, l);
#define MIXER_PASS2 { mlstm_phase<true>(F, args, l); sgu_phase(F, args, l); }
__global__ void __launch_bounds__(NWAVES * 64, 2) mk_fwd(Args args) {
    extern __shared__ __attribute__((aligned(16))) unsigned char lds[];
    Frame F;
    F.lds = (LAS unsigned char*)lds;
    F.MISC = (volatile LAS unsigned*)(F.lds + MISC_OFF);
    F.tid = threadIdx.x; F.lane = F.tid & 63; F.wave = __builtin_amdgcn_readfirstlane(F.tid >> 6);
    F.G = gridDim.x; { const int bx = blockIdx.x; F.vcu = (F.G % 8 == 0) ? (bx % 8) * (F.G / 8) + bx / 8 : bx; }
    F.ws = args.ws;
    F.ctl = (gu32*)(F.ws + WS_CTL);
    for (int u = F.tid; u < (LDS_BYTES - LDSCTL_OFF) / 4; u += NWAVES * 64) ((LAS unsigned*)(F.lds + LDSCTL_OFF))[u] = 0u;
    __syncthreads();
    if (F.tid == 0) {
#pragma unroll
        for (int i = 0; i < 20; ++i) ((LAS unsigned long long*)(F.lds + PT_OFF))[i] = (unsigned long long)args.in[i];
        ((LAS unsigned long long*)(F.lds + PT_OFF))[20] = (unsigned long long)args.out; }
    __syncthreads();
    const int lo = args.ph_lo, hi = args.ph_hi;
    XcdBarrier bar; bar.bar = (unsigned*)(F.ctl + CW_BAR) + args.bar_region * XCD_BAR_WORDS; bar.x = 0; bar.st = nullptr;
    if (hi - lo > 1) bar = xcd_barrier_post((unsigned*)(F.ctl + CW_BAR) + args.bar_region * XCD_BAR_WORDS, F.MISC + 8);

#pragma unroll 1
    for (int ph = lo; ph < hi; ++ph) {
        const int l = (ph - 1) / 7, sub = (ph - 1) % 7;
        int nrep = 1;
        if (DUP_MASK && ph < NPHASE - 1) { if (ph == 0) nrep += (DUP_MASK >> 7) & 1; else nrep += (DUP_MASK >> sub) & 1; }
#pragma unroll 1
        for (int rep = 0; rep < nrep; ++rep) {
        if (ph > lo || rep) xcd_barrier(bar, F.wave == 0 && mk_lane() == 0);
        if (PROBE_CLK >= 10 && blockIdx.x == 0 && F.tid == 0) ((unsigned long long*)(F.ws + WS_CTL + 16384))[ph] = __builtin_amdgcn_s_memrealtime();
#define FRESH_LANE() do { F.lane = mk_lane(); asm volatile("" : "+v"(F.lane)); F.tid = F.wave * 64 + F.lane; } while (0)
        asm volatile("" : "+s"(F.vcu), "+s"(F.wave), "+s"(F.G));
        { unsigned long long wsi = (unsigned long long)F.ws; asm volatile("" : "+s"(wsi)); F.ws = (unsigned char*)(GAS unsigned char*)wsi; }
        unsigned char* ws = F.ws;
        bf16* XN = (bf16*)(ws + WS_XN); bf16* Z = (bf16*)(ws + WS_Z); float* GT = (float*)(ws + WS_GT); bf16* Y = (bf16*)(ws + WS_Y); bf16* H = (bf16*)(ws + WS_H);
        float* G0 = (float*)(ws + WS_G0); float* UP0 = (float*)(ws + WS_UP0);
        if (ph == 0) { FRESH_LANE(); p0_prologue(F, args); continue; }
        const unsigned char* wt = ws + WS_WT + (size_t)l * WT_LAYER;
        const float* cv = (const float*)(ws + WS_CV); float* partA = (float*)(ws + WS_PARTA); float* partB = (float*)(ws + WS_PARTB);
        if (sub == 0) {
#ifndef NO_Z
            FRESH_LANE();
            if (l == 0) cvec_finalize(F, args);
            const float* part = l > 0 ? partB : nullptr;
            pg8::Gemm g{XN, (const bf16*)(wt + WT_IN), M, ZW, DM}; pg8::StaticOrder S; S.init(M, ZW, F.G, (int)blockIdx.x);
            pg8::EpiZ E{Z, ZW, part, cv + CV_IN1, cv + CV_IN1 + 2576, F.lds + MX_TAB};
            pg8::gemm_phase<pg8::EpiZ, pg8::StaticOrder, true, true>(F.lds + RING_OFF, g, S, E, F.tid);
            FRESH_LANE();
            gates_phase(F, XN, (const bf16*)(wt + WT_G), GT, part, cv + CV_IN1 + ZW, cv + CV_IN1 + 2576 + ZW);
            if (l == 0) { FRESH_LANE(); quant_w_step(F); }
#endif
        } else if (sub == 1) {
#ifndef NO_MIX
            FRESH_LANE();
            MIXER_PASS1
#endif
        } else if (sub == 2) {
#ifndef NO_MIX
            FRESH_LANE();
            MIXER_PASS2
#endif
        } else if (sub == 3) {
#ifndef NO_RES
            FRESH_LANE();
            res_gemm_phase_q(F, Y, (const bf16*)(wt + WT_OUT), DM, XN, XN, l > 0 ? partB : (const float*)nullptr, INP(18) + (l > 0 ? l - 1 : 0) * DM, INP(19) + (l > 0 ? l - 1 : 0) * DM, partA, (unsigned*)(F.ctl + CW_PANEL) + l * 128);
#endif
        } else if (sub == 4) {
#ifndef NO_GLU
            FRESH_LANE();
            pg8::Gemm g{(const bf16*)(ws + WS_V8), (const bf16*)(ws + WS_W8 + (size_t)l * 2 * DFF * DM), M, 2 * DFF, DM / 2}; pg8::StaticOrder S; S.init(M, 2 * DFF, F.G, (int)blockIdx.x);
            const float* cu = cv + (l == 0 ? CV_UP0 : CV_UP1); const float* swc = (const float*)(ws + WS_SWC) + (size_t)l * 4 * DFF;
            pg8::EpiGlu8 E{H, INP(15) + (size_t)l * 3 * DFF, INP(16) + l * DFF, G0, UP0, DFF, M / 64, partA, swc + 2 * DFF, cu + 5632, F.lds + MX_TAB, swc, (const float*)(ws + WS_SA)};
            pg8::gemm_phase<pg8::EpiGlu8, pg8::StaticOrder, true, true>(F.lds + RING_OFF, g, S, E, F.tid);
#endif
        } else if (sub == 5) {
            FRESH_LANE();
            glu_fixup_phase(F, G0, UP0, INP(15) + (size_t)l * 3 * DFF, INP(16) + l * DFF, H);
        } else {
#ifndef NO_RES
            FRESH_LANE();
            if (l == DEPTH - 1) res_gemm_phase_f(F, H, (const bf16*)(wt + WT_DN), DFF, XN, partA, INP(12) + l * DM, INP(13) + l * DM, partB, (unsigned*)(F.ctl + CW_PANEL) + (DEPTH + l) * 128, INP(18) + l * DM, INP(19) + l * DM, (float*)INP(20));
            else
            res_gemm_phase(F, H, (const bf16*)(wt + WT_DN), DFF, XN, (DUP_MASK && rep == 0 && nrep == 2) ? (bf16*)(ws + WS_T4) : XN, partA, INP(12) + l * DM, INP(13) + l * DM, (DUP_MASK && rep == 0 && nrep == 2) ? (float*)(ws + WS_T4 + 128 * MiB) : partB);
#endif
        }
        }
    }
    if (PROBE_CLK && hi == NPHASE) { xcd_barrier(bar, F.wave == 0 && mk_lane() == 0); if (blockIdx.x == 0 && F.tid == 0) {
        if (PROBE_CLK >= 10) { unsigned long long* ts = (unsigned long long*)(F.ws + WS_CTL + 16384); ts[NPHASE] = __builtin_amdgcn_s_memrealtime(); const int k = PROBE_CLK - 10;
            ((float*)INP(20))[0] += 0.1f + 1e-5f * (float)(ts[k + 1] - ts[k]); }
        else ((float*)INP(20))[0] += ((float*)(F.ws + WS_CTL))[2048]; } }
}

static void launch_mk(const Args& base, int lo, int hi, int region, hipStream_t stream) {
    Args a = base; a.ph_lo = lo; a.ph_hi = hi; a.bar_region = region; a.pad = 0;
    hipLaunchKernelGGL(mk_fwd, dim3(256), dim3(NWAVES * 64), LDS_BYTES, stream, a);
}

extern "C" void kernel_launch(void* const* d_in, const int* in_sizes, int n_in, void* d_out, int out_size, void* d_ws, size_t ws_size, hipStream_t stream) {
    static int inited = 0;
    if (!inited) {
        if (hipFuncSetAttribute((const void*)mk_fwd, hipFuncAttributeMaxDynamicSharedMemorySize, LDS_BYTES) != hipSuccess) fprintf(stderr, "kernel_launch: hipFuncSetAttribute failed\n");
        int dev = 0, cus = 0, per_cu = 0;
        if (hipGetDevice(&dev) != hipSuccess || hipDeviceGetAttribute(&cus, hipDeviceAttributeMultiprocessorCount, dev) != hipSuccess) cus = 0;
        if (hipOccupancyMaxActiveBlocksPerMultiprocessor(&per_cu, (const void*)mk_fwd, NWAVES * 64, LDS_BYTES) != hipSuccess) per_cu = 0;
        (void)hipGetLastError();
        if (cus * per_cu < 256) fprintf(stderr, "kernel_launch: %d CUs x %d resident workgroups per CU < the 256 workgroups this kernel's grid barriers need\n", cus, per_cu);
        inited = 1;
    }
    unsigned char* ws = (unsigned char*)d_ws;
    (void)hipMemsetAsync(ws + WS_CTL, 0, CTL_ZERO_BYTES, stream);
    Args a{};
    for (int i = 0; i < 20; ++i) a.in[i] = (const float*)d_in[i];
    a.out = (float*)d_out; a.ws = ws;
    launch_mk(a, 0, NPHASE, 0, stream);
}
```
